# Optimizing an MI355X kernel written in HIP

```python
import math
import jax, jax.numpy as jnp
from jax import lax
import numpy as np

D_MODEL = 1024
BATCH = 4
SEQ = 8192
DEPTH = 1

GRID_W = 64
CTX_LEN = 256
DA_HEADS = 4
DA_QK = 64
DA_V = 2 * DA_QK
ML_HEADS = 4
ML_QK = 64
ML_V = 128
D_MIX = DA_HEADS * DA_V + ML_HEADS * ML_V
D_FF = 4 * D_MODEL
ROPE_BASE = 10000.0
Q_BLOCK = 128
ML_CHUNK = 64
EPS = 1e-6

DA_Q_COLS = DA_HEADS * 2 * DA_QK
DA_K_COLS = DA_HEADS * 2 * DA_QK
DA_V_COLS = DA_HEADS * DA_V
ML_Q_COLS = ML_HEADS * ML_QK
ML_K_COLS = ML_HEADS * ML_QK
ML_V_COLS = ML_HEADS * ML_V
ML_O_COLS = ML_HEADS * ML_V
ML_G_COLS = 4 * ML_HEADS
IN_SPLITS = (DA_Q_COLS,
             DA_Q_COLS + DA_K_COLS,
             DA_Q_COLS + DA_K_COLS + DA_V_COLS,
             DA_Q_COLS + DA_K_COLS + DA_V_COLS + ML_Q_COLS,
             DA_Q_COLS + DA_K_COLS + DA_V_COLS + ML_Q_COLS + ML_K_COLS,
             DA_Q_COLS + DA_K_COLS + DA_V_COLS + ML_Q_COLS + ML_K_COLS + ML_V_COLS,
             DA_Q_COLS + DA_K_COLS + DA_V_COLS + ML_Q_COLS + ML_K_COLS + ML_V_COLS + ML_O_COLS)
IN_COLS = IN_SPLITS[-1] + ML_G_COLS

kernel_name = "hybrid_diffattn_mlstm_dit_block"


def rmsnorm(x, g):
    xf = x.astype(jnp.float32)
    y = xf * lax.rsqrt(jnp.mean(xf * xf, axis=-1, keepdims=True) + EPS)
    return (y * g.astype(jnp.float32)).astype(x.dtype)


def axial_rope(T):
    rows = T // GRID_W
    row = jnp.repeat(jnp.arange(rows, dtype=jnp.float32), GRID_W)
    col = jnp.tile(jnp.arange(GRID_W, dtype=jnp.float32), rows)
    half = DA_QK // 2
    inv = ROPE_BASE ** (-jnp.arange(0, half, 2, dtype=jnp.float32) / half)
    ar = row[:, None] * inv
    ac = col[:, None] * inv
    ang = jnp.concatenate([ar, ar, ac, ac], axis=-1)
    return jnp.cos(ang), jnp.sin(ang)


def apply_rope(x, cos, sin):
    def rot(u):
        u1, u2 = jnp.split(u, 2, axis=-1)
        return jnp.concatenate([-u2, u1], axis=-1)
    xr, xc = jnp.split(x, 2, axis=-1)
    xrot = jnp.concatenate([rot(xr), rot(xc)], axis=-1)
    return (x * cos + xrot * sin).astype(x.dtype)


def project(xm, w_in_l, b_gate_l):
    B_, T_ = xm.shape[0], xm.shape[1]
    h = xm @ w_in_l
    dq, dk, dv, mq, mk, mv, mo, mg = jnp.split(h, IN_SPLITS, axis=-1)
    dq = dq.reshape(B_, T_, DA_HEADS, 2, DA_QK).transpose(0, 2, 3, 1, 4)
    dk = dk.reshape(B_, T_, DA_HEADS, 2, DA_QK).transpose(0, 2, 3, 1, 4)
    dv = dv.reshape(B_, T_, DA_HEADS, DA_V).transpose(0, 2, 1, 3)
    mq = mq.reshape(B_, T_, ML_HEADS, ML_QK).transpose(0, 2, 1, 3)
    mk = mk.reshape(B_, T_, ML_HEADS, ML_QK).transpose(0, 2, 1, 3) * (ML_QK ** -0.5)
    mv = mv.reshape(B_, T_, ML_HEADS, ML_V).transpose(0, 2, 1, 3)
    mo = jax.nn.sigmoid(mo)
    mg = (mg.reshape(B_, T_, 4, ML_HEADS) + b_gate_l.reshape(4, ML_HEADS)).transpose(2, 0, 3, 1)
    return dq, dk, dv, mq, mk, mv, mo, mg


def diff_attn_core(q, k, v, lam):
    s = jnp.einsum('bhmqd,bhmkd->bhmqk', q, k).astype(jnp.float32) * (DA_QK ** -0.5)
    p = jax.nn.softmax(s, axis=-1)
    a = p[:, :, 0] - lam * p[:, :, 1]
    return jnp.einsum('bhqk,bhkv->bhqv', a.astype(v.dtype), v)


def diff_attn_latent(q, k_all, v_all, lam):
    B_, H_, _, T_, d = q.shape
    nb = T_ // Q_BLOCK
    qb = jnp.moveaxis(q.reshape(B_, H_, 2, nb, Q_BLOCK, d), 3, 0)
    out = lax.map(lambda qblk: diff_attn_core(qblk, k_all, v_all, lam), qb)
    return jnp.moveaxis(out, 0, 2).reshape(B_, H_, T_, v_all.shape[-1])


def mlstm_chunked(q, k, v, li, lf, state):
    out_dtype = v.dtype
    q, k, v = q.astype(jnp.float32), k.astype(jnp.float32), v.astype(jnp.float32)
    B_, H_, T_, dk = q.shape
    dv = v.shape[-1]
    nc = T_ // ML_CHUNK

    def chunks(a):
        a = a.reshape((B_, H_, nc, ML_CHUNK) + a.shape[3:])
        return jnp.moveaxis(a, 2, 0)

    tril = jnp.tril(jnp.ones((ML_CHUNK, ML_CHUNK), dtype=bool))

    def step(carry, inp):
        C, n, m = carry
        qc, kc, vc, lic, lfc = inp
        b = jnp.cumsum(lfc, axis=-1)
        dmat = b[..., :, None] - b[..., None, :] + lic[..., None, :]
        dmat = jnp.where(tril, dmat, -jnp.inf)
        inter = b + m[..., None]
        m_t = jnp.maximum(inter, jnp.max(dmat, axis=-1))
        s = jnp.einsum('bhtd,bhsd->bhts', qc, kc) * jnp.exp(dmat - m_t[..., None])
        w_inter = jnp.exp(inter - m_t)
        num = jnp.einsum('bhts,bhsv->bhtv', s, vc) + w_inter[..., None] * jnp.einsum('bhvd,bhtd->bhtv', C, qc)
        den = jnp.sum(s, axis=-1) + w_inter * jnp.einsum('bhd,bhtd->bht', n, qc)
        h = num / jnp.maximum(jnp.abs(den), jnp.exp(-m_t))[..., None]
        b_last = b[..., -1]
        g = b_last[..., None] - b + lic
        m_new = jnp.maximum(b_last + m, jnp.max(g, axis=-1))
        w = jnp.exp(g - m_new[..., None])
        decay = jnp.exp(b_last + m - m_new)
        C = decay[..., None, None] * C + jnp.einsum('bhsv,bhsd->bhvd', vc * w[..., None], kc)
        n = decay[..., None] * n + jnp.einsum('bhs,bhsd->bhd', w, kc)
        return (C, n, m_new), h

    state, h = lax.scan(step, state, (chunks(q), chunks(k), chunks(v), chunks(li), chunks(lf)))
    h = jnp.moveaxis(h, 0, 2).reshape(B_, H_, T_, dv)
    return h.astype(out_dtype), state


def mlstm_zero_state(B_):
    return (jnp.zeros((B_, ML_HEADS, ML_V, ML_QK), jnp.float32),
            jnp.zeros((B_, ML_HEADS, ML_QK), jnp.float32),
            jnp.zeros((B_, ML_HEADS), jnp.float32))


def gates(mg):
    mg = mg.astype(jnp.float32)
    return mg[0], jax.nn.log_sigmoid(mg[1]), mg[2], jax.nn.log_sigmoid(mg[3])


def merge_heads(da_h, ml_h, mo, subln_g_l, ml_norm_g_l, lambda_init, w_out_l):
    B_, _, T_, _ = da_h.shape
    da = rmsnorm(da_h, subln_g_l) * (1.0 - lambda_init)
    da = da.transpose(0, 2, 1, 3).reshape(B_, T_, DA_HEADS * DA_V)
    ml = rmsnorm(ml_h, ml_norm_g_l.reshape(ML_HEADS, 1, ML_V))
    ml = ml.transpose(0, 2, 1, 3).reshape(B_, T_, ML_HEADS * ML_V) * mo
    return jnp.concatenate([da, ml], axis=-1) @ w_out_l


def sq_relu_mlp(x, w1, w2):
    return jnp.square(jax.nn.relu(x @ w1)) @ w2


def hybrid_mixer(xm, cm, w_in_l, b_gate_l, lq1, lk1, lq2, lk2, subln_g_l, ml_norm_g_l, w_out_l,
                 cos, sin, lambda_init, update_ctx):
    B_ = xm.shape[0]
    dq, dk, dv, mq, mk, mv, mo, mg = project(xm, w_in_l, b_gate_l)
    cdq, cdk, cdv, cmq, cmk, cmv, cmo, cmg = project(cm, w_in_l, b_gate_l)
    lam = (jnp.exp(jnp.sum(lq1.astype(jnp.float32) * lk1.astype(jnp.float32)))
           - jnp.exp(jnp.sum(lq2.astype(jnp.float32) * lk2.astype(jnp.float32))) + lambda_init)

    q_lat = apply_rope(dq, cos, sin)
    k_all = jnp.concatenate([cdk, apply_rope(dk, cos, sin)], axis=3)
    v_all = jnp.concatenate([cdv, dv], axis=2)
    da_lat = diff_attn_latent(q_lat, k_all, v_all, lam)

    li_f, lf_f, li_b, lf_b = gates(mg)
    cli_f, clf_f, cli_b, clf_b = gates(cmg)
    flip = lambda a: jnp.flip(a, axis=2)
    zero = mlstm_zero_state(B_)
    hc_f, st_f = mlstm_chunked(cmq, cmk, cmv, cli_f, clf_f, zero)
    hc_b_rev, st_b = mlstm_chunked(flip(cmq), flip(cmk), flip(cmv), flip(cli_b), flip(clf_b), zero)
    h_f, _ = mlstm_chunked(mq, mk, mv, li_f, lf_f, st_f)
    h_b_rev, _ = mlstm_chunked(flip(mq), flip(mk), flip(mv), flip(li_b), flip(lf_b), st_b)
    ml_lat = h_f + flip(h_b_rev)

    y_lat = merge_heads(da_lat, ml_lat, mo, subln_g_l, ml_norm_g_l, lambda_init, w_out_l)
    if update_ctx:
        da_ctx = diff_attn_core(cdq, cdk, cdv, lam)
        ml_ctx = hc_f + flip(hc_b_rev)
        y_ctx = merge_heads(da_ctx, ml_ctx, cmo, subln_g_l, ml_norm_g_l, lambda_init, w_out_l)
        return y_lat, y_ctx
    return y_lat, None


def setup_inputs(seed: int = 0) -> dict:
    key = jax.random.key(seed)
    ks = jax.random.split(key, 20)
    f32 = jnp.float32
    nrm = lambda k, shape, s: jax.random.normal(k, shape, f32) * s
    f_bias = jnp.tile(jnp.linspace(3.0, 6.0, ML_HEADS, dtype=f32), 2)
    gate_offset = jnp.concatenate([jnp.zeros((ML_HEADS,), f32), f_bias[:ML_HEADS],
                                   jnp.zeros((ML_HEADS,), f32), f_bias[ML_HEADS:]])
    return {
        "x": nrm(ks[0], (BATCH, SEQ, D_MODEL), 1.0),
        "c": nrm(ks[1], (BATCH, D_MODEL), 1.0),
        "ctx": nrm(ks[2], (BATCH, CTX_LEN, D_MODEL), 1.0),
        "c_ctx": nrm(ks[3], (D_MODEL,), 1.0),
        "w_ada": nrm(ks[4], (DEPTH, D_MODEL, 6 * D_MODEL), D_MODEL ** -0.5),
        "b_ada": nrm(ks[5], (DEPTH, 6 * D_MODEL), 0.02),
        "norm1_g": 1.0 + nrm(ks[6], (DEPTH, D_MODEL), 0.02),
        "norm2_g": 1.0 + nrm(ks[7], (DEPTH, D_MODEL), 0.02),
        "w_in": nrm(ks[8], (DEPTH, D_MODEL, IN_COLS), D_MODEL ** -0.5),
        "b_gate": gate_offset + nrm(ks[9], (DEPTH, ML_G_COLS), 0.1),
        "lam_q1": nrm(ks[10], (DEPTH, DA_QK), 0.1),
        "lam_k1": nrm(ks[11], (DEPTH, DA_QK), 0.1),
        "lam_q2": nrm(ks[12], (DEPTH, DA_QK), 0.1),
        "lam_k2": nrm(ks[13], (DEPTH, DA_QK), 0.1),
        "subln_g": 1.0 + nrm(ks[14], (DEPTH, DA_V), 0.02),
        "mlstm_norm_g": 1.0 + nrm(ks[15], (DEPTH, ML_HEADS * ML_V), 0.02),
        "w_out": nrm(ks[16], (DEPTH, D_MIX, D_MODEL), D_MIX ** -0.5),
        "w_fc1": nrm(ks[17], (DEPTH, D_MODEL, D_FF), D_MODEL ** -0.5),
        "w_fc2": nrm(ks[18], (DEPTH, D_FF, D_MODEL), D_FF ** -0.5),
        "final_g": 1.0 + nrm(ks[19], (D_MODEL,), 0.02),
    }


def reference(x, c, ctx, c_ctx, w_ada, b_ada, norm1_g, norm2_g, w_in, b_gate, lam_q1, lam_k1, lam_q2, lam_k2,
              subln_g, mlstm_norm_g, w_out, w_fc1, w_fc2, final_g):
    T = x.shape[1]
    cos, sin = axial_rope(T)
    for l in range(DEPTH):
        update_ctx = l < DEPTH - 1
        lambda_init = 0.8 - 0.6 * math.exp(-0.3 * l)
        mod = jax.nn.silu(c) @ w_ada[l] + b_ada[l]
        mod_c = jax.nn.silu(c_ctx) @ w_ada[l] + b_ada[l]
        sh1, sc1, g1, sh2, sc2, g2 = jnp.split(mod[:, None, :], 6, axis=-1)
        csh1, csc1, cg1, csh2, csc2, cg2 = jnp.split(mod_c[None, None, :], 6, axis=-1)
        xm = rmsnorm(x, norm1_g[l]) * (1.0 + sc1) + sh1
        cm = rmsnorm(ctx, norm1_g[l]) * (1.0 + csc1) + csh1
        y, y_ctx = hybrid_mixer(xm, cm, w_in[l], b_gate[l], lam_q1[l], lam_k1[l], lam_q2[l], lam_k2[l],
                                subln_g[l], mlstm_norm_g[l], w_out[l], cos, sin, lambda_init, update_ctx)
        x = x + g1 * y
        x = x + g2 * sq_relu_mlp(rmsnorm(x, norm2_g[l]) * (1.0 + sc2) + sh2, w_fc1[l], w_fc2[l])
        if update_ctx:
            ctx = ctx + cg1 * y_ctx
            ctx = ctx + cg2 * sq_relu_mlp(rmsnorm(ctx, norm2_g[l]) * (1.0 + csc2) + csh2, w_fc1[l], w_fc2[l])
    return rmsnorm(x, final_g)
```

```cpp
#include <hip/hip_runtime.h>
#include <cstdio>
#include <cstdint>

constexpr int NB = 4, T = 8192, CT = 256, TK = T + CT, D = 1024, FF = 4096, NH = 4;
constexpr int NTOK = NB * T, NCTX = NB * CT, MROWS = NTOK + NCTX;
constexpr int INC = 3088, INP = 3072;
constexpr float EPS = 1e-6f;
constexpr float LAMBDA_INIT = 0.2f;
constexpr float C2 = 0.125f * 1.4426950408889634f;

constexpr size_t MiB = 1u << 20;
constexpr size_t WS_CTL = 0, CTL_ZERO_BYTES = 1 * MiB;
constexpr size_t WS_ROWSQ1 = 256 * 1024, WS_ROWSQ2 = 384 * 1024;
constexpr size_t WS_MOD = 1 * MiB;
constexpr size_t WS_ROPE = WS_MOD + 128 * 1024;
constexpr size_t WS_BIAS1 = WS_ROPE + 32 * 1024;
constexpr size_t WS_WGT = WS_BIAS1 + 64 * 1024;
constexpr size_t WS_WIN = 2 * MiB, WS_WO = 9 * MiB, WS_W1 = 11 * MiB, WS_W2 = 19 * MiB;
constexpr size_t WS_G = 27 * MiB;
constexpr size_t WS_XM = 32 * MiB;
constexpr size_t WS_Q = 98 * MiB, WS_K = 130 * MiB, WS_V = 163 * MiB, WS_MQ = 196 * MiB, WS_MK = 213 * MiB, WS_MV = 230 * MiB, WS_MO = 263 * MiB;
constexpr size_t WS_DC = 296 * MiB;
constexpr size_t WS_CIN = 430 * MiB;
constexpr size_t WS_MIX = 296 * MiB + 0;
constexpr size_t WS_H = 98 * MiB;
constexpr size_t WS_END = 512 * MiB;

typedef unsigned short bf16;
typedef unsigned v4u __attribute__((ext_vector_type(4)));
typedef unsigned v2u __attribute__((ext_vector_type(2)));
typedef float f32x4 __attribute__((ext_vector_type(4)));
typedef float f32x2 __attribute__((ext_vector_type(2)));
#define LAS __attribute__((address_space(3)))

__device__ __forceinline__ unsigned f2bf(float f) { unsigned u = __builtin_bit_cast(unsigned, f); return (u + 0x7fffu + ((u >> 16) & 1u)) >> 16; }
__device__ __forceinline__ unsigned pk2(float lo, float hi) { return f2bf(lo) | (f2bf(hi) << 16); }
__device__ __forceinline__ float bf2f(unsigned short b) { return __builtin_bit_cast(float, (unsigned)b << 16); }
__device__ __forceinline__ float bflo(unsigned w) { return __builtin_bit_cast(float, w << 16); }
__device__ __forceinline__ float bfhi(unsigned w) { return __builtin_bit_cast(float, w & 0xffff0000u); }
__device__ __forceinline__ float wave_sum(float v) {
#pragma unroll
    for (int o = 1; o < 64; o <<= 1) v += __shfl_xor(v, o);
    return v;
}
__device__ __forceinline__ float wave_max(float v) {
#pragma unroll
    for (int o = 1; o < 64; o <<= 1) v = fmaxf(v, __shfl_xor(v, o));
    return v;
}

constexpr int NWAVES = 8;
constexpr int LDS_BYTES = 147456;

struct Args {
    const float* in[20]; float* out; unsigned char* ws; int ph_lo, ph_hi, li, pad;
};
enum { I_X = 0, I_C, I_CTX, I_CCTX, I_WADA, I_BADA, I_N1G, I_N2G, I_WIN, I_BGATE, I_LQ1, I_LK1, I_LQ2, I_LK2, I_SUBLN, I_MLNG, I_WOUT, I_WFC1, I_WFC2, I_FING };

struct Frame {
    LAS unsigned char* lds;
    int tid, lane, wave, vcu, G;
    const float* in[20]; float* out; unsigned char* ws;
    float* mod; f32x2* rope; float* bias1; float* wgt; float* gates; float* rowsq1; float* rowsq2;
    bf16 *WinT, *WoT, *W1T, *W2T, *XM, *Qd, *Kd, *Vd, *MQ, *MK, *MV, *MO, *MIX, *A2, *Hh;
    float *HF, *HB;
};

__device__ __forceinline__ void gemv_item(Frame& F, const LAS float* a, int R, const float* W, int ldw, int col0, const float* bias, float* out, int ldo, LAS float* red) {
    const int w = F.wave, lane = F.lane, c = lane & 31, kp = lane >> 5;
    float acc[5] = {0.f, 0.f, 0.f, 0.f, 0.f};
    const float* wp = W + (size_t)(128 * w + kp) * ldw + col0 + c;
#pragma unroll 8
    for (int kk = 0; kk < 64; ++kk) {
        const float wv = wp[(size_t)(2 * kk) * ldw];
        const int k = 128 * w + 2 * kk + kp;
#pragma unroll
        for (int r = 0; r < 5; ++r) if (r < R) acc[r] += a[r * 1024 + k] * wv;
    }
#pragma unroll
    for (int r = 0; r < 5; ++r) acc[r] += __shfl_xor(acc[r], 32);
    if (lane < 32) {
#pragma unroll
        for (int r = 0; r < 5; ++r) red[(w * 5 + r) * 32 + lane] = acc[r];
    }
    __syncthreads();
    if (F.tid < R * 32) {
        const int r = F.tid >> 5, cc = F.tid & 31; float s = 0.f;
#pragma unroll
        for (int ww = 0; ww < 8; ++ww) s += red[(ww * 5 + r) * 32 + cc];
        out[(size_t)r * ldo + col0 + cc] = s + (bias ? bias[col0 + cc] : 0.f);
    }
    __syncthreads();
}

__device__ __forceinline__ void p0_transpose_item(const float* W, int K, int ldw, int nblk, bf16* WT, LAS float* scr, int item, int lane) {
    const int kb = item / nblk, nb = item % nblk, k0 = 64 * kb, n0 = 32 * nb;
#pragma unroll 8
    for (int i = 0; i < 32; ++i) { const int kk = 2 * i + (lane >> 5); scr[kk * 33 + (lane & 31)] = W[(size_t)(k0 + kk) * ldw + n0 + (lane & 31)]; }
    asm volatile("s_waitcnt lgkmcnt(0)" ::: "memory");
    const int c = lane & 7;
#pragma unroll
    for (int j = 0; j < 4; ++j) { const int n = (lane >> 3) + 8 * j; const LAS float* s = scr + (8 * c) * 33 + n;
        v4u o; o.x = pk2(s[0 * 33], s[1 * 33]); o.y = pk2(s[2 * 33], s[3 * 33]); o.z = pk2(s[4 * 33], s[5 * 33]); o.w = pk2(s[6 * 33], s[7 * 33]);
        *(v4u*)(WT + (size_t)(n0 + n) * K + k0 + 8 * c) = o; }
    asm volatile("s_waitcnt lgkmcnt(0)" ::: "memory");
}

__device__ __forceinline__ void p0_prologue(Frame& F) {
    LAS float* sa = (LAS float*)F.lds;
    LAS float* red = sa + 5 * 1024;
    for (int i = F.tid; i < 5 * 1024; i += 512) { const int r = i >> 10, k = i & 1023; const float c = r < 4 ? F.in[I_C][r * 1024 + k] : F.in[I_CCTX][k]; sa[i] = c / (1.f + __expf(-c)); }
    __syncthreads();
    for (int item = F.vcu; item < 192; item += F.G) gemv_item(F, sa, 5, F.in[I_WADA], 6 * D, item * 32, F.in[I_BADA], F.mod, 6 * D, red);
    LAS float* scr = (LAS float*)(F.lds + 32768 + F.wave * 8448);
    const int gw = F.vcu * NWAVES + F.wave, NGW = F.G * NWAVES;
    constexpr int I_IN = (D / 64) * (INP / 32), I_O = (D / 64) * (D / 32), I_1 = (D / 64) * (FF / 32), I_2 = (FF / 64) * (D / 32);
    for (int it = gw; it < I_IN + I_O + I_1 + I_2; it += NGW) {
        int r = it;
        if (r < I_IN) { p0_transpose_item(F.in[I_WIN], D, INC, INP / 32, F.WinT, scr, r, F.lane); continue; } r -= I_IN;
        if (r < I_O) { p0_transpose_item(F.in[I_WOUT], D, D, D / 32, F.WoT, scr, r, F.lane); continue; } r -= I_O;
        if (r < I_1) { p0_transpose_item(F.in[I_WFC1], D, FF, FF / 32, F.W1T, scr, r, F.lane); continue; } r -= I_1;
        p0_transpose_item(F.in[I_WFC2], FF, D, D / 32, F.W2T, scr, r, F.lane);
    }
    const int gt = F.vcu * 512 + F.tid, NGT = F.G * 512;
    for (int idx = gt; idx < 192 * 16; idx += NGT) {
        const int p = idx >> 4, j = idx & 15; const int pos = p < 128 ? p : p - 128;
        double inv = 1.0; for (int q = 0; q < j; ++q) inv *= 0.5623413251903491;
        const float ang = (float)pos * (float)inv;
        double a = (double)ang; const double TWO_PI = 6.283185307179586476925;
        const double n = __builtin_rint(a / TWO_PI); a -= n * TWO_PI;
        const double a2 = a * a; double sn = 0.0, cs = 0.0, ts = a, tc = 1.0;
        for (int q = 0; q < 14; ++q) { sn += ts; cs += tc; tc = -tc * a2 / (double)((2 * q + 1) * (2 * q + 2)); ts = -ts * a2 / (double)((2 * q + 2) * (2 * q + 3)); }
        F.rope[idx] = (f32x2){(float)cs, (float)sn};
    }
    for (int idx = gt; idx < 16 * 1024; idx += NGT) { const int g = idx >> 10, k = idx & 1023; F.wgt[idx] = F.in[I_WIN][(size_t)k * INC + INP + g]; }
}

__device__ __forceinline__ float log_sigmoid(float x) { return fminf(x, 0.f) - log1pf(__expf(-fabsf(x))); }
__device__ __forceinline__ void p1_rows(Frame& F) {
    LAS float* wg = (LAS float*)F.lds;
    LAS float* sa = (LAS float*)(F.lds + 65536);
    LAS float* red = (LAS float*)(F.lds + 65536 + 16384);
    for (int i = F.tid; i < 16 * 1024; i += 512) wg[i] = F.wgt[i];
    for (int i = F.tid; i < 4 * 1024; i += 512) sa[i] = F.mod[(i >> 10) * 6 * D + 3 * D + (i & 1023)];
    __syncthreads();
    for (int item = F.vcu; item < 128; item += F.G) gemv_item(F, sa, 4, F.in[I_WFC1], FF, item * 32, nullptr, F.bias1, FF, red);
    const int gw = F.vcu * NWAVES + F.wave, NGW = F.G * NWAVES, lane = F.lane;
    const float* g1n = F.in[I_N1G];
    for (int row = gw; row < MROWS; row += NGW) {
        const bool lat = row < NTOK; const int b5 = lat ? (row >> 13) : 4;
        const float* src = lat ? F.in[I_X] + (size_t)row * D : F.in[I_CTX] + (size_t)(row - NTOK) * D;
        const float* modr = F.mod + (size_t)b5 * 6 * D;
        f32x4 v[4]; float ss = 0.f;
#pragma unroll
        for (int j = 0; j < 4; ++j) { v[j] = *(const f32x4*)(src + 4 * lane + 256 * j); ss += (v[j].x * v[j].x + v[j].y * v[j].y) + (v[j].z * v[j].z + v[j].w * v[j].w); }
        const float rstd = 1.0f / sqrtf(wave_sum(ss) * (1.f / D) + EPS);
        float acc[16]; f32x4 xm[4];
#pragma unroll
        for (int j = 0; j < 4; ++j) {
            const int col = 4 * lane + 256 * j;
            const f32x4 gg = *(const f32x4*)(g1n + col), sc = *(const f32x4*)(modr + D + col), sh = *(const f32x4*)(modr + col);
            xm[j] = (v[j] * rstd) * gg * (sc + 1.0f) + sh;
            v2u o; o.x = pk2(xm[j].x, xm[j].y); o.y = pk2(xm[j].z, xm[j].w);
            *(v2u*)(F.XM + (size_t)row * D + col) = o;
        }
#pragma unroll
        for (int g = 0; g < 16; ++g) {
            float a = 0.f;
#pragma unroll
            for (int j = 0; j < 4; ++j) { const f32x4 w = *(const LAS f32x4*)(wg + g * 1024 + 4 * lane + 256 * j); a += (xm[j].x * w.x + xm[j].y * w.y) + (xm[j].z * w.z + xm[j].w * w.w); }
            acc[g] = a;
            asm volatile("" ::: "memory");
        }
#pragma unroll
        for (int i = 0; i < 8; ++i) { const bool hi = lane & 32; const float mine = hi ? acc[i + 8] : acc[i], send = hi ? acc[i] : acc[i + 8]; acc[i] = mine + __shfl_xor(send, 32); }
#pragma unroll
        for (int i = 0; i < 4; ++i) { const bool hi = lane & 16; const float mine = hi ? acc[i + 4] : acc[i], send = hi ? acc[i] : acc[i + 4]; acc[i] = mine + __shfl_xor(send, 16); }
#pragma unroll
        for (int i = 0; i < 2; ++i) { const bool hi = lane & 8; const float mine = hi ? acc[i + 2] : acc[i], send = hi ? acc[i] : acc[i + 2]; acc[i] = mine + __shfl_xor(send, 8); }
        { const bool hi = lane & 4; const float mine = hi ? acc[1] : acc[0], send = hi ? acc[0] : acc[1]; acc[0] = mine + __shfl_xor(send, 4); }
        acc[0] += __shfl_xor(acc[0], 2); acc[0] += __shfl_xor(acc[0], 1);
        if ((lane & 3) == 0) {
            const int g = ((lane >> 5) & 1) * 8 + ((lane >> 4) & 1) * 4 + ((lane >> 3) & 1) * 2 + ((lane >> 2) & 1);
            const float val = acc[0] + F.in[I_BGATE][g]; const int type = g >> 2, h = g & 3;
            const float o = (type & 1) ? log_sigmoid(val) : val;
            const int b = lat ? (row >> 13) : ((row - NTOK) >> 8), kidx = lat ? (CT + (row & (T - 1))) : ((row - NTOK) & (CT - 1));
            F.gates[((size_t)(b * NH + h) * TK + kidx) * 4 + type] = o;
        }
    }
}

template <class Epi>
__device__ __forceinline__ void naive_gemm(Frame& F, const bf16* A, int lda, int M, const float* W, int ldw, int N, int K, const Epi& E) {
    LAS float* As = (LAS float*)F.lds;
    LAS float* Ws = As + 16 * 132;
    LAS float* Ct = (LAS float*)(F.lds + 32768);
    const int tid = F.tid, ty = tid >> 4, tx = tid & 15;
    const int tn_n = N / 128, ntiles = (M / 128) * tn_n;
    for (int tile = F.vcu; tile < ntiles; tile += F.G) {
        const int tm = tile / tn_n, tn = tile % tn_n;
        float acc[4][8];
#pragma unroll
        for (int i = 0; i < 4; ++i)
#pragma unroll
            for (int j = 0; j < 8; ++j) acc[i][j] = 0.f;
        const int ar = tid >> 2, ak = (tid & 3) * 4, wk = tid >> 5, wn = (tid & 31) * 4;
        const bf16* ap = A + (size_t)(tm * 128 + ar) * lda + ak;
        const float* wp = W + (size_t)wk * ldw + tn * 128 + wn;
        for (int k0 = 0; k0 < K; k0 += 16) {
            const v2u av = *(const v2u*)(ap + k0);
            const f32x4 wv = *(const f32x4*)(wp + (size_t)k0 * ldw);
            As[(ak + 0) * 132 + ar] = bflo(av.x); As[(ak + 1) * 132 + ar] = bfhi(av.x); As[(ak + 2) * 132 + ar] = bflo(av.y); As[(ak + 3) * 132 + ar] = bfhi(av.y);
            *(LAS f32x4*)(Ws + wk * 128 + wn) = wv;
            __syncthreads();
#pragma unroll
            for (int kk = 0; kk < 16; ++kk) {
                const f32x4 a = *(const LAS f32x4*)(As + kk * 132 + ty * 4);
                const f32x4 w0 = *(const LAS f32x4*)(Ws + kk * 128 + tx * 8), w1 = *(const LAS f32x4*)(Ws + kk * 128 + tx * 8 + 4);
                const float aa[4] = {a.x, a.y, a.z, a.w}; const float ww[8] = {w0.x, w0.y, w0.z, w0.w, w1.x, w1.y, w1.z, w1.w};
#pragma unroll
                for (int i = 0; i < 4; ++i)
#pragma unroll
                    for (int j = 0; j < 8; ++j) acc[i][j] += aa[i] * ww[j];
            }
            __syncthreads();
        }
#pragma unroll
        for (int i = 0; i < 4; ++i)
#pragma unroll
            for (int j = 0; j < 8; ++j) Ct[(ty * 4 + i) * 129 + tx * 8 + j] = acc[i][j];
        __syncthreads();
        E.tile(F, Ct, tm * 128, tn * 128);
        __syncthreads();
    }
}

__device__ __forceinline__ void row_decode(int row, bool& lat, int& b, int& t, int& kidx) {
    lat = row < NTOK;
    if (lat) { b = row >> 13; t = row & (T - 1); kidx = CT + t; } else { const int j = row - NTOK; b = j >> 8; t = -1; kidx = j & (CT - 1); }
}

struct NaiveInprojEpi {
    __device__ __forceinline__ void tile(Frame& F, const LAS float* Ct, int row0, int col0) const {
        for (int idx = F.tid; idx < 128 * 128; idx += 512) {
            const int r = idx >> 7, c = idx & 127, row = row0 + r, col = col0 + c;
            bool lat; int b, t, kidx; row_decode(row, lat, b, t, kidx);
            float val = Ct[r * 129 + c];
            if (col < 1024) {
                const bool isq = col < 512; const int cc = col & 511, h = cc >> 7, within = cc & 127, i = within & 63;
                if (isq && !lat) continue;
                if (lat) {
                    const bool lowhalf = (i & 31) < 16; const float partner = Ct[r * 129 + (lowhalf ? c + 16 : c - 16)];
                    const int pos = (i < 32) ? (t >> 6) : (128 + (t & 63)); const f32x2 cs = F.rope[pos * 16 + (i & 15)];
                    val = val * cs.x + (lowhalf ? -partner : partner) * cs.y;
                }
                if (isq) F.Qd[((size_t)(b * NH + h) * T + t) * 128 + within] = (bf16)f2bf(val * C2);
                else F.Kd[((size_t)(b * NH + h) * TK + kidx) * 128 + within] = (bf16)f2bf(val);
            } else if (col < 1536) { const int cc = col - 1024, h = cc >> 7, within = cc & 127; F.Vd[((size_t)(b * NH + h) * TK + kidx) * 128 + within] = (bf16)f2bf(val);
            } else if (col < 1792) { const int cc = col - 1536, h = cc >> 6, i = cc & 63; F.MQ[((size_t)(b * NH + h) * TK + kidx) * 64 + i] = (bf16)f2bf(val);
            } else if (col < 2048) { const int cc = col - 1792, h = cc >> 6, i = cc & 63; F.MK[((size_t)(b * NH + h) * TK + kidx) * 64 + i] = (bf16)f2bf(val * 0.125f);
            } else if (col < 2560) { const int cc = col - 2048, h = cc >> 7, within = cc & 127; F.MV[((size_t)(b * NH + h) * TK + kidx) * 128 + within] = (bf16)f2bf(val);
            } else { if (!lat) continue; F.MO[(size_t)row * 512 + (col - 2560)] = (bf16)f2bf(1.f / (1.f + __expf(-val))); }
        }
    }
};
struct NaiveOutprojEpi {
    __device__ __forceinline__ void tile(Frame& F, const LAS float* Ct, int row0, int col0) const {
        for (int rr = 0; rr < 16; ++rr) {
            const int r = F.wave * 16 + rr, row = row0 + r, b = row >> 13; const float* modr = F.mod + (size_t)b * 6 * D;
            float ss = 0.f;
#pragma unroll
            for (int e = 0; e < 2; ++e) { const int c = F.lane + 64 * e, col = col0 + c;
                const float x1 = F.in[I_X][(size_t)row * D + col] + modr[2 * D + col] * Ct[r * 129 + c];
                F.out[(size_t)row * D + col] = x1; ss += x1 * x1;
                F.A2[(size_t)row * D + col] = (bf16)f2bf(x1 * F.in[I_N2G][col] * (1.f + modr[4 * D + col])); }
            ss = wave_sum(ss); if (F.lane == 0) atomicAdd(F.rowsq1 + row, ss);
        }
    }
};
struct NaiveFc1Epi {
    __device__ __forceinline__ void tile(Frame& F, const LAS float* Ct, int row0, int col0) const {
        for (int idx = F.tid; idx < 128 * 128; idx += 512) {
            const int r = idx >> 7, c = idx & 127, row = row0 + r, col = col0 + c, b = row >> 13;
            const float rstd = 1.0f / sqrtf(F.rowsq1[row] * (1.f / D) + EPS);
            float v = rstd * Ct[r * 129 + c] + F.bias1[b * FF + col]; v = fmaxf(v, 0.f);
            F.Hh[(size_t)row * FF + col] = (bf16)f2bf(v * v);
        }
    }
};
struct NaiveFc2Epi {
    __device__ __forceinline__ void tile(Frame& F, const LAS float* Ct, int row0, int col0) const {
        for (int rr = 0; rr < 16; ++rr) {
            const int r = F.wave * 16 + rr, row = row0 + r, b = row >> 13; const float* modr = F.mod + (size_t)b * 6 * D;
            float ss = 0.f;
#pragma unroll
            for (int e = 0; e < 2; ++e) { const int c = F.lane + 64 * e, col = col0 + c;
                const float x2 = F.out[(size_t)row * D + col] + modr[5 * D + col] * Ct[r * 129 + c];
                F.out[(size_t)row * D + col] = x2; ss += x2 * x2; }
            ss = wave_sum(ss); if (F.lane == 0) atomicAdd(F.rowsq2 + row, ss);
        }
    }
};

__device__ __forceinline__ void naive_mlstm(Frame& F) {
    LAS float* ks = (LAS float*)F.lds;
    LAS float* qs = ks + 64 * 64;
    LAS float* vs = qs + 64 * 64;
    LAS float* fg = vs + 64 * 128;
    LAS float* ig = fg + 64;
    const int tid = F.tid, v = tid >> 2, dq = (tid & 3) * 16;
    for (int item = F.vcu; item < 32; item += F.G) {
        const int bh = item >> 1, dir = item & 1;
        float C[16], n[16];
#pragma unroll
        for (int e = 0; e < 16; ++e) { C[e] = 0.f; n[e] = 0.f; }
        float* Hout = (dir ? F.HB : F.HF) + (size_t)bh * T * 128;
        for (int blk = 0; blk < TK / 64; ++blk) {
            int c;
            if (!dir) c = blk; else c = (blk < 4) ? (3 - blk) : (TK / 64 - 1 - (blk - 4));
            const int kidx0 = c * 64; const bool lat = c >= 4;
            const size_t base64 = ((size_t)bh * TK + kidx0) * 64, base128 = ((size_t)bh * TK + kidx0) * 128;
            for (int i = tid; i < 64 * 64; i += 512) { ks[i] = bf2f(F.MK[base64 + i]); qs[i] = bf2f(F.MQ[base64 + i]); }
            for (int i = tid; i < 64 * 128; i += 512) vs[i] = bf2f(F.MV[base128 + i]);
            if (tid < 64) { const float* g = F.gates + ((size_t)bh * TK + kidx0 + tid) * 4 + dir * 2; ig[tid] = __expf(g[0]); fg[tid] = __expf(g[1]); }
            __syncthreads();
            for (int step = 0; step < 64; ++step) {
                const int s = dir ? 63 - step : step;
                const float f = fg[s], iw = ig[s], vv = vs[s * 128 + v] * iw;
                float num = 0.f, den = 0.f;
#pragma unroll
                for (int e = 0; e < 16; ++e) { const float kk = ks[s * 64 + dq + e], qq = qs[s * 64 + dq + e];
                    C[e] = f * C[e] + vv * kk; n[e] = f * n[e] + iw * kk; num += C[e] * qq; den += n[e] * qq; }
                if (lat) {
                    num += __shfl_xor(num, 1); num += __shfl_xor(num, 2); den += __shfl_xor(den, 1); den += __shfl_xor(den, 2);
                    if ((tid & 3) == 0) Hout[(size_t)(kidx0 - CT + s) * 128 + v] = num / fmaxf(fabsf(den), 1.f);
                }
            }
            __syncthreads();
        }
    }
}
__device__ __forceinline__ void naive_mlstm_combine(Frame& F) {
    const int gw = F.vcu * NWAVES + F.wave, NGW = F.G * NWAVES, lane = F.lane;
    for (int rid = gw; rid < NTOK * NH; rid += NGW) {
        const int row = rid >> 2, h = rid & 3, b = row >> 13, t = row & (T - 1);
        const size_t o = ((size_t)(b * NH + h) * T + t) * 128 + 2 * lane;
        const float a0 = F.HF[o] + F.HB[o], a1 = F.HF[o + 1] + F.HB[o + 1];
        const float r = 1.0f / sqrtf(wave_sum(a0 * a0 + a1 * a1) * (1.f / 128.f) + EPS);
        const float* g = F.in[I_MLNG] + h * 128 + 2 * lane;
        const unsigned mo = *(const unsigned*)(F.MO + (size_t)row * 512 + h * 128 + 2 * lane);
        *(unsigned*)(F.MIX + (size_t)row * D + 512 + h * 128 + 2 * lane) = pk2(a0 * r * g[0] * bflo(mo), a1 * r * g[1] * bfhi(mo));
    }
}

__device__ __forceinline__ void naive_attn(Frame& F) {
    LAS float* qs = (LAS float*)F.lds + F.wave * 64;
    const int gw = F.vcu * NWAVES + F.wave, NGW = F.G * NWAVES, lane = F.lane;
    float lam;
    { const float s1 = wave_sum(F.in[I_LQ1][lane] * F.in[I_LK1][lane]), s2 = wave_sum(F.in[I_LQ2][lane] * F.in[I_LK2][lane]); lam = __expf(s1) - __expf(s2) + LAMBDA_INIT; }
    for (int rid = gw; rid < NB * NH * T; rid += NGW) {
        const int bh = rid >> 13, t = rid & (T - 1), b = bh >> 2, h = bh & 3;
        float o0 = 0.f, o1 = 0.f;
        for (int map = 0; map < 2; ++map) {
            qs[lane] = bf2f(F.Qd[((size_t)bh * T + t) * 128 + map * 64 + lane]);
            asm volatile("s_waitcnt lgkmcnt(0)" ::: "memory");
            float m = -1e30f, l = 0.f, a0 = 0.f, a1 = 0.f;
            for (int ch = 0; ch < TK / 64; ++ch) {
                const bf16* kp = F.Kd + ((size_t)bh * TK + ch * 64 + lane) * 128 + map * 64;
                float s = 0.f;
#pragma unroll
                for (int d8 = 0; d8 < 8; ++d8) { const v4u kv = *(const v4u*)(kp + d8 * 8); const f32x4 qa = *(const LAS f32x4*)(qs + d8 * 8), qb = *(const LAS f32x4*)(qs + d8 * 8 + 4);
                    s += bflo(kv.x) * qa.x + bfhi(kv.x) * qa.y + bflo(kv.y) * qa.z + bfhi(kv.y) * qa.w + bflo(kv.z) * qb.x + bfhi(kv.z) * qb.y + bflo(kv.w) * qb.z + bfhi(kv.w) * qb.w; }
                const float mn = fmaxf(m, wave_max(s)), alpha = exp2f(m - mn), p = exp2f(s - mn);
                l = l * alpha + wave_sum(p); a0 *= alpha; a1 *= alpha; m = mn;
                const bf16* vp = F.Vd + ((size_t)bh * TK + ch * 64) * 128 + 2 * lane;
#pragma unroll 8
                for (int kk = 0; kk < 64; ++kk) { const float pk = __shfl(p, kk); const unsigned vv = *(const unsigned*)(vp + (size_t)kk * 128); a0 += pk * bflo(vv); a1 += pk * bfhi(vv); }
            }
            const float il = 1.f / l;
            if (map == 0) { o0 = a0 * il; o1 = a1 * il; } else { o0 -= lam * a0 * il; o1 -= lam * a1 * il; }
        }
        const float r = 1.0f / sqrtf(wave_sum(o0 * o0 + o1 * o1) * (1.f / 128.f) + EPS);
        const float* g = F.in[I_SUBLN] + 2 * lane;
        *(unsigned*)(F.MIX + (size_t)(b * T + t) * D + h * 128 + 2 * lane) = pk2(o0 * r * g[0] * (1.f - LAMBDA_INIT), o1 * r * g[1] * (1.f - LAMBDA_INIT));
    }
}

__device__ __forceinline__ void p_final(Frame& F) {
    const int gw = F.vcu * NWAVES + F.wave, NGW = F.G * NWAVES, lane = F.lane;
    for (int row = gw; row < NTOK; row += NGW) {
        const float rstd = 1.0f / sqrtf(F.rowsq2[row] * (1.f / D) + EPS);
#pragma unroll
        for (int j = 0; j < 4; ++j) { const int col = 4 * lane + 256 * j; f32x4* p = (f32x4*)(F.out + (size_t)row * D + col);
            const f32x4 g = *(const f32x4*)(F.in[I_FING] + col); *p = (*p * rstd) * g; }
    }
}

constexpr int NPHASE = 9;
__global__ void __launch_bounds__(NWAVES * 64, 2) fwd_kernel(Args args) {
    extern __shared__ __attribute__((aligned(16))) unsigned char lds_raw[];
    Frame F;
    F.lds = (LAS unsigned char*)lds_raw;
    F.tid = threadIdx.x; F.lane = F.tid & 63; F.wave = __builtin_amdgcn_readfirstlane(F.tid >> 6);
    F.G = gridDim.x; { const int bx = blockIdx.x; F.vcu = (F.G % 8 == 0) ? (bx % 8) * (F.G / 8) + bx / 8 : bx; }
#pragma unroll
    for (int i = 0; i < 20; ++i) F.in[i] = args.in[i];
    F.out = args.out; F.ws = args.ws; unsigned char* ws = args.ws;
    F.mod = (float*)(ws + WS_MOD); F.rope = (f32x2*)(ws + WS_ROPE); F.bias1 = (float*)(ws + WS_BIAS1); F.wgt = (float*)(ws + WS_WGT); F.gates = (float*)(ws + WS_G);
    F.rowsq1 = (float*)(ws + WS_ROWSQ1); F.rowsq2 = (float*)(ws + WS_ROWSQ2);
    F.WinT = (bf16*)(ws + WS_WIN); F.WoT = (bf16*)(ws + WS_WO); F.W1T = (bf16*)(ws + WS_W1); F.W2T = (bf16*)(ws + WS_W2);
    F.XM = (bf16*)(ws + WS_XM); F.A2 = (bf16*)(ws + WS_XM);
    F.Qd = (bf16*)(ws + WS_Q); F.Kd = (bf16*)(ws + WS_K); F.Vd = (bf16*)(ws + WS_V); F.MQ = (bf16*)(ws + WS_MQ); F.MK = (bf16*)(ws + WS_MK); F.MV = (bf16*)(ws + WS_MV); F.MO = (bf16*)(ws + WS_MO);
    F.HF = (float*)(ws + WS_DC); F.HB = (float*)(ws + WS_DC + 64 * MiB);
    F.MIX = (bf16*)(ws + WS_CIN);
    F.Hh = (bf16*)(ws + WS_H);
    const int lo = args.ph_lo, hi = args.ph_hi;
#define IN(k) (lo <= (k) && (k) < hi)
    if (IN(0)) p0_prologue(F);
    if (IN(1)) p1_rows(F);
    if (IN(2)) naive_gemm(F, F.XM, D, MROWS, F.in[I_WIN], INC, INP, D, NaiveInprojEpi{});
    if (IN(3)) naive_mlstm(F);
    if (IN(4)) { naive_attn(F); naive_mlstm_combine(F); }
    if (IN(5)) naive_gemm(F, F.MIX, D, NTOK, F.in[I_WOUT], D, D, D, NaiveOutprojEpi{});
    if (IN(6)) naive_gemm(F, F.A2, D, NTOK, F.in[I_WFC1], FF, FF, D, NaiveFc1Epi{});
    if (IN(7)) naive_gemm(F, F.Hh, FF, NTOK, F.in[I_WFC2], D, D, FF, NaiveFc2Epi{});
    if (IN(8)) p_final(F);
#undef IN
}

extern "C" void kernel_launch(void* const* d_in, const int* in_sizes, int n_in, void* d_out, int out_size, void* d_ws, size_t ws_size, hipStream_t stream) {
    static int grid = 0;
    if (grid == 0) {
        if (n_in != 20 || in_sizes[0] != NTOK * D || out_size != NTOK * D || ws_size < WS_END) { fprintf(stderr, "kernel_launch: unexpected shapes n_in %d in0 %d out %d ws %zu\n", n_in, n_in > 0 ? in_sizes[0] : -1, out_size, ws_size); grid = -1; return; }
        int dev = 0, cus = 0, per_cu = 0;
        if (hipGetDevice(&dev) != hipSuccess || hipDeviceGetAttribute(&cus, hipDeviceAttributeMultiprocessorCount, dev) != hipSuccess) { grid = -1; return; }
        if (hipFuncSetAttribute((const void*)fwd_kernel, hipFuncAttributeMaxDynamicSharedMemorySize, LDS_BYTES) != hipSuccess) { fprintf(stderr, "kernel_launch: hipFuncSetAttribute failed\n"); grid = -1; return; }
        if (hipOccupancyMaxActiveBlocksPerMultiprocessor(&per_cu, (const void*)fwd_kernel, NWAVES * 64, LDS_BYTES) != hipSuccess || per_cu < 1) { fprintf(stderr, "kernel_launch: occupancy query says %d\n", per_cu); per_cu = 1; }
        (void)hipGetLastError();
        grid = cus;
    }
    if (grid < 0) return;
    (void)hipMemsetAsync((char*)d_ws + WS_CTL, 0, CTL_ZERO_BYTES, stream);
    Args a{};
    for (int i = 0; i < 20; ++i) a.in[i] = (const float*)d_in[i];
    a.out = (float*)d_out; a.ws = (unsigned char*)d_ws;
    for (int p = 0; p < NPHASE; ++p) {
        a.ph_lo = p; a.ph_hi = p + 1; a.li = 0;
        hipLaunchKernelGGL(fwd_kernel, dim3(grid), dim3(NWAVES * 64), LDS_BYTES, stream, a);
    }
}
```

```cpp
#include <hip/hip_runtime.h>
#include <cstdio>
#include <cstdint>

constexpr int NB = 4, T = 8192, CT = 256, TK = T + CT, D = 1024, FF = 4096, NH = 4;
constexpr int NTOK = NB * T, NCTX = NB * CT, MROWS = NTOK + NCTX;
constexpr int INC = 3088, INP = 3072;
constexpr float EPS = 1e-6f;
constexpr float LAMBDA_INIT = 0.2f;
constexpr float C2 = 0.125f * 1.4426950408889634f;

constexpr size_t MiB = 1u << 20;
constexpr size_t WS_CTL = 0, CTL_ZERO_BYTES = 1 * MiB;
constexpr size_t WS_ROWSQ1 = 256 * 1024, WS_ROWSQ2 = 384 * 1024;
constexpr size_t WS_MOD = 1 * MiB;
constexpr size_t WS_ROPE = WS_MOD + 128 * 1024;
constexpr size_t WS_BIAS1 = WS_ROPE + 32 * 1024;
constexpr size_t WS_WGT = WS_BIAS1 + 64 * 1024;
constexpr size_t WS_WIN = 2 * MiB, WS_WO = 9 * MiB, WS_W1 = 11 * MiB, WS_W2 = 19 * MiB;
constexpr size_t WS_G = 27 * MiB;
constexpr size_t WS_XM = 32 * MiB;
constexpr size_t WS_Q = 98 * MiB, WS_K = 130 * MiB, WS_V = 163 * MiB, WS_MQ = 196 * MiB, WS_MK = 213 * MiB, WS_MV = 230 * MiB, WS_MO = 263 * MiB;
constexpr size_t WS_DC = 296 * MiB;
constexpr size_t WS_CIN = 430 * MiB;
constexpr size_t WS_MIX = 296 * MiB + 0;
constexpr size_t WS_H = 98 * MiB;
constexpr size_t WS_END = 512 * MiB;

typedef unsigned short bf16;
typedef unsigned v4u __attribute__((ext_vector_type(4)));
typedef unsigned v2u __attribute__((ext_vector_type(2)));
typedef float f32x4 __attribute__((ext_vector_type(4)));
typedef float f32x2 __attribute__((ext_vector_type(2)));
#define LAS __attribute__((address_space(3)))

__device__ __forceinline__ unsigned f2bf(float f) { unsigned u = __builtin_bit_cast(unsigned, f); return (u + 0x7fffu + ((u >> 16) & 1u)) >> 16; }
__device__ __forceinline__ unsigned pk2(float lo, float hi) { return f2bf(lo) | (f2bf(hi) << 16); }
__device__ __forceinline__ float bf2f(unsigned short b) { return __builtin_bit_cast(float, (unsigned)b << 16); }
__device__ __forceinline__ float bflo(unsigned w) { return __builtin_bit_cast(float, w << 16); }
__device__ __forceinline__ float bfhi(unsigned w) { return __builtin_bit_cast(float, w & 0xffff0000u); }
__device__ __forceinline__ float wave_sum(float v) {
#pragma unroll
    for (int o = 1; o < 64; o <<= 1) v += __shfl_xor(v, o);
    return v;
}
__device__ __forceinline__ float wave_max(float v) {
#pragma unroll
    for (int o = 1; o < 64; o <<= 1) v = fmaxf(v, __shfl_xor(v, o));
    return v;
}

constexpr int NWAVES = 8;
constexpr int LDS_BYTES = 147456;

struct Args {
    const float* in[20]; float* out; unsigned char* ws; int ph_lo, ph_hi, li, pad;
};
enum { I_X = 0, I_C, I_CTX, I_CCTX, I_WADA, I_BADA, I_N1G, I_N2G, I_WIN, I_BGATE, I_LQ1, I_LK1, I_LQ2, I_LK2, I_SUBLN, I_MLNG, I_WOUT, I_WFC1, I_WFC2, I_FING };

struct Frame {
    LAS unsigned char* lds;
    int tid, lane, wave, vcu, G;
    const float* in[20]; float* out; unsigned char* ws;
    float* mod; f32x2* rope; float* bias1; float* wgt; float* gates; float* rowsq1; float* rowsq2;
    bf16 *WinT, *WoT, *W1T, *W2T, *XM, *Qd, *Kd, *Vd, *MQ, *MK, *MV, *MO, *MIX, *A2, *Hh;
    float *HF, *HB;
};

__device__ __forceinline__ void gemv_item(Frame& F, const LAS float* a, int R, const float* W, int ldw, int col0, const float* bias, float* out, int ldo, LAS float* red) {
    const int w = F.wave, lane = F.lane, c = lane & 31, kp = lane >> 5;
    float acc[5] = {0.f, 0.f, 0.f, 0.f, 0.f};
    const float* wp = W + (size_t)(128 * w + kp) * ldw + col0 + c;
#pragma unroll 8
    for (int kk = 0; kk < 64; ++kk) {
        const float wv = wp[(size_t)(2 * kk) * ldw];
        const int k = 128 * w + 2 * kk + kp;
#pragma unroll
        for (int r = 0; r < 5; ++r) if (r < R) acc[r] += a[r * 1024 + k] * wv;
    }
#pragma unroll
    for (int r = 0; r < 5; ++r) acc[r] += __shfl_xor(acc[r], 32);
    if (lane < 32) {
#pragma unroll
        for (int r = 0; r < 5; ++r) red[(w * 5 + r) * 32 + lane] = acc[r];
    }
    __syncthreads();
    if (F.tid < R * 32) {
        const int r = F.tid >> 5, cc = F.tid & 31; float s = 0.f;
#pragma unroll
        for (int ww = 0; ww < 8; ++ww) s += red[(ww * 5 + r) * 32 + cc];
        out[(size_t)r * ldo + col0 + cc] = s + (bias ? bias[col0 + cc] : 0.f);
    }
    __syncthreads();
}

__device__ __forceinline__ void p0_transpose_item(const float* W, int K, int ldw, int nblk, bf16* WT, LAS float* scr, int item, int lane) {
    const int kb = item / nblk, nb = item % nblk, k0 = 64 * kb, n0 = 32 * nb;
#pragma unroll 8
    for (int i = 0; i < 32; ++i) { const int kk = 2 * i + (lane >> 5); scr[kk * 33 + (lane & 31)] = W[(size_t)(k0 + kk) * ldw + n0 + (lane & 31)]; }
    asm volatile("s_waitcnt lgkmcnt(0)" ::: "memory");
    const int c = lane & 7;
#pragma unroll
    for (int j = 0; j < 4; ++j) { const int n = (lane >> 3) + 8 * j; const LAS float* s = scr + (8 * c) * 33 + n;
        v4u o; o.x = pk2(s[0 * 33], s[1 * 33]); o.y = pk2(s[2 * 33], s[3 * 33]); o.z = pk2(s[4 * 33], s[5 * 33]); o.w = pk2(s[6 * 33], s[7 * 33]);
        *(v4u*)(WT + (size_t)(n0 + n) * K + k0 + 8 * c) = o; }
    asm volatile("s_waitcnt lgkmcnt(0)" ::: "memory");
}

__device__ __forceinline__ void p0_prologue(Frame& F) {
    LAS float* sa = (LAS float*)F.lds;
    LAS float* red = sa + 5 * 1024;
    for (int i = F.tid; i < 5 * 1024; i += 512) { const int r = i >> 10, k = i & 1023; const float c = r < 4 ? F.in[I_C][r * 1024 + k] : F.in[I_CCTX][k]; sa[i] = c / (1.f + __expf(-c)); }
    __syncthreads();
    for (int item = F.vcu; item < 192; item += F.G) gemv_item(F, sa, 5, F.in[I_WADA], 6 * D, item * 32, F.in[I_BADA], F.mod, 6 * D, red);
    LAS float* scr = (LAS float*)(F.lds + 32768 + F.wave * 8448);
    const int gw = F.vcu * NWAVES + F.wave, NGW = F.G * NWAVES;
    constexpr int I_IN = (D / 64) * (INP / 32), I_O = (D / 64) * (D / 32), I_1 = (D / 64) * (FF / 32), I_2 = (FF / 64) * (D / 32);
    for (int it = gw; it < I_IN + I_O + I_1 + I_2; it += NGW) {
        int r = it;
        if (r < I_IN) { p0_transpose_item(F.in[I_WIN], D, INC, INP / 32, F.WinT, scr, r, F.lane); continue; } r -= I_IN;
        if (r < I_O) { p0_transpose_item(F.in[I_WOUT], D, D, D / 32, F.WoT, scr, r, F.lane); continue; } r -= I_O;
        if (r < I_1) { p0_transpose_item(F.in[I_WFC1], D, FF, FF / 32, F.W1T, scr, r, F.lane); continue; } r -= I_1;
        p0_transpose_item(F.in[I_WFC2], FF, D, D / 32, F.W2T, scr, r, F.lane);
    }
    const int gt = F.vcu * 512 + F.tid, NGT = F.G * 512;
    for (int idx = gt; idx < 192 * 16; idx += NGT) {
        const int p = idx >> 4, j = idx & 15; const int pos = p < 128 ? p : p - 128;
        double inv = 1.0; for (int q = 0; q < j; ++q) inv *= 0.5623413251903491;
        const float ang = (float)pos * (float)inv;
        double a = (double)ang; const double TWO_PI = 6.283185307179586476925;
        const double n = __builtin_rint(a / TWO_PI); a -= n * TWO_PI;
        const double a2 = a * a; double sn = 0.0, cs = 0.0, ts = a, tc = 1.0;
        for (int q = 0; q < 14; ++q) { sn += ts; cs += tc; tc = -tc * a2 / (double)((2 * q + 1) * (2 * q + 2)); ts = -ts * a2 / (double)((2 * q + 2) * (2 * q + 3)); }
        F.rope[idx] = (f32x2){(float)cs, (float)sn};
    }
    for (int idx = gt; idx < 16 * 1024; idx += NGT) { const int g = idx >> 10, k = idx & 1023; F.wgt[idx] = F.in[I_WIN][(size_t)k * INC + INP + g]; }
}

__device__ __forceinline__ float log_sigmoid(float x) { return fminf(x, 0.f) - log1pf(__expf(-fabsf(x))); }
__device__ __forceinline__ void p1_rows(Frame& F) {
    LAS float* wg = (LAS float*)F.lds;
    LAS float* sa = (LAS float*)(F.lds + 65536);
    LAS float* red = (LAS float*)(F.lds + 65536 + 16384);
    for (int i = F.tid; i < 16 * 1024; i += 512) wg[i] = F.wgt[i];
    for (int i = F.tid; i < 4 * 1024; i += 512) sa[i] = F.mod[(i >> 10) * 6 * D + 3 * D + (i & 1023)];
    __syncthreads();
    for (int item = F.vcu; item < 128; item += F.G) gemv_item(F, sa, 4, F.in[I_WFC1], FF, item * 32, nullptr, F.bias1, FF, red);
    const int gw = F.vcu * NWAVES + F.wave, NGW = F.G * NWAVES, lane = F.lane;
    const float* g1n = F.in[I_N1G];
    for (int row = gw; row < MROWS; row += NGW) {
        const bool lat = row < NTOK; const int b5 = lat ? (row >> 13) : 4;
        const float* src = lat ? F.in[I_X] + (size_t)row * D : F.in[I_CTX] + (size_t)(row - NTOK) * D;
        const float* modr = F.mod + (size_t)b5 * 6 * D;
        f32x4 v[4]; float ss = 0.f;
#pragma unroll
        for (int j = 0; j < 4; ++j) { v[j] = *(const f32x4*)(src + 4 * lane + 256 * j); ss += (v[j].x * v[j].x + v[j].y * v[j].y) + (v[j].z * v[j].z + v[j].w * v[j].w); }
        const float rstd = 1.0f / sqrtf(wave_sum(ss) * (1.f / D) + EPS);
        float acc[16]; f32x4 xm[4];
#pragma unroll
        for (int j = 0; j < 4; ++j) {
            const int col = 4 * lane + 256 * j;
            const f32x4 gg = *(const f32x4*)(g1n + col), sc = *(const f32x4*)(modr + D + col), sh = *(const f32x4*)(modr + col);
            xm[j] = (v[j] * rstd) * gg * (sc + 1.0f) + sh;
            v2u o; o.x = pk2(xm[j].x, xm[j].y); o.y = pk2(xm[j].z, xm[j].w);
            *(v2u*)(F.XM + (size_t)row * D + col) = o;
        }
#pragma unroll
        for (int g = 0; g < 16; ++g) {
            float a = 0.f;
#pragma unroll
            for (int j = 0; j < 4; ++j) { const f32x4 w = *(const LAS f32x4*)(wg + g * 1024 + 4 * lane + 256 * j); a += (xm[j].x * w.x + xm[j].y * w.y) + (xm[j].z * w.z + xm[j].w * w.w); }
            acc[g] = a;
            asm volatile("" ::: "memory");
        }
#pragma unroll
        for (int i = 0; i < 8; ++i) { const bool hi = lane & 32; const float mine = hi ? acc[i + 8] : acc[i], send = hi ? acc[i] : acc[i + 8]; acc[i] = mine + __shfl_xor(send, 32); }
#pragma unroll
        for (int i = 0; i < 4; ++i) { const bool hi = lane & 16; const float mine = hi ? acc[i + 4] : acc[i], send = hi ? acc[i] : acc[i + 4]; acc[i] = mine + __shfl_xor(send, 16); }
#pragma unroll
        for (int i = 0; i < 2; ++i) { const bool hi = lane & 8; const float mine = hi ? acc[i + 2] : acc[i], send = hi ? acc[i] : acc[i + 2]; acc[i] = mine + __shfl_xor(send, 8); }
        { const bool hi = lane & 4; const float mine = hi ? acc[1] : acc[0], send = hi ? acc[0] : acc[1]; acc[0] = mine + __shfl_xor(send, 4); }
        acc[0] += __shfl_xor(acc[0], 2); acc[0] += __shfl_xor(acc[0], 1);
        if ((lane & 3) == 0) {
            const int g = ((lane >> 5) & 1) * 8 + ((lane >> 4) & 1) * 4 + ((lane >> 3) & 1) * 2 + ((lane >> 2) & 1);
            const float val = acc[0] + F.in[I_BGATE][g]; const int type = g >> 2, h = g & 3;
            const float o = (type & 1) ? log_sigmoid(val) : val;
            const int b = lat ? (row >> 13) : ((row - NTOK) >> 8), kidx = lat ? (CT + (row & (T - 1))) : ((row - NTOK) & (CT - 1));
            F.gates[((size_t)(b * NH + h) * TK + kidx) * 4 + type] = o;
        }
    }
}

template <class Epi>
__device__ __forceinline__ void naive_gemm(Frame& F, const bf16* A, int lda, int M, const float* W, int ldw, int N, int K, const Epi& E) {
    LAS float* As = (LAS float*)F.lds;
    LAS float* Ws = As + 16 * 132;
    LAS float* Ct = (LAS float*)(F.lds + 32768);
    const int tid = F.tid, ty = tid >> 4, tx = tid & 15;
    const int tn_n = N / 128, ntiles = (M / 128) * tn_n;
    for (int tile = F.vcu; tile < ntiles; tile += F.G) {
        const int tm = tile / tn_n, tn = tile % tn_n;
        float acc[4][8];
#pragma unroll
        for (int i = 0; i < 4; ++i)
#pragma unroll
            for (int j = 0; j < 8; ++j) acc[i][j] = 0.f;
        const int ar = tid >> 2, ak = (tid & 3) * 4, wk = tid >> 5, wn = (tid & 31) * 4;
        const bf16* ap = A + (size_t)(tm * 128 + ar) * lda + ak;
        const float* wp = W + (size_t)wk * ldw + tn * 128 + wn;
        for (int k0 = 0; k0 < K; k0 += 16) {
            const v2u av = *(const v2u*)(ap + k0);
            const f32x4 wv = *(const f32x4*)(wp + (size_t)k0 * ldw);
            As[(ak + 0) * 132 + ar] = bflo(av.x); As[(ak + 1) * 132 + ar] = bfhi(av.x); As[(ak + 2) * 132 + ar] = bflo(av.y); As[(ak + 3) * 132 + ar] = bfhi(av.y);
            *(LAS f32x4*)(Ws + wk * 128 + wn) = wv;
            __syncthreads();
#pragma unroll
            for (int kk = 0; kk < 16; ++kk) {
                const f32x4 a = *(const LAS f32x4*)(As + kk * 132 + ty * 4);
                const f32x4 w0 = *(const LAS f32x4*)(Ws + kk * 128 + tx * 8), w1 = *(const LAS f32x4*)(Ws + kk * 128 + tx * 8 + 4);
                const float aa[4] = {a.x, a.y, a.z, a.w}; const float ww[8] = {w0.x, w0.y, w0.z, w0.w, w1.x, w1.y, w1.z, w1.w};
#pragma unroll
                for (int i = 0; i < 4; ++i)
#pragma unroll
                    for (int j = 0; j < 8; ++j) acc[i][j] += aa[i] * ww[j];
            }
            __syncthreads();
        }
#pragma unroll
        for (int i = 0; i < 4; ++i)
#pragma unroll
            for (int j = 0; j < 8; ++j) Ct[(ty * 4 + i) * 129 + tx * 8 + j] = acc[i][j];
        __syncthreads();
        E.tile(F, Ct, tm * 128, tn * 128);
        __syncthreads();
    }
}

__device__ __forceinline__ void row_decode(int row, bool& lat, int& b, int& t, int& kidx) {
    lat = row < NTOK;
    if (lat) { b = row >> 13; t = row & (T - 1); kidx = CT + t; } else { const int j = row - NTOK; b = j >> 8; t = -1; kidx = j & (CT - 1); }
}

struct NaiveInprojEpi {
    __device__ __forceinline__ void tile(Frame& F, const LAS float* Ct, int row0, int col0) const {
        for (int idx = F.tid; idx < 128 * 128; idx += 512) {
            const int r = idx >> 7, c = idx & 127, row = row0 + r, col = col0 + c;
            bool lat; int b, t, kidx; row_decode(row, lat, b, t, kidx);
            float val = Ct[r * 129 + c];
            if (col < 1024) {
                const bool isq = col < 512; const int cc = col & 511, h = cc >> 7, within = cc & 127, i = within & 63;
                if (isq && !lat) continue;
                if (lat) {
                    const bool lowhalf = (i & 31) < 16; const float partner = Ct[r * 129 + (lowhalf ? c + 16 : c - 16)];
                    const int pos = (i < 32) ? (t >> 6) : (128 + (t & 63)); const f32x2 cs = F.rope[pos * 16 + (i & 15)];
                    val = val * cs.x + (lowhalf ? -partner : partner) * cs.y;
                }
                if (isq) F.Qd[((size_t)(b * NH + h) * T + t) * 128 + within] = (bf16)f2bf(val * C2);
                else F.Kd[((size_t)(b * NH + h) * TK + kidx) * 128 + within] = (bf16)f2bf(val);
            } else if (col < 1536) { const int cc = col - 1024, h = cc >> 7, within = cc & 127; F.Vd[((size_t)(b * NH + h) * TK + kidx) * 128 + within] = (bf16)f2bf(val);
            } else if (col < 1792) { const int cc = col - 1536, h = cc >> 6, i = cc & 63; F.MQ[((size_t)(b * NH + h) * TK + kidx) * 64 + i] = (bf16)f2bf(val);
            } else if (col < 2048) { const int cc = col - 1792, h = cc >> 6, i = cc & 63; F.MK[((size_t)(b * NH + h) * TK + kidx) * 64 + i] = (bf16)f2bf(val * 0.125f);
            } else if (col < 2560) { const int cc = col - 2048, h = cc >> 7, within = cc & 127; F.MV[((size_t)(b * NH + h) * TK + kidx) * 128 + within] = (bf16)f2bf(val);
            } else { if (!lat) continue; F.MO[(size_t)row * 512 + (col - 2560)] = (bf16)f2bf(1.f / (1.f + __expf(-val))); }
        }
    }
};
struct NaiveOutprojEpi {
    __device__ __forceinline__ void tile(Frame& F, const LAS float* Ct, int row0, int col0) const {
        for (int rr = 0; rr < 16; ++rr) {
            const int r = F.wave * 16 + rr, row = row0 + r, b = row >> 13; const float* modr = F.mod + (size_t)b * 6 * D;
            float ss = 0.f;
#pragma unroll
            for (int e = 0; e < 2; ++e) { const int c = F.lane + 64 * e, col = col0 + c;
                const float x1 = F.in[I_X][(size_t)row * D + col] + modr[2 * D + col] * Ct[r * 129 + c];
                F.out[(size_t)row * D + col] = x1; ss += x1 * x1;
                F.A2[(size_t)row * D + col] = (bf16)f2bf(x1 * F.in[I_N2G][col] * (1.f + modr[4 * D + col])); }
            ss = wave_sum(ss); if (F.lane == 0) atomicAdd(F.rowsq1 + row, ss);
        }
    }
};
struct NaiveFc1Epi {
    __device__ __forceinline__ void tile(Frame& F, const LAS float* Ct, int row0, int col0) const {
        for (int idx = F.tid; idx < 128 * 128; idx += 512) {
            const int r = idx >> 7, c = idx & 127, row = row0 + r, col = col0 + c, b = row >> 13;
            const float rstd = 1.0f / sqrtf(F.rowsq1[row] * (1.f / D) + EPS);
            float v = rstd * Ct[r * 129 + c] + F.bias1[b * FF + col]; v = fmaxf(v, 0.f);
            F.Hh[(size_t)row * FF + col] = (bf16)f2bf(v * v);
        }
    }
};
struct NaiveFc2Epi {
    __device__ __forceinline__ void tile(Frame& F, const LAS float* Ct, int row0, int col0) const {
        for (int rr = 0; rr < 16; ++rr) {
            const int r = F.wave * 16 + rr, row = row0 + r, b = row >> 13; const float* modr = F.mod + (size_t)b * 6 * D;
            float ss = 0.f;
#pragma unroll
            for (int e = 0; e < 2; ++e) { const int c = F.lane + 64 * e, col = col0 + c;
                const float x2 = F.out[(size_t)row * D + col] + modr[5 * D + col] * Ct[r * 129 + c];
                F.out[(size_t)row * D + col] = x2; ss += x2 * x2; }
            ss = wave_sum(ss); if (F.lane == 0) atomicAdd(F.rowsq2 + row, ss);
        }
    }
};

__device__ __forceinline__ void naive_mlstm(Frame& F) {
    LAS float* ks = (LAS float*)F.lds;
    LAS float* qs = ks + 64 * 64;
    LAS float* vs = qs + 64 * 64;
    LAS float* fg = vs + 64 * 128;
    LAS float* ig = fg + 64;
    const int tid = F.tid, v = tid >> 2, dq = (tid & 3) * 16;
    for (int item = F.vcu; item < 32; item += F.G) {
        const int bh = item >> 1, dir = item & 1;
        float C[16], n[16];
#pragma unroll
        for (int e = 0; e < 16; ++e) { C[e] = 0.f; n[e] = 0.f; }
        float* Hout = (dir ? F.HB : F.HF) + (size_t)bh * T * 128;
        for (int blk = 0; blk < TK / 64; ++blk) {
            int c;
            if (!dir) c = blk; else c = (blk < 4) ? (3 - blk) : (TK / 64 - 1 - (blk - 4));
            const int kidx0 = c * 64; const bool lat = c >= 4;
            const size_t base64 = ((size_t)bh * TK + kidx0) * 64, base128 = ((size_t)bh * TK + kidx0) * 128;
            for (int i = tid; i < 64 * 64; i += 512) { ks[i] = bf2f(F.MK[base64 + i]); qs[i] = bf2f(F.MQ[base64 + i]); }
            for (int i = tid; i < 64 * 128; i += 512) vs[i] = bf2f(F.MV[base128 + i]);
            if (tid < 64) { const float* g = F.gates + ((size_t)bh * TK + kidx0 + tid) * 4 + dir * 2; ig[tid] = __expf(g[0]); fg[tid] = __expf(g[1]); }
            __syncthreads();
            for (int step = 0; step < 64; ++step) {
                const int s = dir ? 63 - step : step;
                const float f = fg[s], iw = ig[s], vv = vs[s * 128 + v] * iw;
                float num = 0.f, den = 0.f;
#pragma unroll
                for (int e = 0; e < 16; ++e) { const float kk = ks[s * 64 + dq + e], qq = qs[s * 64 + dq + e];
                    C[e] = f * C[e] + vv * kk; n[e] = f * n[e] + iw * kk; num += C[e] * qq; den += n[e] * qq; }
                if (lat) {
                    num += __shfl_xor(num, 1); num += __shfl_xor(num, 2); den += __shfl_xor(den, 1); den += __shfl_xor(den, 2);
                    if ((tid & 3) == 0) Hout[(size_t)(kidx0 - CT + s) * 128 + v] = num / fmaxf(fabsf(den), 1.f);
                }
            }
            __syncthreads();
        }
    }
}
__device__ __forceinline__ void naive_mlstm_combine(Frame& F) {
    const int gw = F.vcu * NWAVES + F.wave, NGW = F.G * NWAVES, lane = F.lane;
    for (int rid = gw; rid < NTOK * NH; rid += NGW) {
        const int row = rid >> 2, h = rid & 3, b = row >> 13, t = row & (T - 1);
        const size_t o = ((size_t)(b * NH + h) * T + t) * 128 + 2 * lane;
        const float a0 = F.HF[o] + F.HB[o], a1 = F.HF[o + 1] + F.HB[o + 1];
        const float r = 1.0f / sqrtf(wave_sum(a0 * a0 + a1 * a1) * (1.f / 128.f) + EPS);
        const float* g = F.in[I_MLNG] + h * 128 + 2 * lane;
        const unsigned mo = *(const unsigned*)(F.MO + (size_t)row * 512 + h * 128 + 2 * lane);
        *(unsigned*)(F.MIX + (size_t)row * D + 512 + h * 128 + 2 * lane) = pk2(a0 * r * g[0] * bflo(mo), a1 * r * g[1] * bfhi(mo));
    }
}

__device__ __forceinline__ void naive_attn(Frame& F) {
    LAS float* qs = (LAS float*)F.lds + F.wave * 64;
    const int gw = F.vcu * NWAVES + F.wave, NGW = F.G * NWAVES, lane = F.lane;
    float lam;
    { const float s1 = wave_sum(F.in[I_LQ1][lane] * F.in[I_LK1][lane]), s2 = wave_sum(F.in[I_LQ2][lane] * F.in[I_LK2][lane]); lam = __expf(s1) - __expf(s2) + LAMBDA_INIT; }
    for (int rid = gw; rid < NB * NH * T; rid += NGW) {
        const int bh = rid >> 13, t = rid & (T - 1), b = bh >> 2, h = bh & 3;
        float o0 = 0.f, o1 = 0.f;
        for (int map = 0; map < 2; ++map) {
            qs[lane] = bf2f(F.Qd[((size_t)bh * T + t) * 128 + map * 64 + lane]);
            asm volatile("s_waitcnt lgkmcnt(0)" ::: "memory");
            float m = -1e30f, l = 0.f, a0 = 0.f, a1 = 0.f;
            for (int ch = 0; ch < TK / 64; ++ch) {
                const bf16* kp = F.Kd + ((size_t)bh * TK + ch * 64 + lane) * 128 + map * 64;
                float s = 0.f;
#pragma unroll
                for (int d8 = 0; d8 < 8; ++d8) { const v4u kv = *(const v4u*)(kp + d8 * 8); const f32x4 qa = *(const LAS f32x4*)(qs + d8 * 8), qb = *(const LAS f32x4*)(qs + d8 * 8 + 4);
                    s += bflo(kv.x) * qa.x + bfhi(kv.x) * qa.y + bflo(kv.y) * qa.z + bfhi(kv.y) * qa.w + bflo(kv.z) * qb.x + bfhi(kv.z) * qb.y + bflo(kv.w) * qb.z + bfhi(kv.w) * qb.w; }
                const float mn = fmaxf(m, wave_max(s)), alpha = exp2f(m - mn), p = exp2f(s - mn);
                l = l * alpha + wave_sum(p); a0 *= alpha; a1 *= alpha; m = mn;
                const bf16* vp = F.Vd + ((size_t)bh * TK + ch * 64) * 128 + 2 * lane;
#pragma unroll 8
                for (int kk = 0; kk < 64; ++kk) { const float pk = __shfl(p, kk); const unsigned vv = *(const unsigned*)(vp + (size_t)kk * 128); a0 += pk * bflo(vv); a1 += pk * bfhi(vv); }
            }
            const float il = 1.f / l;
            if (map == 0) { o0 = a0 * il; o1 = a1 * il; } else { o0 -= lam * a0 * il; o1 -= lam * a1 * il; }
        }
        const float r = 1.0f / sqrtf(wave_sum(o0 * o0 + o1 * o1) * (1.f / 128.f) + EPS);
        const float* g = F.in[I_SUBLN] + 2 * lane;
        *(unsigned*)(F.MIX + (size_t)(b * T + t) * D + h * 128 + 2 * lane) = pk2(o0 * r * g[0] * (1.f - LAMBDA_INIT), o1 * r * g[1] * (1.f - LAMBDA_INIT));
    }
}

__device__ __forceinline__ void p_final(Frame& F) {
    const int gw = F.vcu * NWAVES + F.wave, NGW = F.G * NWAVES, lane = F.lane;
    for (int row = gw; row < NTOK; row += NGW) {
        const float rstd = 1.0f / sqrtf(F.rowsq2[row] * (1.f / D) + EPS);
#pragma unroll
        for (int j = 0; j < 4; ++j) { const int col = 4 * lane + 256 * j; f32x4* p = (f32x4*)(F.out + (size_t)row * D + col);
            const f32x4 g = *(const f32x4*)(F.in[I_FING] + col); *p = (*p * rstd) * g; }
    }
}


#define XB_TMO      128
#define XB_XCNT(j)  (256  + 64 * (j))
#define XB_XSUB(j)  (1280 + 64 * (j))
#define XB_XGEN(j)  (2304 + 64 * (j))
#define XB_TOP      3328
#define XB_TOPGEN   3392
#define XCD_BAR_WORDS 3456
#define XB_SPIN_CAP (1u << 22)
constexpr int CW_BAR = 4096;
constexpr int MISC_OFF = 131072 + 320;
__device__ __forceinline__ unsigned xb_ld(unsigned* p)              { return __hip_atomic_load(p, __ATOMIC_RELAXED, __HIP_MEMORY_SCOPE_AGENT); }
__device__ __forceinline__ unsigned xb_add(unsigned* p, unsigned v) { return __hip_atomic_fetch_add(p, v, __ATOMIC_RELAXED, __HIP_MEMORY_SCOPE_AGENT); }
__device__ __forceinline__ unsigned xb_xcc_id() { return (unsigned)__builtin_amdgcn_s_getreg((3 << 11) | 20) & 0xFu; }
#define XB_SPIN(cond, bar) do { unsigned _sp = 0; while (cond) { __builtin_amdgcn_s_sleep(1); \
    if ((++_sp & 255u) == 0u) { if (xb_ld(&(bar)[XB_TMO])) break; if (_sp > XB_SPIN_CAP) { atomicAdd(&(bar)[XB_TMO], 1u); break; } } } } while (0)
struct XcdBarrier { unsigned* bar; unsigned x; volatile LAS unsigned* st; };
__device__ __forceinline__ XcdBarrier xcd_barrier_post(unsigned* bar, volatile LAS unsigned* st) {
    XcdBarrier b; b.bar = bar; b.x = xb_xcc_id(); b.st = st;
    if (threadIdx.x == 0) (void)xb_add(&bar[XB_XCNT(b.x)], 1u);
    return b;
}
__device__ __forceinline__ void xcd_barrier_complete(unsigned* bar, unsigned x, unsigned& nloc, unsigned& nx) {
    const unsigned G = gridDim.x * gridDim.y * gridDim.z;
    unsigned sum, cnt, mine, sp = 0u;
    for (;;) {
        sum = 0u; cnt = 0u; mine = 0u;
#pragma unroll
        for (unsigned j = 0; j < 16; ++j) { const unsigned c = xb_ld(&bar[XB_XCNT(j)]); sum += c; cnt += (c > 0u) ? 1u : 0u; mine = (j == x) ? c : mine; }
        if (sum == G) break;
        __builtin_amdgcn_s_sleep(1);
        if ((++sp & 255u) == 0u) { if (xb_ld(&bar[XB_TMO])) break; if (sp > XB_SPIN_CAP) { atomicAdd(&bar[XB_TMO], 1u); break; } }
    }
    nloc = mine > 0u ? mine : 1u; nx = cnt > 0u ? cnt : 1u;
}
__device__ __forceinline__ void xcd_barrier(const XcdBarrier& b) {
    asm volatile("s_waitcnt vmcnt(0)" ::: "memory");
    __syncthreads();
    if (threadIdx.x == 0) {
        unsigned* bar = b.bar;
        __builtin_amdgcn_s_waitcnt(0);
        unsigned nloc = b.st[0], nx = b.st[1];
        if (nloc == 0u) { xcd_barrier_complete(bar, b.x, nloc, nx); b.st[0] = nloc; b.st[1] = nx; }
        const unsigned old = xb_add(&bar[XB_XSUB(b.x)], 1u);
        const unsigned gen = old / nloc;
        if (old + 1u == (gen + 1u) * nloc) {
            __builtin_amdgcn_fence(__ATOMIC_RELEASE, "agent");
            asm volatile("s_waitcnt vmcnt(0)" ::: "memory");
            const unsigned og = xb_add(&bar[XB_TOP], 1u);
            const unsigned tg = og / nx;
            if (og + 1u == (tg + 1u) * nx) xb_add(&bar[XB_TOPGEN], 1u);
            else XB_SPIN(xb_ld(&bar[XB_TOPGEN]) == tg, bar);
            __builtin_amdgcn_fence(__ATOMIC_ACQUIRE, "agent");
            xb_add(&bar[XB_XGEN(b.x)], 1u);
            asm volatile("s_waitcnt vmcnt(0)" ::: "memory");
        } else {
            XB_SPIN(xb_ld(&bar[XB_XGEN(b.x)]) == gen, bar);
            __builtin_amdgcn_fence(__ATOMIC_ACQUIRE, "agent");
            asm volatile("s_waitcnt vmcnt(0)" ::: "memory");
        }
    }
    __syncthreads();
}

constexpr int NPHASE = 9;
__global__ void __launch_bounds__(NWAVES * 64, 2) fwd_kernel(Args args) {
    extern __shared__ __attribute__((aligned(16))) unsigned char lds_raw[];
    Frame F;
    F.lds = (LAS unsigned char*)lds_raw;
    F.tid = threadIdx.x; F.lane = F.tid & 63; F.wave = __builtin_amdgcn_readfirstlane(F.tid >> 6);
    F.G = gridDim.x; { const int bx = blockIdx.x; F.vcu = (F.G % 8 == 0) ? (bx % 8) * (F.G / 8) + bx / 8 : bx; }
#pragma unroll
    for (int i = 0; i < 20; ++i) F.in[i] = args.in[i];
    F.out = args.out; F.ws = args.ws; unsigned char* ws = args.ws;
    F.mod = (float*)(ws + WS_MOD); F.rope = (f32x2*)(ws + WS_ROPE); F.bias1 = (float*)(ws + WS_BIAS1); F.wgt = (float*)(ws + WS_WGT); F.gates = (float*)(ws + WS_G);
    F.rowsq1 = (float*)(ws + WS_ROWSQ1); F.rowsq2 = (float*)(ws + WS_ROWSQ2);
    F.WinT = (bf16*)(ws + WS_WIN); F.WoT = (bf16*)(ws + WS_WO); F.W1T = (bf16*)(ws + WS_W1); F.W2T = (bf16*)(ws + WS_W2);
    F.XM = (bf16*)(ws + WS_XM); F.A2 = (bf16*)(ws + WS_XM);
    F.Qd = (bf16*)(ws + WS_Q); F.Kd = (bf16*)(ws + WS_K); F.Vd = (bf16*)(ws + WS_V); F.MQ = (bf16*)(ws + WS_MQ); F.MK = (bf16*)(ws + WS_MK); F.MV = (bf16*)(ws + WS_MV); F.MO = (bf16*)(ws + WS_MO);
    F.HF = (float*)(ws + WS_DC); F.HB = (float*)(ws + WS_DC + 64 * MiB);
    F.MIX = (bf16*)(ws + WS_CIN);
    F.Hh = (bf16*)(ws + WS_H);
    const int lo = args.ph_lo, hi = args.ph_hi;
    for (int u = F.tid; u < (LDS_BYTES - 131072) / 4; u += NWAVES * 64) ((LAS unsigned*)(F.lds + 131072))[u] = 0u;
    __syncthreads();
    XcdBarrier bar = xcd_barrier_post((unsigned*)(ws + WS_CTL) + CW_BAR + args.li * XCD_BAR_WORDS, (volatile LAS unsigned*)(F.lds + MISC_OFF));
#define IN(k) (lo <= (k) && (k) < hi)
#define SEAM(k) do { if (IN(k) && IN((k) + 1)) xcd_barrier(bar); } while (0)
    if (IN(0)) p0_prologue(F);
    SEAM(0);
    if (IN(1)) p1_rows(F);
    SEAM(1);
    if (IN(2)) naive_gemm(F, F.XM, D, MROWS, F.in[I_WIN], INC, INP, D, NaiveInprojEpi{});
    SEAM(2);
    if (IN(3)) naive_mlstm(F);
    SEAM(3);
    if (IN(4)) { naive_attn(F); naive_mlstm_combine(F); }
    SEAM(4);
    if (IN(5)) naive_gemm(F, F.MIX, D, NTOK, F.in[I_WOUT], D, D, D, NaiveOutprojEpi{});
    SEAM(5);
    if (IN(6)) naive_gemm(F, F.A2, D, NTOK, F.in[I_WFC1], FF, FF, D, NaiveFc1Epi{});
    SEAM(6);
    if (IN(7)) naive_gemm(F, F.Hh, FF, NTOK, F.in[I_WFC2], D, D, FF, NaiveFc2Epi{});
    SEAM(7);
    if (IN(8)) p_final(F);
#undef IN
#undef SEAM
}

extern "C" void kernel_launch(void* const* d_in, const int* in_sizes, int n_in, void* d_out, int out_size, void* d_ws, size_t ws_size, hipStream_t stream) {
    static int grid = 0;
    if (grid == 0) {
        if (n_in != 20 || in_sizes[0] != NTOK * D || out_size != NTOK * D || ws_size < WS_END) { fprintf(stderr, "kernel_launch: unexpected shapes n_in %d in0 %d out %d ws %zu\n", n_in, n_in > 0 ? in_sizes[0] : -1, out_size, ws_size); grid = -1; return; }
        int dev = 0, cus = 0, per_cu = 0;
        if (hipGetDevice(&dev) != hipSuccess || hipDeviceGetAttribute(&cus, hipDeviceAttributeMultiprocessorCount, dev) != hipSuccess) { grid = -1; return; }
        if (hipFuncSetAttribute((const void*)fwd_kernel, hipFuncAttributeMaxDynamicSharedMemorySize, LDS_BYTES) != hipSuccess) { fprintf(stderr, "kernel_launch: hipFuncSetAttribute failed\n"); grid = -1; return; }
        if (hipOccupancyMaxActiveBlocksPerMultiprocessor(&per_cu, (const void*)fwd_kernel, NWAVES * 64, LDS_BYTES) != hipSuccess || per_cu < 1) { fprintf(stderr, "kernel_launch: occupancy query says %d\n", per_cu); per_cu = 1; }
        (void)hipGetLastError();
        grid = cus;
    }
    if (grid < 0) return;
    (void)hipMemsetAsync((char*)d_ws + WS_CTL, 0, CTL_ZERO_BYTES, stream);
    Args a{};
    for (int i = 0; i < 20; ++i) a.in[i] = (const float*)d_in[i];
    a.out = (float*)d_out; a.ws = (unsigned char*)d_ws;
    a.ph_lo = 0; a.ph_hi = NPHASE; a.li = 0;
    hipLaunchKernelGGL(fwd_kernel, dim3(grid), dim3(NWAVES * 64), LDS_BYTES, stream, a);
}
```

```cpp
#include <hip/hip_runtime.h>
#include <cstdio>
#include <cstdint>

constexpr int NB = 4, T = 8192, CT = 256, TK = T + CT, D = 1024, FF = 4096, NH = 4;
constexpr int NTOK = NB * T, NCTX = NB * CT, MROWS = NTOK + NCTX;
constexpr int INC = 3088, INP = 3072;
constexpr float EPS = 1e-6f;
constexpr float LAMBDA_INIT = 0.2f;
constexpr float C2 = 0.125f * 1.4426950408889634f;

constexpr size_t MiB = 1u << 20;
constexpr size_t WS_CTL = 0, CTL_ZERO_BYTES = 1 * MiB;
constexpr size_t WS_ROWSQ1 = 256 * 1024, WS_ROWSQ2 = 384 * 1024;
constexpr size_t WS_MOD = 1 * MiB;
constexpr size_t WS_ROPE = WS_MOD + 128 * 1024;
constexpr size_t WS_BIAS1 = WS_ROPE + 32 * 1024;
constexpr size_t WS_WGT = WS_BIAS1 + 64 * 1024;
constexpr size_t WS_WIN = 2 * MiB, WS_WO = 9 * MiB, WS_W1 = 11 * MiB, WS_W2 = 19 * MiB;
constexpr size_t WS_G = 27 * MiB;
constexpr size_t WS_XM = 32 * MiB;
constexpr size_t WS_Q = 98 * MiB, WS_K = 130 * MiB, WS_V = 163 * MiB, WS_MQ = 196 * MiB, WS_MK = 213 * MiB, WS_MV = 230 * MiB, WS_MO = 263 * MiB;
constexpr size_t WS_DC = 296 * MiB;
constexpr size_t WS_CIN = 430 * MiB;
constexpr size_t WS_MIX = 296 * MiB + 0;
constexpr size_t WS_H = 98 * MiB;
constexpr size_t WS_END = 512 * MiB;

typedef unsigned short bf16;
typedef unsigned v4u __attribute__((ext_vector_type(4)));
typedef unsigned v2u __attribute__((ext_vector_type(2)));
typedef float f32x4 __attribute__((ext_vector_type(4)));
typedef float f32x2 __attribute__((ext_vector_type(2)));
#define LAS __attribute__((address_space(3)))

__device__ __forceinline__ unsigned f2bf(float f) { unsigned u = __builtin_bit_cast(unsigned, f); return (u + 0x7fffu + ((u >> 16) & 1u)) >> 16; }
__device__ __forceinline__ unsigned pk2(float lo, float hi) { return f2bf(lo) | (f2bf(hi) << 16); }
__device__ __forceinline__ float bf2f(unsigned short b) { return __builtin_bit_cast(float, (unsigned)b << 16); }
__device__ __forceinline__ float bflo(unsigned w) { return __builtin_bit_cast(float, w << 16); }
__device__ __forceinline__ float bfhi(unsigned w) { return __builtin_bit_cast(float, w & 0xffff0000u); }
__device__ __forceinline__ float wave_sum(float v) {
#pragma unroll
    for (int o = 1; o < 64; o <<= 1) v += __shfl_xor(v, o);
    return v;
}
__device__ __forceinline__ float wave_max(float v) {
#pragma unroll
    for (int o = 1; o < 64; o <<= 1) v = fmaxf(v, __shfl_xor(v, o));
    return v;
}

#ifndef FAST_GEMM
#define FAST_GEMM 15
#endif
constexpr int NWAVES = 8;
constexpr int LDS_BYTES = 147456;

struct Args {
    const float* in[20]; float* out; unsigned char* ws; int ph_lo, ph_hi, li, pad;
};
enum { I_X = 0, I_C, I_CTX, I_CCTX, I_WADA, I_BADA, I_N1G, I_N2G, I_WIN, I_BGATE, I_LQ1, I_LK1, I_LQ2, I_LK2, I_SUBLN, I_MLNG, I_WOUT, I_WFC1, I_WFC2, I_FING };

struct Frame {
    LAS unsigned char* lds;
    int tid, lane, wave, vcu, G;
    const float* in[20]; float* out; unsigned char* ws;
    float* mod; f32x2* rope; float* bias1; float* wgt; float* gates; float* rowsq1; float* rowsq2;
    bf16 *WinT, *WoT, *W1T, *W2T, *XM, *Qd, *Kd, *Vd, *MQ, *MK, *MV, *MO, *MIX, *A2, *Hh;
    float *HF, *HB;
};

__device__ __forceinline__ void gemv_item(Frame& F, const LAS float* a, int R, const float* W, int ldw, int col0, const float* bias, float* out, int ldo, LAS float* red) {
    const int w = F.wave, lane = F.lane, c = lane & 31, kp = lane >> 5;
    float acc[5] = {0.f, 0.f, 0.f, 0.f, 0.f};
    const float* wp = W + (size_t)(128 * w + kp) * ldw + col0 + c;
#pragma unroll 8
    for (int kk = 0; kk < 64; ++kk) {
        const float wv = wp[(size_t)(2 * kk) * ldw];
        const int k = 128 * w + 2 * kk + kp;
#pragma unroll
        for (int r = 0; r < 5; ++r) if (r < R) acc[r] += a[r * 1024 + k] * wv;
    }
#pragma unroll
    for (int r = 0; r < 5; ++r) acc[r] += __shfl_xor(acc[r], 32);
    if (lane < 32) {
#pragma unroll
        for (int r = 0; r < 5; ++r) red[(w * 5 + r) * 32 + lane] = acc[r];
    }
    __syncthreads();
    if (F.tid < R * 32) {
        const int r = F.tid >> 5, cc = F.tid & 31; float s = 0.f;
#pragma unroll
        for (int ww = 0; ww < 8; ++ww) s += red[(ww * 5 + r) * 32 + cc];
        out[(size_t)r * ldo + col0 + cc] = s + (bias ? bias[col0 + cc] : 0.f);
    }
    __syncthreads();
}

__device__ __forceinline__ void p0_transpose_item(const float* W, int K, int ldw, int nblk, bf16* WT, LAS float* scr, int item, int lane) {
    const int kb = item / nblk, nb = item % nblk, k0 = 64 * kb, n0 = 32 * nb;
#pragma unroll 8
    for (int i = 0; i < 32; ++i) { const int kk = 2 * i + (lane >> 5); scr[kk * 33 + (lane & 31)] = W[(size_t)(k0 + kk) * ldw + n0 + (lane & 31)]; }
    asm volatile("s_waitcnt lgkmcnt(0)" ::: "memory");
    const int c = lane & 7;
#pragma unroll
    for (int j = 0; j < 4; ++j) { const int n = (lane >> 3) + 8 * j; const LAS float* s = scr + (8 * c) * 33 + n;
        v4u o; o.x = pk2(s[0 * 33], s[1 * 33]); o.y = pk2(s[2 * 33], s[3 * 33]); o.z = pk2(s[4 * 33], s[5 * 33]); o.w = pk2(s[6 * 33], s[7 * 33]);
        *(v4u*)(WT + (size_t)(n0 + n) * K + k0 + 8 * c) = o; }
    asm volatile("s_waitcnt lgkmcnt(0)" ::: "memory");
}

__device__ __forceinline__ void p0_prologue(Frame& F) {
    LAS float* sa = (LAS float*)F.lds;
    LAS float* red = sa + 5 * 1024;
    for (int i = F.tid; i < 5 * 1024; i += 512) { const int r = i >> 10, k = i & 1023; const float c = r < 4 ? F.in[I_C][r * 1024 + k] : F.in[I_CCTX][k]; sa[i] = c / (1.f + __expf(-c)); }
    __syncthreads();
    for (int item = F.vcu; item < 192; item += F.G) gemv_item(F, sa, 5, F.in[I_WADA], 6 * D, item * 32, F.in[I_BADA], F.mod, 6 * D, red);
    LAS float* scr = (LAS float*)(F.lds + 32768 + F.wave * 8448);
    const int gw = F.vcu * NWAVES + F.wave, NGW = F.G * NWAVES;
    constexpr int I_IN = (D / 64) * (INP / 32), I_O = (D / 64) * (D / 32), I_1 = (D / 64) * (FF / 32), I_2 = (FF / 64) * (D / 32);
    for (int it = gw; it < I_IN + I_O + I_1 + I_2; it += NGW) {
        int r = it;
        if (r < I_IN) { p0_transpose_item(F.in[I_WIN], D, INC, INP / 32, F.WinT, scr, r, F.lane); continue; } r -= I_IN;
        if (r < I_O) { p0_transpose_item(F.in[I_WOUT], D, D, D / 32, F.WoT, scr, r, F.lane); continue; } r -= I_O;
        if (r < I_1) { p0_transpose_item(F.in[I_WFC1], D, FF, FF / 32, F.W1T, scr, r, F.lane); continue; } r -= I_1;
        p0_transpose_item(F.in[I_WFC2], FF, D, D / 32, F.W2T, scr, r, F.lane);
    }
    const int gt = F.vcu * 512 + F.tid, NGT = F.G * 512;
    for (int idx = gt; idx < 192 * 16; idx += NGT) {
        const int p = idx >> 4, j = idx & 15; const int pos = p < 128 ? p : p - 128;
        double inv = 1.0; for (int q = 0; q < j; ++q) inv *= 0.5623413251903491;
        const float ang = (float)pos * (float)inv;
        double a = (double)ang; const double TWO_PI = 6.283185307179586476925;
        const double n = __builtin_rint(a / TWO_PI); a -= n * TWO_PI;
        const double a2 = a * a; double sn = 0.0, cs = 0.0, ts = a, tc = 1.0;
        for (int q = 0; q < 14; ++q) { sn += ts; cs += tc; tc = -tc * a2 / (double)((2 * q + 1) * (2 * q + 2)); ts = -ts * a2 / (double)((2 * q + 2) * (2 * q + 3)); }
        F.rope[idx] = (f32x2){(float)cs, (float)sn};
    }
    for (int idx = gt; idx < 16 * 1024; idx += NGT) { const int g = idx >> 10, k = idx & 1023; F.wgt[idx] = F.in[I_WIN][(size_t)k * INC + INP + g]; }
}

__device__ __forceinline__ float log_sigmoid(float x) { return fminf(x, 0.f) - log1pf(__expf(-fabsf(x))); }
__device__ __forceinline__ void p1_rows(Frame& F) {
    LAS float* wg = (LAS float*)F.lds;
    LAS float* sa = (LAS float*)(F.lds + 65536);
    LAS float* red = (LAS float*)(F.lds + 65536 + 16384);
    for (int i = F.tid; i < 16 * 1024; i += 512) wg[i] = F.wgt[i];
    for (int i = F.tid; i < 4 * 1024; i += 512) sa[i] = F.mod[(i >> 10) * 6 * D + 3 * D + (i & 1023)];
    __syncthreads();
    for (int item = F.vcu; item < 128; item += F.G) gemv_item(F, sa, 4, F.in[I_WFC1], FF, item * 32, nullptr, F.bias1, FF, red);
    const int gw = F.vcu * NWAVES + F.wave, NGW = F.G * NWAVES, lane = F.lane;
    const float* g1n = F.in[I_N1G];
    for (int row = gw; row < MROWS; row += NGW) {
        const bool lat = row < NTOK; const int b5 = lat ? (row >> 13) : 4;
        const float* src = lat ? F.in[I_X] + (size_t)row * D : F.in[I_CTX] + (size_t)(row - NTOK) * D;
        const float* modr = F.mod + (size_t)b5 * 6 * D;
        f32x4 v[4]; float ss = 0.f;
#pragma unroll
        for (int j = 0; j < 4; ++j) { v[j] = *(const f32x4*)(src + 4 * lane + 256 * j); ss += (v[j].x * v[j].x + v[j].y * v[j].y) + (v[j].z * v[j].z + v[j].w * v[j].w); }
        const float rstd = 1.0f / sqrtf(wave_sum(ss) * (1.f / D) + EPS);
        float acc[16]; f32x4 xm[4];
#pragma unroll
        for (int j = 0; j < 4; ++j) {
            const int col = 4 * lane + 256 * j;
            const f32x4 gg = *(const f32x4*)(g1n + col), sc = *(const f32x4*)(modr + D + col), sh = *(const f32x4*)(modr + col);
            xm[j] = (v[j] * rstd) * gg * (sc + 1.0f) + sh;
            v2u o; o.x = pk2(xm[j].x, xm[j].y); o.y = pk2(xm[j].z, xm[j].w);
            *(v2u*)(F.XM + (size_t)row * D + col) = o;
        }
#pragma unroll
        for (int g = 0; g < 16; ++g) {
            float a = 0.f;
#pragma unroll
            for (int j = 0; j < 4; ++j) { const f32x4 w = *(const LAS f32x4*)(wg + g * 1024 + 4 * lane + 256 * j); a += (xm[j].x * w.x + xm[j].y * w.y) + (xm[j].z * w.z + xm[j].w * w.w); }
            acc[g] = a;
            asm volatile("" ::: "memory");
        }
#pragma unroll
        for (int i = 0; i < 8; ++i) { const bool hi = lane & 32; const float mine = hi ? acc[i + 8] : acc[i], send = hi ? acc[i] : acc[i + 8]; acc[i] = mine + __shfl_xor(send, 32); }
#pragma unroll
        for (int i = 0; i < 4; ++i) { const bool hi = lane & 16; const float mine = hi ? acc[i + 4] : acc[i], send = hi ? acc[i] : acc[i + 4]; acc[i] = mine + __shfl_xor(send, 16); }
#pragma unroll
        for (int i = 0; i < 2; ++i) { const bool hi = lane & 8; const float mine = hi ? acc[i + 2] : acc[i], send = hi ? acc[i] : acc[i + 2]; acc[i] = mine + __shfl_xor(send, 8); }
        { const bool hi = lane & 4; const float mine = hi ? acc[1] : acc[0], send = hi ? acc[0] : acc[1]; acc[0] = mine + __shfl_xor(send, 4); }
        acc[0] += __shfl_xor(acc[0], 2); acc[0] += __shfl_xor(acc[0], 1);
        if ((lane & 3) == 0) {
            const int g = ((lane >> 5) & 1) * 8 + ((lane >> 4) & 1) * 4 + ((lane >> 3) & 1) * 2 + ((lane >> 2) & 1);
            const float val = acc[0] + F.in[I_BGATE][g]; const int type = g >> 2, h = g & 3;
            const float o = (type & 1) ? log_sigmoid(val) : val;
            const int b = lat ? (row >> 13) : ((row - NTOK) >> 8), kidx = lat ? (CT + (row & (T - 1))) : ((row - NTOK) & (CT - 1));
            F.gates[((size_t)(b * NH + h) * TK + kidx) * 4 + type] = o;
        }
    }
}

template <class Epi>
__device__ __forceinline__ void naive_gemm(Frame& F, const bf16* A, int lda, int M, const float* W, int ldw, int N, int K, const Epi& E) {
    LAS float* As = (LAS float*)F.lds;
    LAS float* Ws = As + 16 * 132;
    LAS float* Ct = (LAS float*)(F.lds + 32768);
    const int tid = F.tid, ty = tid >> 4, tx = tid & 15;
    const int tn_n = N / 128, ntiles = (M / 128) * tn_n;
    for (int tile = F.vcu; tile < ntiles; tile += F.G) {
        const int tm = tile / tn_n, tn = tile % tn_n;
        float acc[4][8];
#pragma unroll
        for (int i = 0; i < 4; ++i)
#pragma unroll
            for (int j = 0; j < 8; ++j) acc[i][j] = 0.f;
        const int ar = tid >> 2, ak = (tid & 3) * 4, wk = tid >> 5, wn = (tid & 31) * 4;
        const bf16* ap = A + (size_t)(tm * 128 + ar) * lda + ak;
        const float* wp = W + (size_t)wk * ldw + tn * 128 + wn;
        for (int k0 = 0; k0 < K; k0 += 16) {
            const v2u av = *(const v2u*)(ap + k0);
            const f32x4 wv = *(const f32x4*)(wp + (size_t)k0 * ldw);
            As[(ak + 0) * 132 + ar] = bflo(av.x); As[(ak + 1) * 132 + ar] = bfhi(av.x); As[(ak + 2) * 132 + ar] = bflo(av.y); As[(ak + 3) * 132 + ar] = bfhi(av.y);
            *(LAS f32x4*)(Ws + wk * 128 + wn) = wv;
            __syncthreads();
#pragma unroll
            for (int kk = 0; kk < 16; ++kk) {
                const f32x4 a = *(const LAS f32x4*)(As + kk * 132 + ty * 4);
                const f32x4 w0 = *(const LAS f32x4*)(Ws + kk * 128 + tx * 8), w1 = *(const LAS f32x4*)(Ws + kk * 128 + tx * 8 + 4);
                const float aa[4] = {a.x, a.y, a.z, a.w}; const float ww[8] = {w0.x, w0.y, w0.z, w0.w, w1.x, w1.y, w1.z, w1.w};
#pragma unroll
                for (int i = 0; i < 4; ++i)
#pragma unroll
                    for (int j = 0; j < 8; ++j) acc[i][j] += aa[i] * ww[j];
            }
            __syncthreads();
        }
#pragma unroll
        for (int i = 0; i < 4; ++i)
#pragma unroll
            for (int j = 0; j < 8; ++j) Ct[(ty * 4 + i) * 129 + tx * 8 + j] = acc[i][j];
        __syncthreads();
        E.tile(F, Ct, tm * 128, tn * 128);
        __syncthreads();
    }
}

__device__ __forceinline__ void row_decode(int row, bool& lat, int& b, int& t, int& kidx) {
    lat = row < NTOK;
    if (lat) { b = row >> 13; t = row & (T - 1); kidx = CT + t; } else { const int j = row - NTOK; b = j >> 8; t = -1; kidx = j & (CT - 1); }
}

struct NaiveInprojEpi {
    __device__ __forceinline__ void tile(Frame& F, const LAS float* Ct, int row0, int col0) const {
        for (int idx = F.tid; idx < 128 * 128; idx += 512) {
            const int r = idx >> 7, c = idx & 127, row = row0 + r, col = col0 + c;
            bool lat; int b, t, kidx; row_decode(row, lat, b, t, kidx);
            float val = Ct[r * 129 + c];
            if (col < 1024) {
                const bool isq = col < 512; const int cc = col & 511, h = cc >> 7, within = cc & 127, i = within & 63;
                if (isq && !lat) continue;
                if (lat) {
                    const bool lowhalf = (i & 31) < 16; const float partner = Ct[r * 129 + (lowhalf ? c + 16 : c - 16)];
                    const int pos = (i < 32) ? (t >> 6) : (128 + (t & 63)); const f32x2 cs = F.rope[pos * 16 + (i & 15)];
                    val = val * cs.x + (lowhalf ? -partner : partner) * cs.y;
                }
                if (isq) F.Qd[((size_t)(b * NH + h) * T + t) * 128 + within] = (bf16)f2bf(val * C2);
                else F.Kd[((size_t)(b * NH + h) * TK + kidx) * 128 + within] = (bf16)f2bf(val);
            } else if (col < 1536) { const int cc = col - 1024, h = cc >> 7, within = cc & 127; F.Vd[((size_t)(b * NH + h) * TK + kidx) * 128 + within] = (bf16)f2bf(val);
            } else if (col < 1792) { const int cc = col - 1536, h = cc >> 6, i = cc & 63; F.MQ[((size_t)(b * NH + h) * TK + kidx) * 64 + i] = (bf16)f2bf(val);
            } else if (col < 2048) { const int cc = col - 1792, h = cc >> 6, i = cc & 63; F.MK[((size_t)(b * NH + h) * TK + kidx) * 64 + i] = (bf16)f2bf(val * 0.125f);
            } else if (col < 2560) { const int cc = col - 2048, h = cc >> 7, within = cc & 127; F.MV[((size_t)(b * NH + h) * TK + kidx) * 128 + within] = (bf16)f2bf(val);
            } else { if (!lat) continue; F.MO[(size_t)row * 512 + (col - 2560)] = (bf16)f2bf(1.f / (1.f + __expf(-val))); }
        }
    }
};
struct NaiveOutprojEpi {
    __device__ __forceinline__ void tile(Frame& F, const LAS float* Ct, int row0, int col0) const {
        for (int rr = 0; rr < 16; ++rr) {
            const int r = F.wave * 16 + rr, row = row0 + r, b = row >> 13; const float* modr = F.mod + (size_t)b * 6 * D;
            float ss = 0.f;
#pragma unroll
            for (int e = 0; e < 2; ++e) { const int c = F.lane + 64 * e, col = col0 + c;
                const float x1 = F.in[I_X][(size_t)row * D + col] + modr[2 * D + col] * Ct[r * 129 + c];
                F.out[(size_t)row * D + col] = x1; ss += x1 * x1;
                F.A2[(size_t)row * D + col] = (bf16)f2bf(x1 * F.in[I_N2G][col] * (1.f + modr[4 * D + col])); }
            ss = wave_sum(ss); if (F.lane == 0) atomicAdd(F.rowsq1 + row, ss);
        }
    }
};
struct NaiveFc1Epi {
    __device__ __forceinline__ void tile(Frame& F, const LAS float* Ct, int row0, int col0) const {
        for (int idx = F.tid; idx < 128 * 128; idx += 512) {
            const int r = idx >> 7, c = idx & 127, row = row0 + r, col = col0 + c, b = row >> 13;
            const float rstd = 1.0f / sqrtf(F.rowsq1[row] * (1.f / D) + EPS);
            float v = rstd * Ct[r * 129 + c] + F.bias1[b * FF + col]; v = fmaxf(v, 0.f);
            F.Hh[(size_t)row * FF + col] = (bf16)f2bf(v * v);
        }
    }
};
struct NaiveFc2Epi {
    __device__ __forceinline__ void tile(Frame& F, const LAS float* Ct, int row0, int col0) const {
        for (int rr = 0; rr < 16; ++rr) {
            const int r = F.wave * 16 + rr, row = row0 + r, b = row >> 13; const float* modr = F.mod + (size_t)b * 6 * D;
            float ss = 0.f;
#pragma unroll
            for (int e = 0; e < 2; ++e) { const int c = F.lane + 64 * e, col = col0 + c;
                const float x2 = F.out[(size_t)row * D + col] + modr[5 * D + col] * Ct[r * 129 + c];
                F.out[(size_t)row * D + col] = x2; ss += x2 * x2; }
            ss = wave_sum(ss); if (F.lane == 0) atomicAdd(F.rowsq2 + row, ss);
        }
    }
};


namespace pg8 {
#define PG8_LAS __attribute__((address_space(3)))
typedef unsigned short bf16_t;
typedef short bf16x8 __attribute__((ext_vector_type(8)));
typedef float f32x4 __attribute__((ext_vector_type(4)));
typedef unsigned u32x4 __attribute__((ext_vector_type(4)));
constexpr int BM = 256, BK = 64, HALF = 128, HTB = HALF * BK * 2  , STAGE_BYTES = 8 * HTB, NXCD = 8, WGM = 8;

__host__ __device__ __forceinline__ int lds_byte(int r, int c) { const int st = (r >> 4) * 2 + (c >> 5), rr = r & 15, cc = c & 31, ob = rr * 64 + cc * 2; return st * 1024 + (ob ^ (((ob >> 9) & 1) << 5)); }
__host__ __device__ __forceinline__ void stage_rc(int b, int& R, int& C) { const int st = b / 1024, sb = b % 1024, swz = sb ^ (((sb >> 9) & 1) << 5); R = (st >> 1) * 16 + swz / 64; C = (st & 1) * 32 + (swz % 64) / 2; }
__host__ __device__ __forceinline__ int perm32(int rho) { const int n = rho >> 4, i = rho & 15; return 8 * (i >> 2) + 4 * n + (i & 3); }

struct Unit { int pm, pn; };
struct Gemm { const bf16_t* A; const bf16_t* Bt; int M, N, K; };

struct StaticOrder {
    int nM, nN, nwg, G, c;
    __host__ __device__ void init(int M, int N, int G_, int c_) { nM = M / BM; nN = N / BM; nwg = nM * nN; G = G_; c = c_; }
    __host__ __device__ bool next(int i, Unit& u) const {
        const long L = (long)i * G + c; if (L >= nwg) return false;
        int wgid = (int)L; { const int q = nwg / NXCD, r = nwg % NXCD, xcd = wgid % NXCD, off = wgid / NXCD; wgid = (xcd < r ? xcd * (q + 1) : r * (q + 1) + (xcd - r) * q) + off; }
        const int nig = WGM * nN, gid = wgid / nig, fm = gid * WGM, gsz = (nM - fm) < WGM ? (nM - fm) : WGM;
        u.pm = fm + ((wgid % nig) % gsz); u.pn = (wgid % nig) / gsz; return true;
    }
    __device__ __forceinline__ void a_ready(const Unit&) const {}
    __device__ __forceinline__ void done(const Unit&) const {}
};

__device__ __forceinline__ unsigned cvt_pk_bf16(float lo, float hi) { unsigned r; asm volatile("v_cvt_pk_bf16_f32 %0, %1, %2" : "=v"(r) : "v"(lo), "v"(hi)); return r; }
template <class Epi, class Sched, bool ALIGN_EPI = false, bool SP2 = false>
__device__ __forceinline__ void gemm_phase(PG8_LAS unsigned char* lds, const Gemm g, const Sched& S, const Epi& E) {
    const int tid = threadIdx.x, wid = __builtin_amdgcn_readfirstlane(tid >> 6), lane = tid & 63, wr = wid >> 2, wc = wid & 3, fr = lane & 15, fq = lane >> 4;
    const int K = g.K, nt = K / BK;
    unsigned voffA[2], voffB[2];
#pragma unroll
    for (int i = 0; i < 2; ++i) { int R, C; stage_rc(tid * 16 + i * 8192, R, C); const int Rb = Epi::PERM ? ((R & ~31) + perm32(R & 31)) : R;
        voffA[i] = (unsigned)(R * K + C) * 2u; voffB[i] = (unsigned)(Rb * K + C) * 2u; }
    const size_t kstep = (size_t)(BK * 2);
    const size_t hstep = (size_t)HALF * K * 2;
    const size_t tstep = 2 * hstep;
    const unsigned ldsw = (unsigned)wid * 1024u;
    const int aoff = lds_byte(wr * 64 + fr, fq * 8), boff = lds_byte(wc * 32 + fr, fq * 8);
#define PG8_SA(b, h) (((b) * 2 + (h)) * HTB)
#define PG8_SB(b, h) ((4 + (b) * 2 + (h)) * HTB)
#define PG8_STAGE(bufoff, gbase, voff) do { _Pragma("unroll") for (int _i = 0; _i < 2; ++_i) \
        __builtin_amdgcn_global_load_lds((const unsigned*)((const char*)(gbase) + (voff)[_i]), (PG8_LAS unsigned*)(lds + (bufoff) + ldsw + _i * 8192), 16, 0, 0); } while (0)
#define PG8_LDA(dst, b, h) do { _Pragma("unroll") for (int m = 0; m < 4; ++m) _Pragma("unroll") for (int k = 0; k < 2; ++k) dst[m][k] = *(const PG8_LAS bf16x8*)(lds + PG8_SA(b, h) + aoff + m * 2048 + k * 1024); } while (0)
#define PG8_LDB(dst, b, h) do { _Pragma("unroll") for (int n = 0; n < 2; ++n) _Pragma("unroll") for (int k = 0; k < 2; ++k) dst[n][k] = *(const PG8_LAS bf16x8*)(lds + PG8_SB(b, h) + boff + n * 2048 + k * 1024); } while (0)
#define PG8_MMA(ai, bj, At, Bt) do { __builtin_amdgcn_s_setprio(1); _Pragma("unroll") for (int m = 0; m < 4; ++m) _Pragma("unroll") for (int n = 0; n < 2; ++n) _Pragma("unroll") for (int k = 0; k < 2; ++k) \
        acc[ai][bj][m][n] = __builtin_amdgcn_mfma_f32_16x16x32_bf16(Bt[n][k], At[m][k], acc[ai][bj][m][n], 0, 0, 0); __builtin_amdgcn_s_setprio(0); } while (0)
#define PG8_WAIT_V(n) asm volatile("s_waitcnt vmcnt(" #n ")" ::: "memory")
#define PG8_WAIT_L(n) asm volatile("s_waitcnt lgkmcnt(" #n ")" ::: "memory")
#define PG8_BAR __builtin_amdgcn_s_barrier()
#define PG8_SCHED __builtin_amdgcn_sched_barrier(0)
    Unit cur, nxt; int ui = 0;
    if (!S.next(0, cur)) return;
    f32x4 acc[2][2][4][2];
#pragma unroll
    for (int a = 0; a < 2; ++a)
#pragma unroll
        for (int b = 0; b < 2; ++b)
#pragma unroll
            for (int m = 0; m < 4; ++m)
#pragma unroll
                for (int n = 0; n < 2; ++n) acc[a][b][m][n] = (f32x4){0.f, 0.f, 0.f, 0.f};
    bf16x8 At[4][2], B0[2][2], B1[2][2];
    const char* cA = (const char*)g.A + (size_t)cur.pm * tstep; const char* cB = (const char*)g.Bt + (size_t)cur.pn * tstep;
    S.a_ready(cur);
    if constexpr (SP2) {
        PG8_STAGE(PG8_SB(0, 0), cB, voffB); PG8_STAGE(PG8_SB(0, 1), cB + hstep, voffB); PG8_STAGE(PG8_SA(0, 0), cA, voffA); PG8_STAGE(PG8_SA(0, 1), cA + hstep, voffA);
        if (wr == 1) PG8_BAR;
        PG8_WAIT_V(2); PG8_BAR;
        PG8_STAGE(PG8_SB(1, 0), cB + kstep, voffB); PG8_STAGE(PG8_SA(1, 0), cA + kstep, voffA); PG8_STAGE(PG8_SB(1, 1), cB + hstep + kstep, voffB);
        PG8_WAIT_V(6); PG8_BAR;
    } else {
        PG8_STAGE(PG8_SB(0, 0), cB, voffB); PG8_STAGE(PG8_SA(0, 0), cA, voffA); PG8_STAGE(PG8_SB(0, 1), cB + hstep, voffB); PG8_STAGE(PG8_SA(0, 1), cA + hstep, voffA);
        if (wr == 1) PG8_BAR;
        PG8_WAIT_V(4); PG8_BAR;
        PG8_STAGE(PG8_SB(1, 0), cB + kstep, voffB); PG8_STAGE(PG8_SA(1, 0), cA + kstep, voffA); PG8_STAGE(PG8_SB(1, 1), cB + hstep + kstep, voffB);
        PG8_WAIT_V(6); PG8_BAR;
    }
    for (;;) {
        const bool has_next = S.next(ui + 1, nxt);
        const char* nA = has_next ? (const char*)g.A + (size_t)nxt.pm * tstep : cA; const char* nB = has_next ? (const char*)g.Bt + (size_t)nxt.pn * tstep : cB;
        for (int t = 0; t < nt; t += 2) {
            const bool last = (t == nt - 2);
            const char* a1 = cA + (size_t)(t + 1) * kstep;
            const char* a2 = last ? nA : cA + (size_t)(t + 2) * kstep; const char* b2 = last ? nB : cB + (size_t)(t + 2) * kstep;
            const char* a3 = a2 + kstep; const char* b3 = b2 + kstep;
            if (last && has_next) S.a_ready(nxt);
            if constexpr (SP2) {
            PG8_LDB(B0, 0, 0); PG8_LDB(B1, 0, 1); PG8_SCHED; PG8_LDA(At, 0, 0); PG8_STAGE(PG8_SA(1, 1), a1 + hstep, voffA);
            PG8_WAIT_V(8); PG8_WAIT_L(0); PG8_BAR; PG8_MMA(0, 0, At, B0); PG8_MMA(0, 1, At, B1); PG8_BAR; PG8_SCHED;
            PG8_LDA(At, 0, 1); PG8_STAGE(PG8_SB(0, 0), b2, voffB); PG8_STAGE(PG8_SB(0, 1), b2 + hstep, voffB); PG8_STAGE(PG8_SA(0, 0), a2, voffA);
            PG8_WAIT_V(8); PG8_WAIT_L(0); PG8_BAR; PG8_MMA(1, 0, At, B0); PG8_MMA(1, 1, At, B1); PG8_BAR; PG8_SCHED;
            PG8_LDB(B0, 1, 0); PG8_LDB(B1, 1, 1); PG8_SCHED; PG8_LDA(At, 1, 0); PG8_STAGE(PG8_SA(0, 1), a2 + hstep, voffA);
            PG8_WAIT_V(8); PG8_WAIT_L(0); PG8_BAR; PG8_MMA(0, 0, At, B0); PG8_MMA(0, 1, At, B1); PG8_BAR; PG8_SCHED;
            PG8_LDA(At, 1, 1); PG8_STAGE(PG8_SB(1, 0), b3, voffB); PG8_STAGE(PG8_SB(1, 1), b3 + hstep, voffB); PG8_STAGE(PG8_SA(1, 0), a3, voffA);
            PG8_WAIT_V(8); PG8_WAIT_L(0); PG8_BAR; PG8_MMA(1, 0, At, B0); PG8_MMA(1, 1, At, B1); PG8_BAR; PG8_SCHED;
            } else {
            PG8_LDB(B0, 0, 0); PG8_SCHED; PG8_LDA(At, 0, 0); PG8_STAGE(PG8_SA(1, 1), a1 + hstep, voffA);
            PG8_WAIT_L(8); PG8_BAR; PG8_WAIT_L(0); PG8_MMA(0, 0, At, B0); PG8_BAR; PG8_SCHED;
            PG8_LDB(B1, 0, 1); PG8_STAGE(PG8_SB(0, 0), b2, voffB);
            PG8_BAR; PG8_WAIT_L(0); PG8_MMA(0, 1, At, B1); PG8_BAR;
            PG8_LDA(At, 0, 1); PG8_STAGE(PG8_SA(0, 0), a2, voffA);
            PG8_BAR; PG8_WAIT_L(0); PG8_MMA(1, 0, At, B0); PG8_BAR; PG8_SCHED;
            PG8_STAGE(PG8_SB(0, 1), b2 + hstep, voffB);
            PG8_WAIT_V(6); PG8_BAR; PG8_MMA(1, 1, At, B1); PG8_BAR;
            PG8_LDB(B0, 1, 0); PG8_SCHED; PG8_LDA(At, 1, 0); PG8_STAGE(PG8_SA(0, 1), a2 + hstep, voffA);
            PG8_WAIT_L(8); PG8_BAR; PG8_WAIT_L(0); PG8_MMA(0, 0, At, B0); PG8_BAR; PG8_SCHED;
            PG8_LDB(B1, 1, 1); PG8_STAGE(PG8_SB(1, 0), b3, voffB);
            PG8_BAR; PG8_WAIT_L(0); PG8_MMA(0, 1, At, B1); PG8_BAR;
            PG8_LDA(At, 1, 1); PG8_STAGE(PG8_SA(1, 0), a3, voffA);
            PG8_BAR; PG8_WAIT_L(0); PG8_MMA(1, 0, At, B0); PG8_BAR; PG8_SCHED;
            PG8_STAGE(PG8_SB(1, 1), b3 + hstep, voffB);
            PG8_WAIT_V(6); PG8_BAR; PG8_MMA(1, 1, At, B1); PG8_BAR;
            }
        }
        if constexpr (ALIGN_EPI) { if (wr == 0) PG8_BAR; }
        if constexpr (!Epi::AFTER_DRAIN) { E(acc, cur, wr, wc, fr, fq); S.done(cur); }
        if (!has_next) break;
#pragma unroll
        for (int a = 0; a < 2; ++a)
#pragma unroll
            for (int b = 0; b < 2; ++b)
#pragma unroll
                for (int m = 0; m < 4; ++m)
#pragma unroll
                    for (int n = 0; n < 2; ++n) acc[a][b][m][n] = (f32x4){0.f, 0.f, 0.f, 0.f};
        cur = nxt; cA = nA; cB = nB; ++ui;
        if constexpr (ALIGN_EPI) { if (wr == 1) PG8_BAR; }
    }
    PG8_WAIT_V(0);
    if constexpr (!ALIGN_EPI) { if (wr == 0) PG8_BAR; }
    PG8_BAR;
    if constexpr (Epi::AFTER_DRAIN) { E.fused(acc, cur, wr, wc, fr, fq, lds, wid, lane); S.done(cur); }
#undef PG8_SA
#undef PG8_SB
#undef PG8_STAGE
#undef PG8_LDA
#undef PG8_LDB
#undef PG8_MMA
#undef PG8_WAIT_V
#undef PG8_WAIT_L
#undef PG8_BAR
#undef PG8_SCHED
}
}

__device__ __forceinline__ v4u pack8(const f32x4& a, const f32x4& b) { v4u w; w.x = pg8::cvt_pk_bf16(a[0], a[1]); w.y = pg8::cvt_pk_bf16(a[2], a[3]); w.z = pg8::cvt_pk_bf16(b[0], b[1]); w.w = pg8::cvt_pk_bf16(b[2], b[3]); return w; }
struct EpiInproj {
    static constexpr bool PERM = true, AFTER_DRAIN = false;
    bf16 *Qd, *Kd, *Vd, *MQ, *MK, *MV, *MO; const f32x2* rope;
    __device__ __forceinline__ void operator()(const f32x4 (&acc)[2][2][4][2], const pg8::Unit& u, int wr, int wc, int fr, int fq) const {
        const int pn = u.pn; const bool lat = u.pm < 128;
        if (!lat && (pn < 2 || pn >= 10)) return;
        const int b = lat ? (u.pm >> 5) : (u.pm - 128);
        const int tbase = lat ? ((u.pm & 31) * 256) : 0;
        const int within0 = wc * 32 + fq * 8;
        if (pn < 4) {
            const bool isq = pn < 2; const int hb = (pn & 1) * 2; const bool rowaxis = (wc & 1) == 0, low = fq < 2; const int j0 = (fq & 1) * 8;
#pragma unroll
            for (int ai = 0; ai < 2; ++ai)
#pragma unroll
                for (int m = 0; m < 4; ++m) {
                    const int rloc = ai * 128 + wr * 64 + m * 16 + fr, t = tbase + rloc;
                    f32x4 cs[4];
                    if (lat) { const int pos = rowaxis ? (t >> 6) : (128 + (t & 63)); const f32x4* rp = (const f32x4*)(rope + pos * 16 + j0);
#pragma unroll
                        for (int q = 0; q < 4; ++q) cs[q] = rp[q]; }
#pragma unroll
                    for (int bj = 0; bj < 2; ++bj) {
                        f32x4 v0 = acc[ai][bj][m][0], v1 = acc[ai][bj][m][1];
                        if (lat) {
                            f32x4 p0, p1;
#pragma unroll
                            for (int e = 0; e < 4; ++e) { p0[e] = __shfl_xor(v0[e], 32); p1[e] = __shfl_xor(v1[e], 32); }
                            if (low) { p0 = -p0; p1 = -p1; }
                            v0[0] = v0[0] * cs[0][0] + p0[0] * cs[0][1]; v0[1] = v0[1] * cs[0][2] + p0[1] * cs[0][3];
                            v0[2] = v0[2] * cs[1][0] + p0[2] * cs[1][1]; v0[3] = v0[3] * cs[1][2] + p0[3] * cs[1][3];
                            v1[0] = v1[0] * cs[2][0] + p1[0] * cs[2][1]; v1[1] = v1[1] * cs[2][2] + p1[1] * cs[2][3];
                            v1[2] = v1[2] * cs[3][0] + p1[2] * cs[3][1]; v1[3] = v1[3] * cs[3][2] + p1[3] * cs[3][3];
                        }
                        if (isq) { v0 = v0 * C2; v1 = v1 * C2; *(v4u*)(Qd + ((size_t)(b * NH + hb + bj) * T + t) * 128 + within0) = pack8(v0, v1); }
                        else *(v4u*)(Kd + ((size_t)(b * NH + hb + bj) * TK + (lat ? CT + t : rloc)) * 128 + within0) = pack8(v0, v1);
                    }
                }
        } else if (pn == 6 || pn == 7) {
            bf16* dst = pn == 6 ? MQ : MK; const float sc = pn == 6 ? 1.f : 0.125f; const int i0 = 32 * (wc & 1) + 8 * fq;
#pragma unroll
            for (int ai = 0; ai < 2; ++ai)
#pragma unroll
                for (int m = 0; m < 4; ++m) { const int rloc = ai * 128 + wr * 64 + m * 16 + fr, kidx = lat ? CT + tbase + rloc : rloc;
#pragma unroll
                    for (int bj = 0; bj < 2; ++bj) { const int h = 2 * bj + (wc >> 1);
                        *(v4u*)(dst + ((size_t)(b * NH + h) * TK + kidx) * 64 + i0) = pack8(acc[ai][bj][m][0] * sc, acc[ai][bj][m][1] * sc); } }
        } else if (pn < 10) {
            bf16* dst = pn < 6 ? Vd : MV; const int hb = (pn & 1) * 2;
#pragma unroll
            for (int ai = 0; ai < 2; ++ai)
#pragma unroll
                for (int m = 0; m < 4; ++m) { const int rloc = ai * 128 + wr * 64 + m * 16 + fr, kidx = lat ? CT + tbase + rloc : rloc;
#pragma unroll
                    for (int bj = 0; bj < 2; ++bj)
                        *(v4u*)(dst + ((size_t)(b * NH + hb + bj) * TK + kidx) * 128 + within0) = pack8(acc[ai][bj][m][0], acc[ai][bj][m][1]); }
        } else {
#pragma unroll
            for (int ai = 0; ai < 2; ++ai)
#pragma unroll
                for (int m = 0; m < 4; ++m) { const int row = u.pm * 256 + ai * 128 + wr * 64 + m * 16 + fr;
#pragma unroll
                    for (int bj = 0; bj < 2; ++bj) { f32x4 v0 = acc[ai][bj][m][0], v1 = acc[ai][bj][m][1];
#pragma unroll
                        for (int e = 0; e < 4; ++e) { v0[e] = __builtin_amdgcn_rcpf(1.f + __expf(-v0[e])); v1[e] = __builtin_amdgcn_rcpf(1.f + __expf(-v1[e])); }
                        *(v4u*)(MO + (size_t)row * 512 + (pn - 10) * 256 + bj * 128 + within0) = pack8(v0, v1); } }
        }
    }
};
struct EpiOutproj {
    static constexpr bool PERM = true, AFTER_DRAIN = false;
    const float* x; float* out; bf16* A2; const float* mod; const float* n2g; float* rowsq;
    __device__ __forceinline__ void operator()(const f32x4 (&acc)[2][2][4][2], const pg8::Unit& u, int wr, int wc, int fr, int fq) const {
        const int b = u.pm >> 5; const float* modr = mod + (size_t)b * 6 * D; const int col0 = u.pn * 256 + wc * 32 + fq * 8;
        f32x4 g1v[2][2], gs2[2][2];
#pragma unroll
        for (int bj = 0; bj < 2; ++bj)
#pragma unroll
            for (int n = 0; n < 2; ++n) { const int c = col0 + bj * 128 + 4 * n; g1v[bj][n] = *(const f32x4*)(modr + 2 * D + c);
                gs2[bj][n] = *(const f32x4*)(n2g + c) * (*(const f32x4*)(modr + 4 * D + c) + 1.0f); }
#pragma unroll
        for (int ai = 0; ai < 2; ++ai)
#pragma unroll
            for (int m = 0; m < 4; ++m) { const int row = u.pm * 256 + ai * 128 + wr * 64 + m * 16 + fr; float ss = 0.f;
#pragma unroll
                for (int bj = 0; bj < 2; ++bj) { const size_t o = (size_t)row * D + col0 + bj * 128;
                    const f32x4 x0 = *(const f32x4*)(x + o) + g1v[bj][0] * acc[ai][bj][m][0], x1 = *(const f32x4*)(x + o + 4) + g1v[bj][1] * acc[ai][bj][m][1];
                    *(f32x4*)(out + o) = x0; *(f32x4*)(out + o + 4) = x1;
                    ss += (x0[0] * x0[0] + x0[1] * x0[1]) + (x0[2] * x0[2] + x0[3] * x0[3]) + (x1[0] * x1[0] + x1[1] * x1[1]) + (x1[2] * x1[2] + x1[3] * x1[3]);
                    *(v4u*)(A2 + o) = pack8(x0 * gs2[bj][0], x1 * gs2[bj][1]); }
                ss += __shfl_xor(ss, 16); ss += __shfl_xor(ss, 32);
                if (fq == 0) atomicAdd(rowsq + row, ss); }
    }
};
struct EpiFc1 {
    static constexpr bool PERM = true, AFTER_DRAIN = false;
    bf16* Hh; const float* bias1; const float* rowsq;
    __device__ __forceinline__ void operator()(const f32x4 (&acc)[2][2][4][2], const pg8::Unit& u, int wr, int wc, int fr, int fq) const {
        const int b = u.pm >> 5; const int col0 = u.pn * 256 + wc * 32 + fq * 8;
        f32x4 bv[2][2];
#pragma unroll
        for (int bj = 0; bj < 2; ++bj)
#pragma unroll
            for (int n = 0; n < 2; ++n) bv[bj][n] = *(const f32x4*)(bias1 + (size_t)b * FF + col0 + bj * 128 + 4 * n);
#pragma unroll
        for (int ai = 0; ai < 2; ++ai)
#pragma unroll
            for (int m = 0; m < 4; ++m) { const int row = u.pm * 256 + ai * 128 + wr * 64 + m * 16 + fr;
                const float rstd = 1.0f / sqrtf(rowsq[row] * (1.f / D) + EPS);
#pragma unroll
                for (int bj = 0; bj < 2; ++bj) { f32x4 v0 = acc[ai][bj][m][0] * rstd + bv[bj][0], v1 = acc[ai][bj][m][1] * rstd + bv[bj][1];
#pragma unroll
                    for (int e = 0; e < 4; ++e) { const float a0 = fmaxf(v0[e], 0.f), a1 = fmaxf(v1[e], 0.f); v0[e] = a0 * a0; v1[e] = a1 * a1; }
                    *(v4u*)(Hh + (size_t)row * FF + col0 + bj * 128) = pack8(v0, v1); } }
    }
};
struct EpiFc2 {
    static constexpr bool PERM = true, AFTER_DRAIN = false;
    float* out; const float* mod; float* rowsq;
    __device__ __forceinline__ void operator()(const f32x4 (&acc)[2][2][4][2], const pg8::Unit& u, int wr, int wc, int fr, int fq) const {
        const int b = u.pm >> 5; const float* modr = mod + (size_t)b * 6 * D; const int col0 = u.pn * 256 + wc * 32 + fq * 8;
        f32x4 g2v[2][2];
#pragma unroll
        for (int bj = 0; bj < 2; ++bj)
#pragma unroll
            for (int n = 0; n < 2; ++n) g2v[bj][n] = *(const f32x4*)(modr + 5 * D + col0 + bj * 128 + 4 * n);
#pragma unroll
        for (int ai = 0; ai < 2; ++ai)
#pragma unroll
            for (int m = 0; m < 4; ++m) { const int row = u.pm * 256 + ai * 128 + wr * 64 + m * 16 + fr; float ss = 0.f;
#pragma unroll
                for (int bj = 0; bj < 2; ++bj) { const size_t o = (size_t)row * D + col0 + bj * 128;
                    const f32x4 x0 = *(const f32x4*)(out + o) + g2v[bj][0] * acc[ai][bj][m][0], x1 = *(const f32x4*)(out + o + 4) + g2v[bj][1] * acc[ai][bj][m][1];
                    *(f32x4*)(out + o) = x0; *(f32x4*)(out + o + 4) = x1;
                    ss += (x0[0] * x0[0] + x0[1] * x0[1]) + (x0[2] * x0[2] + x0[3] * x0[3]) + (x1[0] * x1[0] + x1[1] * x1[1]) + (x1[2] * x1[2] + x1[3] * x1[3]); }
                ss += __shfl_xor(ss, 16); ss += __shfl_xor(ss, 32);
                if (fq == 0) atomicAdd(rowsq + row, ss); }
    }
};

__device__ __forceinline__ void naive_mlstm(Frame& F) {
    LAS float* ks = (LAS float*)F.lds;
    LAS float* qs = ks + 64 * 64;
    LAS float* vs = qs + 64 * 64;
    LAS float* fg = vs + 64 * 128;
    LAS float* ig = fg + 64;
    const int tid = F.tid, v = tid >> 2, dq = (tid & 3) * 16;
    for (int item = F.vcu; item < 32; item += F.G) {
        const int bh = item >> 1, dir = item & 1;
        float C[16], n[16];
#pragma unroll
        for (int e = 0; e < 16; ++e) { C[e] = 0.f; n[e] = 0.f; }
        float* Hout = (dir ? F.HB : F.HF) + (size_t)bh * T * 128;
        for (int blk = 0; blk < TK / 64; ++blk) {
            int c;
            if (!dir) c = blk; else c = (blk < 4) ? (3 - blk) : (TK / 64 - 1 - (blk - 4));
            const int kidx0 = c * 64; const bool lat = c >= 4;
            const size_t base64 = ((size_t)bh * TK + kidx0) * 64, base128 = ((size_t)bh * TK + kidx0) * 128;
            for (int i = tid; i < 64 * 64; i += 512) { ks[i] = bf2f(F.MK[base64 + i]); qs[i] = bf2f(F.MQ[base64 + i]); }
            for (int i = tid; i < 64 * 128; i += 512) vs[i] = bf2f(F.MV[base128 + i]);
            if (tid < 64) { const float* g = F.gates + ((size_t)bh * TK + kidx0 + tid) * 4 + dir * 2; ig[tid] = __expf(g[0]); fg[tid] = __expf(g[1]); }
            __syncthreads();
            for (int step = 0; step < 64; ++step) {
                const int s = dir ? 63 - step : step;
                const float f = fg[s], iw = ig[s], vv = vs[s * 128 + v] * iw;
                float num = 0.f, den = 0.f;
#pragma unroll
                for (int e = 0; e < 16; ++e) { const float kk = ks[s * 64 + dq + e], qq = qs[s * 64 + dq + e];
                    C[e] = f * C[e] + vv * kk; n[e] = f * n[e] + iw * kk; num += C[e] * qq; den += n[e] * qq; }
                if (lat) {
                    num += __shfl_xor(num, 1); num += __shfl_xor(num, 2); den += __shfl_xor(den, 1); den += __shfl_xor(den, 2);
                    if ((tid & 3) == 0) Hout[(size_t)(kidx0 - CT + s) * 128 + v] = num / fmaxf(fabsf(den), 1.f);
                }
            }
            __syncthreads();
        }
    }
}
__device__ __forceinline__ void naive_mlstm_combine(Frame& F) {
    const int gw = F.vcu * NWAVES + F.wave, NGW = F.G * NWAVES, lane = F.lane;
    for (int rid = gw; rid < NTOK * NH; rid += NGW) {
        const int row = rid >> 2, h = rid & 3, b = row >> 13, t = row & (T - 1);
        const size_t o = ((size_t)(b * NH + h) * T + t) * 128 + 2 * lane;
        const float a0 = F.HF[o] + F.HB[o], a1 = F.HF[o + 1] + F.HB[o + 1];
        const float r = 1.0f / sqrtf(wave_sum(a0 * a0 + a1 * a1) * (1.f / 128.f) + EPS);
        const float* g = F.in[I_MLNG] + h * 128 + 2 * lane;
        const unsigned mo = *(const unsigned*)(F.MO + (size_t)row * 512 + h * 128 + 2 * lane);
        *(unsigned*)(F.MIX + (size_t)row * D + 512 + h * 128 + 2 * lane) = pk2(a0 * r * g[0] * bflo(mo), a1 * r * g[1] * bfhi(mo));
    }
}

__device__ __forceinline__ void naive_attn(Frame& F) {
    LAS float* qs = (LAS float*)F.lds + F.wave * 64;
    const int gw = F.vcu * NWAVES + F.wave, NGW = F.G * NWAVES, lane = F.lane;
    float lam;
    { const float s1 = wave_sum(F.in[I_LQ1][lane] * F.in[I_LK1][lane]), s2 = wave_sum(F.in[I_LQ2][lane] * F.in[I_LK2][lane]); lam = __expf(s1) - __expf(s2) + LAMBDA_INIT; }
    for (int rid = gw; rid < NB * NH * T; rid += NGW) {
        const int bh = rid >> 13, t = rid & (T - 1), b = bh >> 2, h = bh & 3;
        float o0 = 0.f, o1 = 0.f;
        for (int map = 0; map < 2; ++map) {
            qs[lane] = bf2f(F.Qd[((size_t)bh * T + t) * 128 + map * 64 + lane]);
            asm volatile("s_waitcnt lgkmcnt(0)" ::: "memory");
            float m = -1e30f, l = 0.f, a0 = 0.f, a1 = 0.f;
            for (int ch = 0; ch < TK / 64; ++ch) {
                const bf16* kp = F.Kd + ((size_t)bh * TK + ch * 64 + lane) * 128 + map * 64;
                float s = 0.f;
#pragma unroll
                for (int d8 = 0; d8 < 8; ++d8) { const v4u kv = *(const v4u*)(kp + d8 * 8); const f32x4 qa = *(const LAS f32x4*)(qs + d8 * 8), qb = *(const LAS f32x4*)(qs + d8 * 8 + 4);
                    s += bflo(kv.x) * qa.x + bfhi(kv.x) * qa.y + bflo(kv.y) * qa.z + bfhi(kv.y) * qa.w + bflo(kv.z) * qb.x + bfhi(kv.z) * qb.y + bflo(kv.w) * qb.z + bfhi(kv.w) * qb.w; }
                const float mn = fmaxf(m, wave_max(s)), alpha = exp2f(m - mn), p = exp2f(s - mn);
                l = l * alpha + wave_sum(p); a0 *= alpha; a1 *= alpha; m = mn;
                const bf16* vp = F.Vd + ((size_t)bh * TK + ch * 64) * 128 + 2 * lane;
#pragma unroll 8
                for (int kk = 0; kk < 64; ++kk) { const float pk = __shfl(p, kk); const unsigned vv = *(const unsigned*)(vp + (size_t)kk * 128); a0 += pk * bflo(vv); a1 += pk * bfhi(vv); }
            }
            const float il = 1.f / l;
            if (map == 0) { o0 = a0 * il; o1 = a1 * il; } else { o0 -= lam * a0 * il; o1 -= lam * a1 * il; }
        }
        const float r = 1.0f / sqrtf(wave_sum(o0 * o0 + o1 * o1) * (1.f / 128.f) + EPS);
        const float* g = F.in[I_SUBLN] + 2 * lane;
        *(unsigned*)(F.MIX + (size_t)(b * T + t) * D + h * 128 + 2 * lane) = pk2(o0 * r * g[0] * (1.f - LAMBDA_INIT), o1 * r * g[1] * (1.f - LAMBDA_INIT));
    }
}

__device__ __forceinline__ void p_final(Frame& F) {
    const int gw = F.vcu * NWAVES + F.wave, NGW = F.G * NWAVES, lane = F.lane;
    for (int row = gw; row < NTOK; row += NGW) {
        const float rstd = 1.0f / sqrtf(F.rowsq2[row] * (1.f / D) + EPS);
#pragma unroll
        for (int j = 0; j < 4; ++j) { const int col = 4 * lane + 256 * j; f32x4* p = (f32x4*)(F.out + (size_t)row * D + col);
            const f32x4 g = *(const f32x4*)(F.in[I_FING] + col); *p = (*p * rstd) * g; }
    }
}


#define XB_TMO      128
#define XB_XCNT(j)  (256  + 64 * (j))
#define XB_XSUB(j)  (1280 + 64 * (j))
#define XB_XGEN(j)  (2304 + 64 * (j))
#define XB_TOP      3328
#define XB_TOPGEN   3392
#define XCD_BAR_WORDS 3456
#define XB_SPIN_CAP (1u << 22)
constexpr int CW_BAR = 4096;
constexpr int MISC_OFF = 131072 + 320;
__device__ __forceinline__ unsigned xb_ld(unsigned* p)              { return __hip_atomic_load(p, __ATOMIC_RELAXED, __HIP_MEMORY_SCOPE_AGENT); }
__device__ __forceinline__ unsigned xb_add(unsigned* p, unsigned v) { return __hip_atomic_fetch_add(p, v, __ATOMIC_RELAXED, __HIP_MEMORY_SCOPE_AGENT); }
__device__ __forceinline__ unsigned xb_xcc_id() { return (unsigned)__builtin_amdgcn_s_getreg((3 << 11) | 20) & 0xFu; }
#define XB_SPIN(cond, bar) do { unsigned _sp = 0; while (cond) { __builtin_amdgcn_s_sleep(1); \
    if ((++_sp & 255u) == 0u) { if (xb_ld(&(bar)[XB_TMO])) break; if (_sp > XB_SPIN_CAP) { atomicAdd(&(bar)[XB_TMO], 1u); break; } } } } while (0)
struct XcdBarrier { unsigned* bar; unsigned x; volatile LAS unsigned* st; };
__device__ __forceinline__ XcdBarrier xcd_barrier_post(unsigned* bar, volatile LAS unsigned* st) {
    XcdBarrier b; b.bar = bar; b.x = xb_xcc_id(); b.st = st;
    if (threadIdx.x == 0) (void)xb_add(&bar[XB_XCNT(b.x)], 1u);
    return b;
}
__device__ __forceinline__ void xcd_barrier_complete(unsigned* bar, unsigned x, unsigned& nloc, unsigned& nx) {
    const unsigned G = gridDim.x * gridDim.y * gridDim.z;
    unsigned sum, cnt, mine, sp = 0u;
    for (;;) {
        sum = 0u; cnt = 0u; mine = 0u;
#pragma unroll
        for (unsigned j = 0; j < 16; ++j) { const unsigned c = xb_ld(&bar[XB_XCNT(j)]); sum += c; cnt += (c > 0u) ? 1u : 0u; mine = (j == x) ? c : mine; }
        if (sum == G) break;
        __builtin_amdgcn_s_sleep(1);
        if ((++sp & 255u) == 0u) { if (xb_ld(&bar[XB_TMO])) break; if (sp > XB_SPIN_CAP) { atomicAdd(&bar[XB_TMO], 1u); break; } }
    }
    nloc = mine > 0u ? mine : 1u; nx = cnt > 0u ? cnt : 1u;
}
__device__ __forceinline__ void xcd_barrier(const XcdBarrier& b) {
    asm volatile("s_waitcnt vmcnt(0)" ::: "memory");
    __syncthreads();
    if (threadIdx.x == 0) {
        unsigned* bar = b.bar;
        __builtin_amdgcn_s_waitcnt(0);
        unsigned nloc = b.st[0], nx = b.st[1];
        if (nloc == 0u) { xcd_barrier_complete(bar, b.x, nloc, nx); b.st[0] = nloc; b.st[1] = nx; }
        const unsigned old = xb_add(&bar[XB_XSUB(b.x)], 1u);
        const unsigned gen = old / nloc;
        if (old + 1u == (gen + 1u) * nloc) {
            __builtin_amdgcn_fence(__ATOMIC_RELEASE, "agent");
            asm volatile("s_waitcnt vmcnt(0)" ::: "memory");
            const unsigned og = xb_add(&bar[XB_TOP], 1u);
            const unsigned tg = og / nx;
            if (og + 1u == (tg + 1u) * nx) xb_add(&bar[XB_TOPGEN], 1u);
            else XB_SPIN(xb_ld(&bar[XB_TOPGEN]) == tg, bar);
            __builtin_amdgcn_fence(__ATOMIC_ACQUIRE, "agent");
            xb_add(&bar[XB_XGEN(b.x)], 1u);
            asm volatile("s_waitcnt vmcnt(0)" ::: "memory");
        } else {
            XB_SPIN(xb_ld(&bar[XB_XGEN(b.x)]) == gen, bar);
            __builtin_amdgcn_fence(__ATOMIC_ACQUIRE, "agent");
            asm volatile("s_waitcnt vmcnt(0)" ::: "memory");
        }
    }
    __syncthreads();
}

constexpr int NPHASE = 9;
__global__ void __launch_bounds__(NWAVES * 64, 2) fwd_kernel(Args args) {
    extern __shared__ __attribute__((aligned(16))) unsigned char lds_raw[];
    Frame F;
    F.lds = (LAS unsigned char*)lds_raw;
    F.tid = threadIdx.x; F.lane = F.tid & 63; F.wave = __builtin_amdgcn_readfirstlane(F.tid >> 6);
    F.G = gridDim.x; { const int bx = blockIdx.x; F.vcu = (F.G % 8 == 0) ? (bx % 8) * (F.G / 8) + bx / 8 : bx; }
#pragma unroll
    for (int i = 0; i < 20; ++i) F.in[i] = args.in[i];
    F.out = args.out; F.ws = args.ws; unsigned char* ws = args.ws;
    F.mod = (float*)(ws + WS_MOD); F.rope = (f32x2*)(ws + WS_ROPE); F.bias1 = (float*)(ws + WS_BIAS1); F.wgt = (float*)(ws + WS_WGT); F.gates = (float*)(ws + WS_G);
    F.rowsq1 = (float*)(ws + WS_ROWSQ1); F.rowsq2 = (float*)(ws + WS_ROWSQ2);
    F.WinT = (bf16*)(ws + WS_WIN); F.WoT = (bf16*)(ws + WS_WO); F.W1T = (bf16*)(ws + WS_W1); F.W2T = (bf16*)(ws + WS_W2);
    F.XM = (bf16*)(ws + WS_XM); F.A2 = (bf16*)(ws + WS_XM);
    F.Qd = (bf16*)(ws + WS_Q); F.Kd = (bf16*)(ws + WS_K); F.Vd = (bf16*)(ws + WS_V); F.MQ = (bf16*)(ws + WS_MQ); F.MK = (bf16*)(ws + WS_MK); F.MV = (bf16*)(ws + WS_MV); F.MO = (bf16*)(ws + WS_MO);
    F.HF = (float*)(ws + WS_DC); F.HB = (float*)(ws + WS_DC + 64 * MiB);
    F.MIX = (bf16*)(ws + WS_CIN);
    F.Hh = (bf16*)(ws + WS_H);
    const int lo = args.ph_lo, hi = args.ph_hi;
    for (int u = F.tid; u < (LDS_BYTES - 131072) / 4; u += NWAVES * 64) ((LAS unsigned*)(F.lds + 131072))[u] = 0u;
    __syncthreads();
    XcdBarrier bar = xcd_barrier_post((unsigned*)(ws + WS_CTL) + CW_BAR + args.li * XCD_BAR_WORDS, (volatile LAS unsigned*)(F.lds + MISC_OFF));
#define IN(k) (lo <= (k) && (k) < hi)
#define SEAM(k) do { if (IN(k) && IN((k) + 1)) xcd_barrier(bar); } while (0)
    if (IN(0)) p0_prologue(F);
    SEAM(0);
    if (IN(1)) p1_rows(F);
    SEAM(1);
#if FAST_GEMM & 1
    if (IN(2)) { pg8::Gemm g{F.XM, F.WinT, MROWS, INP, D}; pg8::StaticOrder S; S.init(MROWS, INP, F.G, (int)blockIdx.x);
        EpiInproj E{F.Qd, F.Kd, F.Vd, F.MQ, F.MK, F.MV, F.MO, F.rope}; pg8::gemm_phase<EpiInproj, pg8::StaticOrder, true, true>(F.lds, g, S, E); }
#else
    if (IN(2)) naive_gemm(F, F.XM, D, MROWS, F.in[I_WIN], INC, INP, D, NaiveInprojEpi{});
#endif
    SEAM(2);
    if (IN(3)) naive_mlstm(F);
    SEAM(3);
    if (IN(4)) { naive_attn(F); naive_mlstm_combine(F); }
    SEAM(4);
#if FAST_GEMM & 2
    if (IN(5)) { pg8::Gemm g{F.MIX, F.WoT, NTOK, D, D}; pg8::StaticOrder S; S.init(NTOK, D, F.G, (int)blockIdx.x);
        EpiOutproj E{F.in[I_X], F.out, F.A2, F.mod, F.in[I_N2G], F.rowsq1}; pg8::gemm_phase<EpiOutproj, pg8::StaticOrder, true, true>(F.lds, g, S, E); }
#else
    if (IN(5)) naive_gemm(F, F.MIX, D, NTOK, F.in[I_WOUT], D, D, D, NaiveOutprojEpi{});
#endif
    SEAM(5);
#if FAST_GEMM & 4
    if (IN(6)) { pg8::Gemm g{F.A2, F.W1T, NTOK, FF, D}; pg8::StaticOrder S; S.init(NTOK, FF, F.G, (int)blockIdx.x);
        EpiFc1 E{F.Hh, F.bias1, F.rowsq1}; pg8::gemm_phase<EpiFc1, pg8::StaticOrder, true, true>(F.lds, g, S, E); }
#else
    if (IN(6)) naive_gemm(F, F.A2, D, NTOK, F.in[I_WFC1], FF, FF, D, NaiveFc1Epi{});
#endif
    SEAM(6);
#if FAST_GEMM & 8
    if (IN(7)) { pg8::Gemm g{F.Hh, F.W2T, NTOK, D, FF}; pg8::StaticOrder S; S.init(NTOK, D, F.G, (int)blockIdx.x);
        EpiFc2 E{F.out, F.mod, F.rowsq2}; pg8::gemm_phase<EpiFc2, pg8::StaticOrder, true, true>(F.lds, g, S, E); }
#else
    if (IN(7)) naive_gemm(F, F.Hh, FF, NTOK, F.in[I_WFC2], D, D, FF, NaiveFc2Epi{});
#endif
    SEAM(7);
    if (IN(8)) p_final(F);
#undef IN
#undef SEAM
}

extern "C" void kernel_launch(void* const* d_in, const int* in_sizes, int n_in, void* d_out, int out_size, void* d_ws, size_t ws_size, hipStream_t stream) {
    static int grid = 0;
    if (grid == 0) {
        if (n_in != 20 || in_sizes[0] != NTOK * D || out_size != NTOK * D || ws_size < WS_END) { fprintf(stderr, "kernel_launch: unexpected shapes n_in %d in0 %d out %d ws %zu\n", n_in, n_in > 0 ? in_sizes[0] : -1, out_size, ws_size); grid = -1; return; }
        int dev = 0, cus = 0, per_cu = 0;
        if (hipGetDevice(&dev) != hipSuccess || hipDeviceGetAttribute(&cus, hipDeviceAttributeMultiprocessorCount, dev) != hipSuccess) { grid = -1; return; }
        if (hipFuncSetAttribute((const void*)fwd_kernel, hipFuncAttributeMaxDynamicSharedMemorySize, LDS_BYTES) != hipSuccess) { fprintf(stderr, "kernel_launch: hipFuncSetAttribute failed\n"); grid = -1; return; }
        if (hipOccupancyMaxActiveBlocksPerMultiprocessor(&per_cu, (const void*)fwd_kernel, NWAVES * 64, LDS_BYTES) != hipSuccess || per_cu < 1) { fprintf(stderr, "kernel_launch: occupancy query says %d\n", per_cu); per_cu = 1; }
        (void)hipGetLastError();
        grid = cus;
    }
    if (grid < 0) return;
    (void)hipMemsetAsync((char*)d_ws + WS_CTL, 0, CTL_ZERO_BYTES, stream);
    Args a{};
    for (int i = 0; i < 20; ++i) a.in[i] = (const float*)d_in[i];
    a.out = (float*)d_out; a.ws = (unsigned char*)d_ws;
    a.ph_lo = 0; a.ph_hi = NPHASE; a.li = 0;
    hipLaunchKernelGGL(fwd_kernel, dim3(grid), dim3(NWAVES * 64), LDS_BYTES, stream, a);
}
```

```cpp
#include <hip/hip_runtime.h>
#include <cstdio>
#include <cstdint>

constexpr int NB = 4, T = 8192, CT = 256, TK = T + CT, D = 1024, FF = 4096, NH = 4;
constexpr int NTOK = NB * T, NCTX = NB * CT, MROWS = NTOK + NCTX;
constexpr int INC = 3088, INP = 3072;
constexpr float EPS = 1e-6f;
constexpr float LAMBDA_INIT = 0.2f;
constexpr float C2 = 0.125f * 1.4426950408889634f;

constexpr size_t MiB = 1u << 20;
constexpr size_t WS_CTL = 0, CTL_ZERO_BYTES = 1 * MiB;
constexpr size_t WS_ROWSQ1 = 256 * 1024, WS_ROWSQ2 = 384 * 1024;
constexpr size_t WS_MOD = 1 * MiB;
constexpr size_t WS_ROPE = WS_MOD + 128 * 1024;
constexpr size_t WS_BIAS1 = WS_ROPE + 32 * 1024;
constexpr size_t WS_WGT = WS_BIAS1 + 64 * 1024;
constexpr size_t WS_WIN = 2 * MiB, WS_WO = 9 * MiB, WS_W1 = 11 * MiB, WS_W2 = 19 * MiB;
constexpr size_t WS_G = 27 * MiB;
constexpr size_t WS_XM = 32 * MiB;
constexpr size_t WS_Q = 98 * MiB, WS_K = 130 * MiB, WS_V = 163 * MiB, WS_MQ = 196 * MiB, WS_MK = 213 * MiB, WS_MV = 230 * MiB, WS_MO = 263 * MiB;
constexpr size_t WS_DC = 296 * MiB;
constexpr size_t WS_CIN = 430 * MiB;
constexpr size_t WS_MIX = 296 * MiB + 0;
constexpr size_t WS_H = 98 * MiB;
constexpr size_t WS_END = 512 * MiB;

typedef unsigned short bf16;
typedef unsigned v4u __attribute__((ext_vector_type(4)));
typedef unsigned v2u __attribute__((ext_vector_type(2)));
typedef float f32x4 __attribute__((ext_vector_type(4)));
typedef float f32x2 __attribute__((ext_vector_type(2)));
#define LAS __attribute__((address_space(3)))

__device__ __forceinline__ unsigned f2bf(float f) { unsigned u = __builtin_bit_cast(unsigned, f); return (u + 0x7fffu + ((u >> 16) & 1u)) >> 16; }
__device__ __forceinline__ unsigned pk2(float lo, float hi) { return f2bf(lo) | (f2bf(hi) << 16); }
__device__ __forceinline__ float bf2f(unsigned short b) { return __builtin_bit_cast(float, (unsigned)b << 16); }
__device__ __forceinline__ float bflo(unsigned w) { return __builtin_bit_cast(float, w << 16); }
__device__ __forceinline__ float bfhi(unsigned w) { return __builtin_bit_cast(float, w & 0xffff0000u); }
__device__ __forceinline__ float wave_sum(float v) {
#pragma unroll
    for (int o = 1; o < 64; o <<= 1) v += __shfl_xor(v, o);
    return v;
}
__device__ __forceinline__ float wave_max(float v) {
#pragma unroll
    for (int o = 1; o < 64; o <<= 1) v = fmaxf(v, __shfl_xor(v, o));
    return v;
}

#ifndef FAST_ATTN
#define FAST_ATTN 1
#endif
#ifndef FAST_GEMM
#define FAST_GEMM 15
#endif
constexpr int NWAVES = 8;
constexpr int LDS_BYTES = 147456;

struct Args {
    const float* in[20]; float* out; unsigned char* ws; int ph_lo, ph_hi, li, pad;
};
enum { I_X = 0, I_C, I_CTX, I_CCTX, I_WADA, I_BADA, I_N1G, I_N2G, I_WIN, I_BGATE, I_LQ1, I_LK1, I_LQ2, I_LK2, I_SUBLN, I_MLNG, I_WOUT, I_WFC1, I_WFC2, I_FING };

struct Frame {
    LAS unsigned char* lds;
    int tid, lane, wave, vcu, G;
    const float* in[20]; float* out; unsigned char* ws;
    float* mod; f32x2* rope; float* bias1; float* wgt; float* gates; float* rowsq1; float* rowsq2;
    bf16 *WinT, *WoT, *W1T, *W2T, *XM, *Qd, *Kd, *Vd, *MQ, *MK, *MV, *MO, *MIX, *A2, *Hh;
    float *HF, *HB;
};

__device__ __forceinline__ void refresh_ids(Frame& F) { int l = (int)__builtin_amdgcn_mbcnt_hi(~0u, __builtin_amdgcn_mbcnt_lo(~0u, 0u)); asm volatile("" : "+v"(l)); F.lane = l; F.tid = F.wave * 64 + l; }

__device__ __forceinline__ void gemv_item(Frame& F, const LAS float* a, int R, const float* W, int ldw, int col0, const float* bias, float* out, int ldo, LAS float* red) {
    const int w = F.wave, lane = F.lane, c = lane & 31, kp = lane >> 5;
    float acc[5] = {0.f, 0.f, 0.f, 0.f, 0.f};
    const float* wp = W + (size_t)(128 * w + kp) * ldw + col0 + c;
#pragma unroll 8
    for (int kk = 0; kk < 64; ++kk) {
        const float wv = wp[(size_t)(2 * kk) * ldw];
        const int k = 128 * w + 2 * kk + kp;
#pragma unroll
        for (int r = 0; r < 5; ++r) if (r < R) acc[r] += a[r * 1024 + k] * wv;
    }
#pragma unroll
    for (int r = 0; r < 5; ++r) acc[r] += __shfl_xor(acc[r], 32);
    if (lane < 32) {
#pragma unroll
        for (int r = 0; r < 5; ++r) red[(w * 5 + r) * 32 + lane] = acc[r];
    }
    __syncthreads();
    if (F.tid < R * 32) {
        const int r = F.tid >> 5, cc = F.tid & 31; float s = 0.f;
#pragma unroll
        for (int ww = 0; ww < 8; ++ww) s += red[(ww * 5 + r) * 32 + cc];
        out[(size_t)r * ldo + col0 + cc] = s + (bias ? bias[col0 + cc] : 0.f);
    }
    __syncthreads();
}

__device__ __forceinline__ void p0_transpose_item(const float* W, int K, int ldw, int nblk, bf16* WT, LAS float* scr, int item, int lane) {
    const int kb = item / nblk, nb = item % nblk, k0 = 64 * kb, n0 = 32 * nb;
#pragma unroll 8
    for (int i = 0; i < 32; ++i) { const int kk = 2 * i + (lane >> 5); scr[kk * 33 + (lane & 31)] = W[(size_t)(k0 + kk) * ldw + n0 + (lane & 31)]; }
    asm volatile("s_waitcnt lgkmcnt(0)" ::: "memory");
    const int c = lane & 7;
#pragma unroll
    for (int j = 0; j < 4; ++j) { const int n = (lane >> 3) + 8 * j; const LAS float* s = scr + (8 * c) * 33 + n;
        v4u o; o.x = pk2(s[0 * 33], s[1 * 33]); o.y = pk2(s[2 * 33], s[3 * 33]); o.z = pk2(s[4 * 33], s[5 * 33]); o.w = pk2(s[6 * 33], s[7 * 33]);
        *(v4u*)(WT + (size_t)(n0 + n) * K + k0 + 8 * c) = o; }
    asm volatile("s_waitcnt lgkmcnt(0)" ::: "memory");
}

__device__ __forceinline__ void p0_prologue(Frame& F) {
    LAS float* sa = (LAS float*)F.lds;
    LAS float* red = sa + 5 * 1024;
    for (int i = F.tid; i < 5 * 1024; i += 512) { const int r = i >> 10, k = i & 1023; const float c = r < 4 ? F.in[I_C][r * 1024 + k] : F.in[I_CCTX][k]; sa[i] = c / (1.f + __expf(-c)); }
    __syncthreads();
    for (int item = F.vcu; item < 192; item += F.G) gemv_item(F, sa, 5, F.in[I_WADA], 6 * D, item * 32, F.in[I_BADA], F.mod, 6 * D, red);
    LAS float* scr = (LAS float*)(F.lds + 32768 + F.wave * 8448);
    const int gw = F.vcu * NWAVES + F.wave, NGW = F.G * NWAVES;
    constexpr int I_IN = (D / 64) * (INP / 32), I_O = (D / 64) * (D / 32), I_1 = (D / 64) * (FF / 32), I_2 = (FF / 64) * (D / 32);
    for (int it = gw; it < I_IN + I_O + I_1 + I_2; it += NGW) {
        int r = it;
        if (r < I_IN) { p0_transpose_item(F.in[I_WIN], D, INC, INP / 32, F.WinT, scr, r, F.lane); continue; } r -= I_IN;
        if (r < I_O) { p0_transpose_item(F.in[I_WOUT], D, D, D / 32, F.WoT, scr, r, F.lane); continue; } r -= I_O;
        if (r < I_1) { p0_transpose_item(F.in[I_WFC1], D, FF, FF / 32, F.W1T, scr, r, F.lane); continue; } r -= I_1;
        p0_transpose_item(F.in[I_WFC2], FF, D, D / 32, F.W2T, scr, r, F.lane);
    }
    const int gt = F.vcu * 512 + F.tid, NGT = F.G * 512;
    for (int idx = gt; idx < 192 * 16; idx += NGT) {
        const int p = idx >> 4, j = idx & 15; const int pos = p < 128 ? p : p - 128;
        double inv = 1.0; for (int q = 0; q < j; ++q) inv *= 0.5623413251903491;
        const float ang = (float)pos * (float)inv;
        double a = (double)ang; const double TWO_PI = 6.283185307179586476925;
        const double n = __builtin_rint(a / TWO_PI); a -= n * TWO_PI;
        const double a2 = a * a; double sn = 0.0, cs = 0.0, ts = a, tc = 1.0;
        for (int q = 0; q < 14; ++q) { sn += ts; cs += tc; tc = -tc * a2 / (double)((2 * q + 1) * (2 * q + 2)); ts = -ts * a2 / (double)((2 * q + 2) * (2 * q + 3)); }
        F.rope[idx] = (f32x2){(float)cs, (float)sn};
    }
    for (int idx = gt; idx < 16 * 1024; idx += NGT) { const int g = idx >> 10, k = idx & 1023; F.wgt[idx] = F.in[I_WIN][(size_t)k * INC + INP + g]; }
}

__device__ __forceinline__ float log_sigmoid(float x) { return fminf(x, 0.f) - log1pf(__expf(-fabsf(x))); }
__device__ __forceinline__ void p1_rows(Frame& F) {
    LAS float* wg = (LAS float*)F.lds;
    LAS float* sa = (LAS float*)(F.lds + 65536);
    LAS float* red = (LAS float*)(F.lds + 65536 + 16384);
    for (int i = F.tid; i < 16 * 1024; i += 512) wg[i] = F.wgt[i];
    for (int i = F.tid; i < 4 * 1024; i += 512) sa[i] = F.mod[(i >> 10) * 6 * D + 3 * D + (i & 1023)];
    __syncthreads();
    for (int item = F.vcu; item < 128; item += F.G) gemv_item(F, sa, 4, F.in[I_WFC1], FF, item * 32, nullptr, F.bias1, FF, red);
    const int gw = F.vcu * NWAVES + F.wave, NGW = F.G * NWAVES, lane = F.lane;
    const float* g1n = F.in[I_N1G];
    for (int row = gw; row < MROWS; row += NGW) {
        const bool lat = row < NTOK; const int b5 = lat ? (row >> 13) : 4;
        const float* src = lat ? F.in[I_X] + (size_t)row * D : F.in[I_CTX] + (size_t)(row - NTOK) * D;
        const float* modr = F.mod + (size_t)b5 * 6 * D;
        f32x4 v[4]; float ss = 0.f;
#pragma unroll
        for (int j = 0; j < 4; ++j) { v[j] = *(const f32x4*)(src + 4 * lane + 256 * j); ss += (v[j].x * v[j].x + v[j].y * v[j].y) + (v[j].z * v[j].z + v[j].w * v[j].w); }
        const float rstd = 1.0f / sqrtf(wave_sum(ss) * (1.f / D) + EPS);
        float acc[16]; f32x4 xm[4];
#pragma unroll
        for (int j = 0; j < 4; ++j) {
            const int col = 4 * lane + 256 * j;
            const f32x4 gg = *(const f32x4*)(g1n + col), sc = *(const f32x4*)(modr + D + col), sh = *(const f32x4*)(modr + col);
            xm[j] = (v[j] * rstd) * gg * (sc + 1.0f) + sh;
            v2u o; o.x = pk2(xm[j].x, xm[j].y); o.y = pk2(xm[j].z, xm[j].w);
            *(v2u*)(F.XM + (size_t)row * D + col) = o;
        }
#pragma unroll
        for (int g = 0; g < 16; ++g) {
            float a = 0.f;
#pragma unroll
            for (int j = 0; j < 4; ++j) { const f32x4 w = *(const LAS f32x4*)(wg + g * 1024 + 4 * lane + 256 * j); a += (xm[j].x * w.x + xm[j].y * w.y) + (xm[j].z * w.z + xm[j].w * w.w); }
            acc[g] = a;
            asm volatile("" ::: "memory");
        }
#pragma unroll
        for (int i = 0; i < 8; ++i) { const bool hi = lane & 32; const float mine = hi ? acc[i + 8] : acc[i], send = hi ? acc[i] : acc[i + 8]; acc[i] = mine + __shfl_xor(send, 32); }
#pragma unroll
        for (int i = 0; i < 4; ++i) { const bool hi = lane & 16; const float mine = hi ? acc[i + 4] : acc[i], send = hi ? acc[i] : acc[i + 4]; acc[i] = mine + __shfl_xor(send, 16); }
#pragma unroll
        for (int i = 0; i < 2; ++i) { const bool hi = lane & 8; const float mine = hi ? acc[i + 2] : acc[i], send = hi ? acc[i] : acc[i + 2]; acc[i] = mine + __shfl_xor(send, 8); }
        { const bool hi = lane & 4; const float mine = hi ? acc[1] : acc[0], send = hi ? acc[0] : acc[1]; acc[0] = mine + __shfl_xor(send, 4); }
        acc[0] += __shfl_xor(acc[0], 2); acc[0] += __shfl_xor(acc[0], 1);
        if ((lane & 3) == 0) {
            const int g = ((lane >> 5) & 1) * 8 + ((lane >> 4) & 1) * 4 + ((lane >> 3) & 1) * 2 + ((lane >> 2) & 1);
            const float val = acc[0] + F.in[I_BGATE][g]; const int type = g >> 2, h = g & 3;
            const float o = (type & 1) ? log_sigmoid(val) : val;
            const int b = lat ? (row >> 13) : ((row - NTOK) >> 8), kidx = lat ? (CT + (row & (T - 1))) : ((row - NTOK) & (CT - 1));
            F.gates[((size_t)(b * NH + h) * TK + kidx) * 4 + type] = o;
        }
    }
}

template <class Epi>
__device__ __forceinline__ void naive_gemm(Frame& F, const bf16* A, int lda, int M, const float* W, int ldw, int N, int K, const Epi& E) {
    LAS float* As = (LAS float*)F.lds;
    LAS float* Ws = As + 16 * 132;
    LAS float* Ct = (LAS float*)(F.lds + 32768);
    const int tid = F.tid, ty = tid >> 4, tx = tid & 15;
    const int tn_n = N / 128, ntiles = (M / 128) * tn_n;
    for (int tile = F.vcu; tile < ntiles; tile += F.G) {
        const int tm = tile / tn_n, tn = tile % tn_n;
        float acc[4][8];
#pragma unroll
        for (int i = 0; i < 4; ++i)
#pragma unroll
            for (int j = 0; j < 8; ++j) acc[i][j] = 0.f;
        const int ar = tid >> 2, ak = (tid & 3) * 4, wk = tid >> 5, wn = (tid & 31) * 4;
        const bf16* ap = A + (size_t)(tm * 128 + ar) * lda + ak;
        const float* wp = W + (size_t)wk * ldw + tn * 128 + wn;
        for (int k0 = 0; k0 < K; k0 += 16) {
            const v2u av = *(const v2u*)(ap + k0);
            const f32x4 wv = *(const f32x4*)(wp + (size_t)k0 * ldw);
            As[(ak + 0) * 132 + ar] = bflo(av.x); As[(ak + 1) * 132 + ar] = bfhi(av.x); As[(ak + 2) * 132 + ar] = bflo(av.y); As[(ak + 3) * 132 + ar] = bfhi(av.y);
            *(LAS f32x4*)(Ws + wk * 128 + wn) = wv;
            __syncthreads();
#pragma unroll
            for (int kk = 0; kk < 16; ++kk) {
                const f32x4 a = *(const LAS f32x4*)(As + kk * 132 + ty * 4);
                const f32x4 w0 = *(const LAS f32x4*)(Ws + kk * 128 + tx * 8), w1 = *(const LAS f32x4*)(Ws + kk * 128 + tx * 8 + 4);
                const float aa[4] = {a.x, a.y, a.z, a.w}; const float ww[8] = {w0.x, w0.y, w0.z, w0.w, w1.x, w1.y, w1.z, w1.w};
#pragma unroll
                for (int i = 0; i < 4; ++i)
#pragma unroll
                    for (int j = 0; j < 8; ++j) acc[i][j] += aa[i] * ww[j];
            }
            __syncthreads();
        }
#pragma unroll
        for (int i = 0; i < 4; ++i)
#pragma unroll
            for (int j = 0; j < 8; ++j) Ct[(ty * 4 + i) * 129 + tx * 8 + j] = acc[i][j];
        __syncthreads();
        E.tile(F, Ct, tm * 128, tn * 128);
        __syncthreads();
    }
}

__device__ __forceinline__ void row_decode(int row, bool& lat, int& b, int& t, int& kidx) {
    lat = row < NTOK;
    if (lat) { b = row >> 13; t = row & (T - 1); kidx = CT + t; } else { const int j = row - NTOK; b = j >> 8; t = -1; kidx = j & (CT - 1); }
}

struct NaiveInprojEpi {
    __device__ __forceinline__ void tile(Frame& F, const LAS float* Ct, int row0, int col0) const {
        for (int idx = F.tid; idx < 128 * 128; idx += 512) {
            const int r = idx >> 7, c = idx & 127, row = row0 + r, col = col0 + c;
            bool lat; int b, t, kidx; row_decode(row, lat, b, t, kidx);
            float val = Ct[r * 129 + c];
            if (col < 1024) {
                const bool isq = col < 512; const int cc = col & 511, h = cc >> 7, within = cc & 127, i = within & 63;
                if (isq && !lat) continue;
                if (lat) {
                    const bool lowhalf = (i & 31) < 16; const float partner = Ct[r * 129 + (lowhalf ? c + 16 : c - 16)];
                    const int pos = (i < 32) ? (t >> 6) : (128 + (t & 63)); const f32x2 cs = F.rope[pos * 16 + (i & 15)];
                    val = val * cs.x + (lowhalf ? -partner : partner) * cs.y;
                }
                if (isq) F.Qd[((size_t)(b * NH + h) * T + t) * 128 + within] = (bf16)f2bf(val * C2);
                else F.Kd[((size_t)(b * NH + h) * TK + kidx) * 128 + within] = (bf16)f2bf(val);
            } else if (col < 1536) { const int cc = col - 1024, h = cc >> 7, within = cc & 127; F.Vd[((size_t)(b * NH + h) * TK + kidx) * 128 + within] = (bf16)f2bf(val);
            } else if (col < 1792) { const int cc = col - 1536, h = cc >> 6, i = cc & 63; F.MQ[((size_t)(b * NH + h) * TK + kidx) * 64 + i] = (bf16)f2bf(val);
            } else if (col < 2048) { const int cc = col - 1792, h = cc >> 6, i = cc & 63; F.MK[((size_t)(b * NH + h) * TK + kidx) * 64 + i] = (bf16)f2bf(val * 0.125f);
            } else if (col < 2560) { const int cc = col - 2048, h = cc >> 7, within = cc & 127; F.MV[((size_t)(b * NH + h) * TK + kidx) * 128 + within] = (bf16)f2bf(val);
            } else { if (!lat) continue; F.MO[(size_t)row * 512 + (col - 2560)] = (bf16)f2bf(1.f / (1.f + __expf(-val))); }
        }
    }
};
struct NaiveOutprojEpi {
    __device__ __forceinline__ void tile(Frame& F, const LAS float* Ct, int row0, int col0) const {
        for (int rr = 0; rr < 16; ++rr) {
            const int r = F.wave * 16 + rr, row = row0 + r, b = row >> 13; const float* modr = F.mod + (size_t)b * 6 * D;
            float ss = 0.f;
#pragma unroll
            for (int e = 0; e < 2; ++e) { const int c = F.lane + 64 * e, col = col0 + c;
                const float x1 = F.in[I_X][(size_t)row * D + col] + modr[2 * D + col] * Ct[r * 129 + c];
                F.out[(size_t)row * D + col] = x1; ss += x1 * x1;
                F.A2[(size_t)row * D + col] = (bf16)f2bf(x1 * F.in[I_N2G][col] * (1.f + modr[4 * D + col])); }
            ss = wave_sum(ss); if (F.lane == 0) atomicAdd(F.rowsq1 + row, ss);
        }
    }
};
struct NaiveFc1Epi {
    __device__ __forceinline__ void tile(Frame& F, const LAS float* Ct, int row0, int col0) const {
        for (int idx = F.tid; idx < 128 * 128; idx += 512) {
            const int r = idx >> 7, c = idx & 127, row = row0 + r, col = col0 + c, b = row >> 13;
            const float rstd = 1.0f / sqrtf(F.rowsq1[row] * (1.f / D) + EPS);
            float v = rstd * Ct[r * 129 + c] + F.bias1[b * FF + col]; v = fmaxf(v, 0.f);
            F.Hh[(size_t)row * FF + col] = (bf16)f2bf(v * v);
        }
    }
};
struct NaiveFc2Epi {
    __device__ __forceinline__ void tile(Frame& F, const LAS float* Ct, int row0, int col0) const {
        for (int rr = 0; rr < 16; ++rr) {
            const int r = F.wave * 16 + rr, row = row0 + r, b = row >> 13; const float* modr = F.mod + (size_t)b * 6 * D;
            float ss = 0.f;
#pragma unroll
            for (int e = 0; e < 2; ++e) { const int c = F.lane + 64 * e, col = col0 + c;
                const float x2 = F.out[(size_t)row * D + col] + modr[5 * D + col] * Ct[r * 129 + c];
                F.out[(size_t)row * D + col] = x2; ss += x2 * x2; }
            ss = wave_sum(ss); if (F.lane == 0) atomicAdd(F.rowsq2 + row, ss);
        }
    }
};


namespace pg8 {
#define PG8_LAS __attribute__((address_space(3)))
typedef unsigned short bf16_t;
typedef short bf16x8 __attribute__((ext_vector_type(8)));
typedef float f32x4 __attribute__((ext_vector_type(4)));
typedef unsigned u32x4 __attribute__((ext_vector_type(4)));
constexpr int BM = 256, BK = 64, HALF = 128, HTB = HALF * BK * 2  , STAGE_BYTES = 8 * HTB, NXCD = 8, WGM = 8;

__host__ __device__ __forceinline__ int lds_byte(int r, int c) { const int st = (r >> 4) * 2 + (c >> 5), rr = r & 15, cc = c & 31, ob = rr * 64 + cc * 2; return st * 1024 + (ob ^ (((ob >> 9) & 1) << 5)); }
__host__ __device__ __forceinline__ void stage_rc(int b, int& R, int& C) { const int st = b / 1024, sb = b % 1024, swz = sb ^ (((sb >> 9) & 1) << 5); R = (st >> 1) * 16 + swz / 64; C = (st & 1) * 32 + (swz % 64) / 2; }
__host__ __device__ __forceinline__ int perm32(int rho) { const int n = rho >> 4, i = rho & 15; return 8 * (i >> 2) + 4 * n + (i & 3); }

struct Unit { int pm, pn; };
struct Gemm { const bf16_t* A; const bf16_t* Bt; int M, N, K; };

struct StaticOrder {
    int nM, nN, nwg, G, c;
    __host__ __device__ void init(int M, int N, int G_, int c_) { nM = M / BM; nN = N / BM; nwg = nM * nN; G = G_; c = c_; }
    __host__ __device__ bool next(int i, Unit& u) const {
        const long L = (long)i * G + c; if (L >= nwg) return false;
        int wgid = (int)L; { const int q = nwg / NXCD, r = nwg % NXCD, xcd = wgid % NXCD, off = wgid / NXCD; wgid = (xcd < r ? xcd * (q + 1) : r * (q + 1) + (xcd - r) * q) + off; }
        const int nig = WGM * nN, gid = wgid / nig, fm = gid * WGM, gsz = (nM - fm) < WGM ? (nM - fm) : WGM;
        u.pm = fm + ((wgid % nig) % gsz); u.pn = (wgid % nig) / gsz; return true;
    }
    __device__ __forceinline__ void a_ready(const Unit&) const {}
    __device__ __forceinline__ void done(const Unit&) const {}
};

__device__ __forceinline__ unsigned cvt_pk_bf16(float lo, float hi) { unsigned r; asm volatile("v_cvt_pk_bf16_f32 %0, %1, %2" : "=v"(r) : "v"(lo), "v"(hi)); return r; }
template <class Epi, class Sched, bool ALIGN_EPI = false, bool SP2 = false>
__device__ __forceinline__ void gemm_phase(PG8_LAS unsigned char* lds, const Gemm g, const Sched& S, const Epi& E) {
    const int tid = threadIdx.x, wid = __builtin_amdgcn_readfirstlane(tid >> 6), lane = tid & 63, wr = wid >> 2, wc = wid & 3, fr = lane & 15, fq = lane >> 4;
    const int K = g.K, nt = K / BK;
    unsigned voffA[2], voffB[2];
#pragma unroll
    for (int i = 0; i < 2; ++i) { int R, C; stage_rc(tid * 16 + i * 8192, R, C); const int Rb = Epi::PERM ? ((R & ~31) + perm32(R & 31)) : R;
        voffA[i] = (unsigned)(R * K + C) * 2u; voffB[i] = (unsigned)(Rb * K + C) * 2u; }
    const size_t kstep = (size_t)(BK * 2);
    const size_t hstep = (size_t)HALF * K * 2;
    const size_t tstep = 2 * hstep;
    const unsigned ldsw = (unsigned)wid * 1024u;
    const int aoff = lds_byte(wr * 64 + fr, fq * 8), boff = lds_byte(wc * 32 + fr, fq * 8);
#define PG8_SA(b, h) (((b) * 2 + (h)) * HTB)
#define PG8_SB(b, h) ((4 + (b) * 2 + (h)) * HTB)
#define PG8_STAGE(bufoff, gbase, voff) do { _Pragma("unroll") for (int _i = 0; _i < 2; ++_i) \
        __builtin_amdgcn_global_load_lds((const unsigned*)((const char*)(gbase) + (voff)[_i]), (PG8_LAS unsigned*)(lds + (bufoff) + ldsw + _i * 8192), 16, 0, 0); } while (0)
#define PG8_LDA(dst, b, h) do { _Pragma("unroll") for (int m = 0; m < 4; ++m) _Pragma("unroll") for (int k = 0; k < 2; ++k) dst[m][k] = *(const PG8_LAS bf16x8*)(lds + PG8_SA(b, h) + aoff + m * 2048 + k * 1024); } while (0)
#define PG8_LDB(dst, b, h) do { _Pragma("unroll") for (int n = 0; n < 2; ++n) _Pragma("unroll") for (int k = 0; k < 2; ++k) dst[n][k] = *(const PG8_LAS bf16x8*)(lds + PG8_SB(b, h) + boff + n * 2048 + k * 1024); } while (0)
#define PG8_MMA(ai, bj, At, Bt) do { __builtin_amdgcn_s_setprio(1); _Pragma("unroll") for (int m = 0; m < 4; ++m) _Pragma("unroll") for (int n = 0; n < 2; ++n) _Pragma("unroll") for (int k = 0; k < 2; ++k) \
        acc[ai][bj][m][n] = __builtin_amdgcn_mfma_f32_16x16x32_bf16(Bt[n][k], At[m][k], acc[ai][bj][m][n], 0, 0, 0); __builtin_amdgcn_s_setprio(0); } while (0)
#define PG8_WAIT_V(n) asm volatile("s_waitcnt vmcnt(" #n ")" ::: "memory")
#define PG8_WAIT_L(n) asm volatile("s_waitcnt lgkmcnt(" #n ")" ::: "memory")
#define PG8_BAR __builtin_amdgcn_s_barrier()
#define PG8_SCHED __builtin_amdgcn_sched_barrier(0)
    Unit cur, nxt; int ui = 0;
    if (!S.next(0, cur)) return;
    f32x4 acc[2][2][4][2];
#pragma unroll
    for (int a = 0; a < 2; ++a)
#pragma unroll
        for (int b = 0; b < 2; ++b)
#pragma unroll
            for (int m = 0; m < 4; ++m)
#pragma unroll
                for (int n = 0; n < 2; ++n) acc[a][b][m][n] = (f32x4){0.f, 0.f, 0.f, 0.f};
    bf16x8 At[4][2], B0[2][2], B1[2][2];
    const char* cA = (const char*)g.A + (size_t)cur.pm * tstep; const char* cB = (const char*)g.Bt + (size_t)cur.pn * tstep;
    S.a_ready(cur);
    if constexpr (SP2) {
        PG8_STAGE(PG8_SB(0, 0), cB, voffB); PG8_STAGE(PG8_SB(0, 1), cB + hstep, voffB); PG8_STAGE(PG8_SA(0, 0), cA, voffA); PG8_STAGE(PG8_SA(0, 1), cA + hstep, voffA);
        if (wr == 1) PG8_BAR;
        PG8_WAIT_V(2); PG8_BAR;
        PG8_STAGE(PG8_SB(1, 0), cB + kstep, voffB); PG8_STAGE(PG8_SA(1, 0), cA + kstep, voffA); PG8_STAGE(PG8_SB(1, 1), cB + hstep + kstep, voffB);
        PG8_WAIT_V(6); PG8_BAR;
    } else {
        PG8_STAGE(PG8_SB(0, 0), cB, voffB); PG8_STAGE(PG8_SA(0, 0), cA, voffA); PG8_STAGE(PG8_SB(0, 1), cB + hstep, voffB); PG8_STAGE(PG8_SA(0, 1), cA + hstep, voffA);
        if (wr == 1) PG8_BAR;
        PG8_WAIT_V(4); PG8_BAR;
        PG8_STAGE(PG8_SB(1, 0), cB + kstep, voffB); PG8_STAGE(PG8_SA(1, 0), cA + kstep, voffA); PG8_STAGE(PG8_SB(1, 1), cB + hstep + kstep, voffB);
        PG8_WAIT_V(6); PG8_BAR;
    }
    for (;;) {
        const bool has_next = S.next(ui + 1, nxt);
        const char* nA = has_next ? (const char*)g.A + (size_t)nxt.pm * tstep : cA; const char* nB = has_next ? (const char*)g.Bt + (size_t)nxt.pn * tstep : cB;
        for (int t = 0; t < nt; t += 2) {
            const bool last = (t == nt - 2);
            const char* a1 = cA + (size_t)(t + 1) * kstep;
            const char* a2 = last ? nA : cA + (size_t)(t + 2) * kstep; const char* b2 = last ? nB : cB + (size_t)(t + 2) * kstep;
            const char* a3 = a2 + kstep; const char* b3 = b2 + kstep;
            if (last && has_next) S.a_ready(nxt);
            if constexpr (SP2) {
            PG8_LDB(B0, 0, 0); PG8_LDB(B1, 0, 1); PG8_SCHED; PG8_LDA(At, 0, 0); PG8_STAGE(PG8_SA(1, 1), a1 + hstep, voffA);
            PG8_WAIT_V(8); PG8_WAIT_L(0); PG8_BAR; PG8_MMA(0, 0, At, B0); PG8_MMA(0, 1, At, B1); PG8_BAR; PG8_SCHED;
            PG8_LDA(At, 0, 1); PG8_STAGE(PG8_SB(0, 0), b2, voffB); PG8_STAGE(PG8_SB(0, 1), b2 + hstep, voffB); PG8_STAGE(PG8_SA(0, 0), a2, voffA);
            PG8_WAIT_V(8); PG8_WAIT_L(0); PG8_BAR; PG8_MMA(1, 0, At, B0); PG8_MMA(1, 1, At, B1); PG8_BAR; PG8_SCHED;
            PG8_LDB(B0, 1, 0); PG8_LDB(B1, 1, 1); PG8_SCHED; PG8_LDA(At, 1, 0); PG8_STAGE(PG8_SA(0, 1), a2 + hstep, voffA);
            PG8_WAIT_V(8); PG8_WAIT_L(0); PG8_BAR; PG8_MMA(0, 0, At, B0); PG8_MMA(0, 1, At, B1); PG8_BAR; PG8_SCHED;
            PG8_LDA(At, 1, 1); PG8_STAGE(PG8_SB(1, 0), b3, voffB); PG8_STAGE(PG8_SB(1, 1), b3 + hstep, voffB); PG8_STAGE(PG8_SA(1, 0), a3, voffA);
            PG8_WAIT_V(8); PG8_WAIT_L(0); PG8_BAR; PG8_MMA(1, 0, At, B0); PG8_MMA(1, 1, At, B1); PG8_BAR; PG8_SCHED;
            } else {
            PG8_LDB(B0, 0, 0); PG8_SCHED; PG8_LDA(At, 0, 0); PG8_STAGE(PG8_SA(1, 1), a1 + hstep, voffA);
            PG8_WAIT_L(8); PG8_BAR; PG8_WAIT_L(0); PG8_MMA(0, 0, At, B0); PG8_BAR; PG8_SCHED;
            PG8_LDB(B1, 0, 1); PG8_STAGE(PG8_SB(0, 0), b2, voffB);
            PG8_BAR; PG8_WAIT_L(0); PG8_MMA(0, 1, At, B1); PG8_BAR;
            PG8_LDA(At, 0, 1); PG8_STAGE(PG8_SA(0, 0), a2, voffA);
            PG8_BAR; PG8_WAIT_L(0); PG8_MMA(1, 0, At, B0); PG8_BAR; PG8_SCHED;
            PG8_STAGE(PG8_SB(0, 1), b2 + hstep, voffB);
            PG8_WAIT_V(6); PG8_BAR; PG8_MMA(1, 1, At, B1); PG8_BAR;
            PG8_LDB(B0, 1, 0); PG8_SCHED; PG8_LDA(At, 1, 0); PG8_STAGE(PG8_SA(0, 1), a2 + hstep, voffA);
            PG8_WAIT_L(8); PG8_BAR; PG8_WAIT_L(0); PG8_MMA(0, 0, At, B0); PG8_BAR; PG8_SCHED;
            PG8_LDB(B1, 1, 1); PG8_STAGE(PG8_SB(1, 0), b3, voffB);
            PG8_BAR; PG8_WAIT_L(0); PG8_MMA(0, 1, At, B1); PG8_BAR;
            PG8_LDA(At, 1, 1); PG8_STAGE(PG8_SA(1, 0), a3, voffA);
            PG8_BAR; PG8_WAIT_L(0); PG8_MMA(1, 0, At, B0); PG8_BAR; PG8_SCHED;
            PG8_STAGE(PG8_SB(1, 1), b3 + hstep, voffB);
            PG8_WAIT_V(6); PG8_BAR; PG8_MMA(1, 1, At, B1); PG8_BAR;
            }
        }
        if constexpr (ALIGN_EPI) { if (wr == 0) PG8_BAR; }
        if constexpr (!Epi::AFTER_DRAIN) { E(acc, cur, wr, wc, fr, fq); S.done(cur); }
        if (!has_next) break;
#pragma unroll
        for (int a = 0; a < 2; ++a)
#pragma unroll
            for (int b = 0; b < 2; ++b)
#pragma unroll
                for (int m = 0; m < 4; ++m)
#pragma unroll
                    for (int n = 0; n < 2; ++n) acc[a][b][m][n] = (f32x4){0.f, 0.f, 0.f, 0.f};
        cur = nxt; cA = nA; cB = nB; ++ui;
        if constexpr (ALIGN_EPI) { if (wr == 1) PG8_BAR; }
    }
    PG8_WAIT_V(0);
    if constexpr (!ALIGN_EPI) { if (wr == 0) PG8_BAR; }
    PG8_BAR;
    if constexpr (Epi::AFTER_DRAIN) { E.fused(acc, cur, wr, wc, fr, fq, lds, wid, lane); S.done(cur); }
#undef PG8_SA
#undef PG8_SB
#undef PG8_STAGE
#undef PG8_LDA
#undef PG8_LDB
#undef PG8_MMA
#undef PG8_WAIT_V
#undef PG8_WAIT_L
#undef PG8_BAR
#undef PG8_SCHED
}
}

__device__ __forceinline__ v4u pack8(const f32x4& a, const f32x4& b) { v4u w; w.x = pg8::cvt_pk_bf16(a[0], a[1]); w.y = pg8::cvt_pk_bf16(a[2], a[3]); w.z = pg8::cvt_pk_bf16(b[0], b[1]); w.w = pg8::cvt_pk_bf16(b[2], b[3]); return w; }
struct EpiInproj {
    static constexpr bool PERM = true, AFTER_DRAIN = false;
    bf16 *Qd, *Kd, *Vd, *MQ, *MK, *MV, *MO; const f32x2* rope;
    __device__ __forceinline__ void operator()(const f32x4 (&acc)[2][2][4][2], const pg8::Unit& u, int wr, int wc, int fr, int fq) const {
        const int pn = u.pn; const bool lat = u.pm < 128;
        if (!lat && (pn < 2 || pn >= 10)) return;
        const int b = lat ? (u.pm >> 5) : (u.pm - 128);
        const int tbase = lat ? ((u.pm & 31) * 256) : 0;
        const int within0 = wc * 32 + fq * 8;
        if (pn < 4) {
            const bool isq = pn < 2; const int hb = (pn & 1) * 2; const bool rowaxis = (wc & 1) == 0, low = fq < 2; const int j0 = (fq & 1) * 8;
#pragma unroll
            for (int ai = 0; ai < 2; ++ai)
#pragma unroll
                for (int m = 0; m < 4; ++m) {
                    const int rloc = ai * 128 + wr * 64 + m * 16 + fr, t = tbase + rloc;
                    f32x4 cs[4];
                    if (lat) { const int pos = rowaxis ? (t >> 6) : (128 + (t & 63)); const f32x4* rp = (const f32x4*)(rope + pos * 16 + j0);
#pragma unroll
                        for (int q = 0; q < 4; ++q) cs[q] = rp[q]; }
#pragma unroll
                    for (int bj = 0; bj < 2; ++bj) {
                        f32x4 v0 = acc[ai][bj][m][0], v1 = acc[ai][bj][m][1];
                        if (lat) {
                            f32x4 p0, p1;
#pragma unroll
                            for (int e = 0; e < 4; ++e) { p0[e] = __shfl_xor(v0[e], 32); p1[e] = __shfl_xor(v1[e], 32); }
                            if (low) { p0 = -p0; p1 = -p1; }
                            v0[0] = v0[0] * cs[0][0] + p0[0] * cs[0][1]; v0[1] = v0[1] * cs[0][2] + p0[1] * cs[0][3];
                            v0[2] = v0[2] * cs[1][0] + p0[2] * cs[1][1]; v0[3] = v0[3] * cs[1][2] + p0[3] * cs[1][3];
                            v1[0] = v1[0] * cs[2][0] + p1[0] * cs[2][1]; v1[1] = v1[1] * cs[2][2] + p1[1] * cs[2][3];
                            v1[2] = v1[2] * cs[3][0] + p1[2] * cs[3][1]; v1[3] = v1[3] * cs[3][2] + p1[3] * cs[3][3];
                        }
                        if (isq) { v0 = v0 * C2; v1 = v1 * C2; *(v4u*)(Qd + ((size_t)(b * NH + hb + bj) * T + t) * 128 + within0) = pack8(v0, v1); }
                        else *(v4u*)(Kd + ((size_t)(b * NH + hb + bj) * TK + (lat ? CT + t : rloc)) * 128 + within0) = pack8(v0, v1);
                    }
                }
        } else if (pn == 6 || pn == 7) {
            bf16* dst = pn == 6 ? MQ : MK; const float sc = pn == 6 ? 1.f : 0.125f; const int i0 = 32 * (wc & 1) + 8 * fq;
#pragma unroll
            for (int ai = 0; ai < 2; ++ai)
#pragma unroll
                for (int m = 0; m < 4; ++m) { const int rloc = ai * 128 + wr * 64 + m * 16 + fr, kidx = lat ? CT + tbase + rloc : rloc;
#pragma unroll
                    for (int bj = 0; bj < 2; ++bj) { const int h = 2 * bj + (wc >> 1);
                        *(v4u*)(dst + ((size_t)(b * NH + h) * TK + kidx) * 64 + i0) = pack8(acc[ai][bj][m][0] * sc, acc[ai][bj][m][1] * sc); } }
        } else if (pn < 10) {
            bf16* dst = pn < 6 ? Vd : MV; const int hb = (pn & 1) * 2;
#pragma unroll
            for (int ai = 0; ai < 2; ++ai)
#pragma unroll
                for (int m = 0; m < 4; ++m) { const int rloc = ai * 128 + wr * 64 + m * 16 + fr, kidx = lat ? CT + tbase + rloc : rloc;
#pragma unroll
                    for (int bj = 0; bj < 2; ++bj)
                        *(v4u*)(dst + ((size_t)(b * NH + hb + bj) * TK + kidx) * 128 + within0) = pack8(acc[ai][bj][m][0], acc[ai][bj][m][1]); }
        } else {
#pragma unroll
            for (int ai = 0; ai < 2; ++ai)
#pragma unroll
                for (int m = 0; m < 4; ++m) { const int row = u.pm * 256 + ai * 128 + wr * 64 + m * 16 + fr;
#pragma unroll
                    for (int bj = 0; bj < 2; ++bj) { f32x4 v0 = acc[ai][bj][m][0], v1 = acc[ai][bj][m][1];
#pragma unroll
                        for (int e = 0; e < 4; ++e) { v0[e] = __builtin_amdgcn_rcpf(1.f + __expf(-v0[e])); v1[e] = __builtin_amdgcn_rcpf(1.f + __expf(-v1[e])); }
                        *(v4u*)(MO + (size_t)row * 512 + (pn - 10) * 256 + bj * 128 + within0) = pack8(v0, v1); } }
        }
    }
};
struct EpiOutproj {
    static constexpr bool PERM = true, AFTER_DRAIN = false;
    const float* x; float* out; bf16* A2; const float* mod; const float* n2g; float* rowsq;
    __device__ __forceinline__ void operator()(const f32x4 (&acc)[2][2][4][2], const pg8::Unit& u, int wr, int wc, int fr, int fq) const {
        const int b = u.pm >> 5; const float* modr = mod + (size_t)b * 6 * D; const int col0 = u.pn * 256 + wc * 32 + fq * 8;
        f32x4 g1v[2][2], gs2[2][2];
#pragma unroll
        for (int bj = 0; bj < 2; ++bj)
#pragma unroll
            for (int n = 0; n < 2; ++n) { const int c = col0 + bj * 128 + 4 * n; g1v[bj][n] = *(const f32x4*)(modr + 2 * D + c);
                gs2[bj][n] = *(const f32x4*)(n2g + c) * (*(const f32x4*)(modr + 4 * D + c) + 1.0f); }
#pragma unroll
        for (int ai = 0; ai < 2; ++ai)
#pragma unroll
            for (int m = 0; m < 4; ++m) { const int row = u.pm * 256 + ai * 128 + wr * 64 + m * 16 + fr; float ss = 0.f;
#pragma unroll
                for (int bj = 0; bj < 2; ++bj) { const size_t o = (size_t)row * D + col0 + bj * 128;
                    const f32x4 x0 = *(const f32x4*)(x + o) + g1v[bj][0] * acc[ai][bj][m][0], x1 = *(const f32x4*)(x + o + 4) + g1v[bj][1] * acc[ai][bj][m][1];
                    *(f32x4*)(out + o) = x0; *(f32x4*)(out + o + 4) = x1;
                    ss += (x0[0] * x0[0] + x0[1] * x0[1]) + (x0[2] * x0[2] + x0[3] * x0[3]) + (x1[0] * x1[0] + x1[1] * x1[1]) + (x1[2] * x1[2] + x1[3] * x1[3]);
                    *(v4u*)(A2 + o) = pack8(x0 * gs2[bj][0], x1 * gs2[bj][1]); }
                ss += __shfl_xor(ss, 16); ss += __shfl_xor(ss, 32);
                if (fq == 0) atomicAdd(rowsq + row, ss); }
    }
};
struct EpiFc1 {
    static constexpr bool PERM = true, AFTER_DRAIN = false;
    bf16* Hh; const float* bias1; const float* rowsq;
    __device__ __forceinline__ void operator()(const f32x4 (&acc)[2][2][4][2], const pg8::Unit& u, int wr, int wc, int fr, int fq) const {
        const int b = u.pm >> 5; const int col0 = u.pn * 256 + wc * 32 + fq * 8;
        f32x4 bv[2][2];
#pragma unroll
        for (int bj = 0; bj < 2; ++bj)
#pragma unroll
            for (int n = 0; n < 2; ++n) bv[bj][n] = *(const f32x4*)(bias1 + (size_t)b * FF + col0 + bj * 128 + 4 * n);
#pragma unroll
        for (int ai = 0; ai < 2; ++ai)
#pragma unroll
            for (int m = 0; m < 4; ++m) { const int row = u.pm * 256 + ai * 128 + wr * 64 + m * 16 + fr;
                const float rstd = 1.0f / sqrtf(rowsq[row] * (1.f / D) + EPS);
#pragma unroll
                for (int bj = 0; bj < 2; ++bj) { f32x4 v0 = acc[ai][bj][m][0] * rstd + bv[bj][0], v1 = acc[ai][bj][m][1] * rstd + bv[bj][1];
#pragma unroll
                    for (int e = 0; e < 4; ++e) { const float a0 = fmaxf(v0[e], 0.f), a1 = fmaxf(v1[e], 0.f); v0[e] = a0 * a0; v1[e] = a1 * a1; }
                    *(v4u*)(Hh + (size_t)row * FF + col0 + bj * 128) = pack8(v0, v1); } }
    }
};
struct EpiFc2 {
    static constexpr bool PERM = true, AFTER_DRAIN = false;
    float* out; const float* mod; float* rowsq;
    __device__ __forceinline__ void operator()(const f32x4 (&acc)[2][2][4][2], const pg8::Unit& u, int wr, int wc, int fr, int fq) const {
        const int b = u.pm >> 5; const float* modr = mod + (size_t)b * 6 * D; const int col0 = u.pn * 256 + wc * 32 + fq * 8;
        f32x4 g2v[2][2];
#pragma unroll
        for (int bj = 0; bj < 2; ++bj)
#pragma unroll
            for (int n = 0; n < 2; ++n) g2v[bj][n] = *(const f32x4*)(modr + 5 * D + col0 + bj * 128 + 4 * n);
#pragma unroll
        for (int ai = 0; ai < 2; ++ai)
#pragma unroll
            for (int m = 0; m < 4; ++m) { const int row = u.pm * 256 + ai * 128 + wr * 64 + m * 16 + fr; float ss = 0.f;
#pragma unroll
                for (int bj = 0; bj < 2; ++bj) { const size_t o = (size_t)row * D + col0 + bj * 128;
                    const f32x4 x0 = *(const f32x4*)(out + o) + g2v[bj][0] * acc[ai][bj][m][0], x1 = *(const f32x4*)(out + o + 4) + g2v[bj][1] * acc[ai][bj][m][1];
                    *(f32x4*)(out + o) = x0; *(f32x4*)(out + o + 4) = x1;
                    ss += (x0[0] * x0[0] + x0[1] * x0[1]) + (x0[2] * x0[2] + x0[3] * x0[3]) + (x1[0] * x1[0] + x1[1] * x1[1]) + (x1[2] * x1[2] + x1[3] * x1[3]); }
                ss += __shfl_xor(ss, 16); ss += __shfl_xor(ss, 32);
                if (fq == 0) atomicAdd(rowsq + row, ss); }
    }
};

__device__ __forceinline__ void naive_mlstm(Frame& F) {
    LAS float* ks = (LAS float*)F.lds;
    LAS float* qs = ks + 64 * 64;
    LAS float* vs = qs + 64 * 64;
    LAS float* fg = vs + 64 * 128;
    LAS float* ig = fg + 64;
    const int tid = F.tid, v = tid >> 2, dq = (tid & 3) * 16;
    for (int item = F.vcu; item < 32; item += F.G) {
        const int bh = item >> 1, dir = item & 1;
        float C[16], n[16];
#pragma unroll
        for (int e = 0; e < 16; ++e) { C[e] = 0.f; n[e] = 0.f; }
        float* Hout = (dir ? F.HB : F.HF) + (size_t)bh * T * 128;
        for (int blk = 0; blk < TK / 64; ++blk) {
            int c;
            if (!dir) c = blk; else c = (blk < 4) ? (3 - blk) : (TK / 64 - 1 - (blk - 4));
            const int kidx0 = c * 64; const bool lat = c >= 4;
            const size_t base64 = ((size_t)bh * TK + kidx0) * 64, base128 = ((size_t)bh * TK + kidx0) * 128;
            for (int i = tid; i < 64 * 64; i += 512) { ks[i] = bf2f(F.MK[base64 + i]); qs[i] = bf2f(F.MQ[base64 + i]); }
            for (int i = tid; i < 64 * 128; i += 512) vs[i] = bf2f(F.MV[base128 + i]);
            if (tid < 64) { const float* g = F.gates + ((size_t)bh * TK + kidx0 + tid) * 4 + dir * 2; ig[tid] = __expf(g[0]); fg[tid] = __expf(g[1]); }
            __syncthreads();
            for (int step = 0; step < 64; ++step) {
                const int s = dir ? 63 - step : step;
                const float f = fg[s], iw = ig[s], vv = vs[s * 128 + v] * iw;
                float num = 0.f, den = 0.f;
#pragma unroll
                for (int e = 0; e < 16; ++e) { const float kk = ks[s * 64 + dq + e], qq = qs[s * 64 + dq + e];
                    C[e] = f * C[e] + vv * kk; n[e] = f * n[e] + iw * kk; num += C[e] * qq; den += n[e] * qq; }
                if (lat) {
                    num += __shfl_xor(num, 1); num += __shfl_xor(num, 2); den += __shfl_xor(den, 1); den += __shfl_xor(den, 2);
                    if ((tid & 3) == 0) Hout[(size_t)(kidx0 - CT + s) * 128 + v] = num / fmaxf(fabsf(den), 1.f);
                }
            }
            __syncthreads();
        }
    }
}
__device__ __forceinline__ void naive_mlstm_combine(Frame& F) {
    const int gw = F.vcu * NWAVES + F.wave, NGW = F.G * NWAVES, lane = F.lane;
    for (int rid = gw; rid < NTOK * NH; rid += NGW) {
        const int row = rid >> 2, h = rid & 3, b = row >> 13, t = row & (T - 1);
        const size_t o = ((size_t)(b * NH + h) * T + t) * 128 + 2 * lane;
        const float a0 = F.HF[o] + F.HB[o], a1 = F.HF[o + 1] + F.HB[o + 1];
        const float r = 1.0f / sqrtf(wave_sum(a0 * a0 + a1 * a1) * (1.f / 128.f) + EPS);
        const float* g = F.in[I_MLNG] + h * 128 + 2 * lane;
        const unsigned mo = *(const unsigned*)(F.MO + (size_t)row * 512 + h * 128 + 2 * lane);
        *(unsigned*)(F.MIX + (size_t)row * D + 512 + h * 128 + 2 * lane) = pk2(a0 * r * g[0] * bflo(mo), a1 * r * g[1] * bfhi(mo));
    }
}

__device__ __forceinline__ void naive_attn(Frame& F) {
    LAS float* qs = (LAS float*)F.lds + F.wave * 64;
    const int gw = F.vcu * NWAVES + F.wave, NGW = F.G * NWAVES, lane = F.lane;
    float lam;
    { const float s1 = wave_sum(F.in[I_LQ1][lane] * F.in[I_LK1][lane]), s2 = wave_sum(F.in[I_LQ2][lane] * F.in[I_LK2][lane]); lam = __expf(s1) - __expf(s2) + LAMBDA_INIT; }
    for (int rid = gw; rid < NB * NH * T; rid += NGW) {
        const int bh = rid >> 13, t = rid & (T - 1), b = bh >> 2, h = bh & 3;
        float o0 = 0.f, o1 = 0.f;
        for (int map = 0; map < 2; ++map) {
            qs[lane] = bf2f(F.Qd[((size_t)bh * T + t) * 128 + map * 64 + lane]);
            asm volatile("s_waitcnt lgkmcnt(0)" ::: "memory");
            float m = -1e30f, l = 0.f, a0 = 0.f, a1 = 0.f;
            for (int ch = 0; ch < TK / 64; ++ch) {
                const bf16* kp = F.Kd + ((size_t)bh * TK + ch * 64 + lane) * 128 + map * 64;
                float s = 0.f;
#pragma unroll
                for (int d8 = 0; d8 < 8; ++d8) { const v4u kv = *(const v4u*)(kp + d8 * 8); const f32x4 qa = *(const LAS f32x4*)(qs + d8 * 8), qb = *(const LAS f32x4*)(qs + d8 * 8 + 4);
                    s += bflo(kv.x) * qa.x + bfhi(kv.x) * qa.y + bflo(kv.y) * qa.z + bfhi(kv.y) * qa.w + bflo(kv.z) * qb.x + bfhi(kv.z) * qb.y + bflo(kv.w) * qb.z + bfhi(kv.w) * qb.w; }
                const float mn = fmaxf(m, wave_max(s)), alpha = exp2f(m - mn), p = exp2f(s - mn);
                l = l * alpha + wave_sum(p); a0 *= alpha; a1 *= alpha; m = mn;
                const bf16* vp = F.Vd + ((size_t)bh * TK + ch * 64) * 128 + 2 * lane;
#pragma unroll 8
                for (int kk = 0; kk < 64; ++kk) { const float pk = __shfl(p, kk); const unsigned vv = *(const unsigned*)(vp + (size_t)kk * 128); a0 += pk * bflo(vv); a1 += pk * bfhi(vv); }
            }
            const float il = 1.f / l;
            if (map == 0) { o0 = a0 * il; o1 = a1 * il; } else { o0 -= lam * a0 * il; o1 -= lam * a1 * il; }
        }
        const float r = 1.0f / sqrtf(wave_sum(o0 * o0 + o1 * o1) * (1.f / 128.f) + EPS);
        const float* g = F.in[I_SUBLN] + 2 * lane;
        *(unsigned*)(F.MIX + (size_t)(b * T + t) * D + h * 128 + 2 * lane) = pk2(o0 * r * g[0] * (1.f - LAMBDA_INIT), o1 * r * g[1] * (1.f - LAMBDA_INIT));
    }
}


namespace da {
using bf16x8 = __attribute__((ext_vector_type(8))) short;
using s16x4  = __attribute__((ext_vector_type(4))) short;
using f32x16 = __attribute__((ext_vector_type(16))) float;
using u32x4  = __attribute__((ext_vector_type(4))) unsigned;
constexpr int KVBLK = 64;
constexpr size_t SHM_V = KVBLK * 128 * 2, SHM_K = KVBLK * 128 * 2;
constexpr float THR2 = 8.f * 1.4426950408889634f;
#define KSWZ(row, colB) ((row) * 256 + ((colB) ^ (((row) & 7) << 4)))
#define SBAR() __builtin_amdgcn_sched_barrier(0)
__device__ __forceinline__ int crow(int r, int hi) { return (r & 3) + 8 * (r >> 2) + 4 * hi; }
__device__ __forceinline__ unsigned cvtpk(float lo, float hi) { unsigned r; asm volatile("v_cvt_pk_bf16_f32 %0, %1, %2" : "=v"(r) : "v"(lo), "v"(hi)); return r; }
__device__ __forceinline__ void partialSM(f32x16& p0, f32x16& p1, float& m_reg, float& mn, float& alpha) {
  float pmax = p0[0]; for (int r = 1; r < 16; ++r) pmax = fmaxf(pmax, p0[r]); for (int r = 0; r < 16; ++r) pmax = fmaxf(pmax, p1[r]);
  { auto rr = __builtin_amdgcn_permlane32_swap(__float_as_uint(pmax), __float_as_uint(pmax), false, false);
    pmax = fmaxf(__uint_as_float(rr[0]), __uint_as_float(rr[1])); }
  if (__builtin_expect(__all(pmax - m_reg <= THR2), 1)) { mn = m_reg; alpha = 1.f; }
  else { mn = fmaxf(m_reg, pmax); alpha = __builtin_amdgcn_exp2f(m_reg - mn); m_reg = mn; }
  for (int r = 0; r < 16; ++r) p0[r] = p0[r] - mn; for (int r = 0; r < 16; ++r) p1[r] = p1[r] - mn;
  for (int r = 0; r < 16; ++r) p0[r] = __builtin_amdgcn_exp2f(p0[r]);
}
__device__ __forceinline__ void finishSM(f32x16& p0, f32x16& p1, float alpha, float& l_reg, bf16x8& pa0, bf16x8& pa1, bf16x8& pa2, bf16x8& pa3) {
  for (int r = 0; r < 16; ++r) p1[r] = __builtin_amdgcn_exp2f(p1[r]);
  float ps = 0; for (int r = 0; r < 16; ++r) ps += p0[r]; for (int r = 0; r < 16; ++r) ps += p1[r];
  { auto rr = __builtin_amdgcn_permlane32_swap(__float_as_uint(ps), __float_as_uint(ps), false, false);
    ps = __uint_as_float(rr[0]) + __uint_as_float(rr[1]); }
  l_reg = l_reg * alpha + ps;
#define PK4(P, BASE, OUT) do { unsigned a0 = cvtpk(P[BASE + 0], P[BASE + 1]), a1 = cvtpk(P[BASE + 2], P[BASE + 3]);   \
    unsigned b0 = cvtpk(P[BASE + 4], P[BASE + 5]), b1 = cvtpk(P[BASE + 6], P[BASE + 7]);                              \
    auto r0 = __builtin_amdgcn_permlane32_swap(a0, b0, false, false); auto r1 = __builtin_amdgcn_permlane32_swap(a1, b1, false, false); \
    u32x4 w = {r0[0], r1[0], r0[1], r1[1]}; OUT = *reinterpret_cast<bf16x8*>(&w); } while (0)
  PK4(p0, 0, pa0); PK4(p0, 8, pa1); PK4(p1, 0, pa2); PK4(p1, 8, pa3);
#undef PK4
}
__device__ __forceinline__ void qkt(f32x16& p0, f32x16& p1, const char* Ks, const bf16x8* qr, int r32, int hi, int mapB) {
  p0 = f32x16{}; p1 = f32x16{};
  for (int d0 = 0; d0 < 4; ++d0) { int cb = mapB + (d0 * 16 + hi * 8) * 2;
    bf16x8 b0 = *reinterpret_cast<const bf16x8*>(Ks + KSWZ(r32, cb));
    bf16x8 b1 = *reinterpret_cast<const bf16x8*>(Ks + KSWZ(32 + r32, cb));
    p0 = __builtin_amdgcn_mfma_f32_32x32x16_bf16(b0, qr[d0], p0, 0, 0, 0);
    p1 = __builtin_amdgcn_mfma_f32_32x32x16_bf16(b1, qr[d0], p1, 0, 0, 0); }
}
__device__ __forceinline__ int v_st(int k, int c) { const int kk = (k & ~0xC) | ((k & 4) << 1) | ((k & 8) >> 1); return ((kk >> 3) * 4 + (c >> 5)) * 512 + ((kk & 7) * 32 + (c & 31)) * 2; }
__device__ __forceinline__ int v_rd_base(int lane) { return ((lane & 3) << 3) | (((lane >> 2) & 3) << 6) | (((lane >> 4) & 1) << 5) | (((lane >> 5) & 1) << 8); }
constexpr int v_rd_off(int d0, int ks, int half) { return d0 * 512 + ks * 4096 + half * 2048; }
template <int OFF> __device__ __forceinline__ s16x4 tr_read(int vb) {
  s16x4 r; asm volatile("ds_read_b64_tr_b16 %0, %1 offset:%2" : "=&v"(r) : "v"(vb), "i"(OFF) : "memory"); return r;
}
template <int D0> __device__ __forceinline__ void pv_one(f32x16& od, int vb, bf16x8 pa0, bf16x8 pa1, bf16x8 pa2, bf16x8 pa3) {
  const s16x4 l0 = tr_read<v_rd_off(D0, 0, 0)>(vb), h0 = tr_read<v_rd_off(D0, 0, 1)>(vb), l1 = tr_read<v_rd_off(D0, 1, 0)>(vb), h1 = tr_read<v_rd_off(D0, 1, 1)>(vb);
  const s16x4 l2 = tr_read<v_rd_off(D0, 2, 0)>(vb), h2 = tr_read<v_rd_off(D0, 2, 1)>(vb), l3 = tr_read<v_rd_off(D0, 3, 0)>(vb), h3 = tr_read<v_rd_off(D0, 3, 1)>(vb);
  asm volatile("s_waitcnt lgkmcnt(0)" ::: "memory"); SBAR();
#define PK(L, H) (bf16x8){L[0], L[1], L[2], L[3], H[0], H[1], H[2], H[3]}
  od = __builtin_amdgcn_mfma_f32_32x32x16_bf16(pa0, PK(l0, h0), od, 0, 0, 0);
  od = __builtin_amdgcn_mfma_f32_32x32x16_bf16(pa1, PK(l1, h1), od, 0, 0, 0);
  od = __builtin_amdgcn_mfma_f32_32x32x16_bf16(pa2, PK(l2, h2), od, 0, 0, 0);
  od = __builtin_amdgcn_mfma_f32_32x32x16_bf16(pa3, PK(l3, h3), od, 0, 0, 0);
#undef PK
}
__device__ __forceinline__ void pv_d0(f32x16* o, int vb, bf16x8 pa0, bf16x8 pa1, bf16x8 pa2, bf16x8 pa3) {
  pv_one<0>(o[0], vb, pa0, pa1, pa2, pa3); pv_one<1>(o[1], vb, pa0, pa1, pa2, pa3); pv_one<2>(o[2], vb, pa0, pa1, pa2, pa3); pv_one<3>(o[3], vb, pa0, pa1, pa2, pa3);
}
__device__ __forceinline__ void da_unit(const bf16* __restrict__ Qb, const bf16* __restrict__ Kh, const bf16* __restrict__ Vh, bf16* __restrict__ Mx,
                                        const float* __restrict__ subg, float lam, int seq, char* lds) {
  const int tid = threadIdx.x, wid = tid >> 6, lane = tid & 63, r32 = lane & 31, hi = lane >> 5, map = wid >> 2, wq = wid & 3;
  bf16* V_lds = (bf16*)lds; bf16* K_lds = (bf16*)(lds + 2 * SHM_V);
  float* ws = (float*)(lds + 2 * SHM_V + 2 * SHM_K) + wid * 64; float* li_l = ws; float* al_l = ws + 32;
  float m_reg = -1e30f, l_reg = 0; f32x16 o[4] = {}; bf16x8 qr[4];
  const bf16* Qw = Qb + (long)(wq * 32 + r32) * 128 + map * 64 + hi * 8;
#pragma unroll
  for (int d0 = 0; d0 < 4; ++d0) qr[d0] = *reinterpret_cast<const bf16x8*>(Qw + d0 * 16);
  const int mapB = map * 128;
  const int sr = tid >> 4, sc = (tid & 15) * 8, vst0 = v_st(sr, sc), vst1 = v_st(32 + sr, sc);
  const int vb0 = (int)(uintptr_t)V_lds + v_rd_base(lane);
  struct { bf16x8 vs0, vs1, ks0, ks1; } sr_[1];
#define SLOAD(i, k0) do { sr_[i].vs0 = *reinterpret_cast<const bf16x8*>(&Vh[(long)((k0) + sr) * 128 + sc]); sr_[i].vs1 = *reinterpret_cast<const bf16x8*>(&Vh[(long)((k0) + 32 + sr) * 128 + sc]); \
    sr_[i].ks0 = *reinterpret_cast<const bf16x8*>(&Kh[(long)((k0) + sr) * 128 + sc]); sr_[i].ks1 = *reinterpret_cast<const bf16x8*>(&Kh[(long)((k0) + 32 + sr) * 128 + sc]); } while (0)
#define SWRITE(b, i) do { *(bf16x8*)((char*)V_lds + (b) * SHM_V + vst0) = sr_[i].vs0;          \
    *(bf16x8*)((char*)V_lds + (b) * SHM_V + vst1) = sr_[i].vs1; int kc = sc * 2;               \
    *(bf16x8*)((char*)K_lds + (b) * SHM_K + KSWZ(sr, kc)) = sr_[i].ks0;                       \
    *(bf16x8*)((char*)K_lds + (b) * SHM_K + KSWZ(32 + sr, kc)) = sr_[i].ks1; } while (0)
#define SWAIT() asm volatile("s_waitcnt vmcnt(0)" ::: "memory")
#define RESC(a) do { if (__any((a) < 1.f)) { if (hi == 0) al_l[r32] = (a); asm volatile("s_waitcnt lgkmcnt(0)" ::: "memory"); \
    for (int d = 0; d < 4; ++d) for (int r = 0; r < 16; ++r) o[d][r] *= al_l[crow(r, hi)]; } } while (0)
  f32x16 pA0, pA1, pB0, pB1; float mnA, mnB, alA, alB; bf16x8 pa0, pa1, pa2, pa3; const int NT = seq / KVBLK;
  constexpr int SE = 0, SO = 0;
  SLOAD(SE, 0); asm volatile("s_waitcnt vmcnt(0)" ::: "memory"); SWRITE(0, SE); __syncthreads();
  qkt(pA0, pA1, (const char*)K_lds, qr, r32, hi, mapB); partialSM(pA0, pA1, m_reg, mnA, alA);
  SLOAD(SO, KVBLK);
  SWAIT(); SWRITE(1, SO); __syncthreads();
  for (int j = 1; j + 1 < NT; j += 2) {
    SBAR(); qkt(pB0, pB1, (const char*)K_lds + SHM_K, qr, r32, hi, mapB);
    finishSM(pA0, pA1, alA, l_reg, pa0, pa1, pa2, pa3); SBAR();
    SLOAD(SO, (j + 1) * KVBLK); SBAR();
    pv_d0(o, vb0, pa0, pa1, pa2, pa3); partialSM(pB0, pB1, m_reg, mnB, alB);
    __syncthreads(); SWAIT(); SWRITE(0, SE);
    RESC(alB); __syncthreads();
    SBAR(); qkt(pA0, pA1, (const char*)K_lds, qr, r32, hi, mapB);
    finishSM(pB0, pB1, alB, l_reg, pa0, pa1, pa2, pa3); SBAR();
    SLOAD(SE, (j + 2) * KVBLK); SBAR();
    pv_d0(o, vb0 + (int)SHM_V, pa0, pa1, pa2, pa3); partialSM(pA0, pA1, m_reg, mnA, alA);
    __syncthreads(); SWAIT(); SWRITE(1, SO);
    RESC(alA); __syncthreads();
  }
  SBAR(); qkt(pB0, pB1, (const char*)K_lds + SHM_K, qr, r32, hi, mapB);
  finishSM(pA0, pA1, alA, l_reg, pa0, pa1, pa2, pa3); SBAR();
  pv_d0(o, vb0, pa0, pa1, pa2, pa3); partialSM(pB0, pB1, m_reg, mnB, alB);
  __syncthreads(); RESC(alB);
  finishSM(pB0, pB1, alB, l_reg, pa0, pa1, pa2, pa3); SBAR();
  pv_d0(o, vb0 + (int)SHM_V, pa0, pa1, pa2, pa3);
  int lane_e = threadIdx.x & 63; asm volatile("" : "+v"(lane_e));
  if (hi == 0) li_l[r32] = l_reg; asm volatile("s_waitcnt lgkmcnt(0)" ::: "memory");
  float rli[16];
#pragma unroll
  for (int r = 0; r < 16; ++r) rli[r] = __builtin_amdgcn_rcpf(li_l[crow(r, hi)]);
  __syncthreads();
  float* X = (float*)lds + (wq * 64 + lane_e) * 64;
  if (map == 1) {
#pragma unroll
    for (int d0 = 0; d0 < 4; ++d0)
#pragma unroll
      for (int r = 0; r < 16; ++r) X[d0 * 16 + r] = o[d0][r] * rli[r] * lam;
  }
  __syncthreads();
  if (map == 0) {
    float ssq[16];
#pragma unroll
    for (int r = 0; r < 16; ++r) ssq[r] = 0.f;
#pragma unroll
    for (int d0 = 0; d0 < 4; ++d0)
#pragma unroll
      for (int r = 0; r < 16; ++r) { o[d0][r] = o[d0][r] * rli[r] - X[d0 * 16 + r]; ssq[r] += o[d0][r] * o[d0][r]; }
#pragma unroll
    for (int r = 0; r < 16; ++r) {
#pragma unroll
      for (int off = 1; off < 32; off <<= 1) ssq[r] += __shfl_xor(ssq[r], off);
      ssq[r] = (1.f - LAMBDA_INIT) / sqrtf(ssq[r] * (1.f / 128.f) + EPS);
    }
    char* st = lds + 65536 + 2048 + wq * 8704;
#pragma unroll
    for (int d0 = 0; d0 < 4; ++d0) { const float g = subg[d0 * 32 + (lane_e & 31)];
#pragma unroll
      for (int r = 0; r < 16; ++r) *(bf16*)(st + crow(r, lane_e >> 5) * 272 + (d0 * 32 + (lane_e & 31)) * 2) = (bf16)f2bf(o[d0][r] * ssq[r] * g); }
    asm volatile("s_waitcnt lgkmcnt(0)" ::: "memory");
    bf16* Mw = Mx + (long)(wq * 32 + (lane_e >> 4)) * D + (lane_e & 15) * 8;
#pragma unroll
    for (int it = 0; it < 8; ++it) { const u32x4 v = *(const u32x4*)(st + (it * 4 + (lane_e >> 4)) * 272 + (lane_e & 15) * 16); *(u32x4*)(Mw + (long)(it * 4) * D) = v; }
  }
  __syncthreads();
#undef SLOAD
#undef SWRITE
#undef SWAIT
#undef RESC
}
#undef KSWZ
#undef SBAR
}

__device__ __forceinline__ void fast_attn(Frame& F) {
    float lam;
    { const int l = F.lane; const float s1 = wave_sum(F.in[I_LQ1][l] * F.in[I_LK1][l]), s2 = wave_sum(F.in[I_LQ2][l] * F.in[I_LK2][l]); lam = __expf(s1) - __expf(s2) + LAMBDA_INIT; lam = __builtin_bit_cast(float, __builtin_amdgcn_readfirstlane(__builtin_bit_cast(int, lam))); }
    for (int u = F.vcu * 4; u < NB * NH * (T / 128); u += F.G * 4)
        for (int i = 0; i < 4; ++i) {
            const int uu = u + i, bh = uu >> 6, qb = uu & 63, b = bh >> 2, h = bh & 3;
            da::da_unit(F.Qd + ((size_t)bh * T + qb * 128) * 128, F.Kd + (size_t)bh * TK * 128, F.Vd + (size_t)bh * TK * 128,
                        F.MIX + ((size_t)b * T + qb * 128) * D + h * 128, F.in[I_SUBLN], lam, TK, (char*)(F.lds));
        }
}

__device__ __forceinline__ void p_final(Frame& F) {
    const int gw = F.vcu * NWAVES + F.wave, NGW = F.G * NWAVES, lane = F.lane;
    for (int row = gw; row < NTOK; row += NGW) {
        const float rstd = 1.0f / sqrtf(F.rowsq2[row] * (1.f / D) + EPS);
#pragma unroll
        for (int j = 0; j < 4; ++j) { const int col = 4 * lane + 256 * j; f32x4* p = (f32x4*)(F.out + (size_t)row * D + col);
            const f32x4 g = *(const f32x4*)(F.in[I_FING] + col); *p = (*p * rstd) * g; }
    }
}


#define XB_TMO      128
#define XB_XCNT(j)  (256  + 64 * (j))
#define XB_XSUB(j)  (1280 + 64 * (j))
#define XB_XGEN(j)  (2304 + 64 * (j))
#define XB_TOP      3328
#define XB_TOPGEN   3392
#define XCD_BAR_WORDS 3456
#define XB_SPIN_CAP (1u << 22)
constexpr int CW_BAR = 4096;
constexpr int MISC_OFF = 131072 + 320;
__device__ __forceinline__ unsigned xb_ld(unsigned* p)              { return __hip_atomic_load(p, __ATOMIC_RELAXED, __HIP_MEMORY_SCOPE_AGENT); }
__device__ __forceinline__ unsigned xb_add(unsigned* p, unsigned v) { return __hip_atomic_fetch_add(p, v, __ATOMIC_RELAXED, __HIP_MEMORY_SCOPE_AGENT); }
__device__ __forceinline__ unsigned xb_xcc_id() { return (unsigned)__builtin_amdgcn_s_getreg((3 << 11) | 20) & 0xFu; }
#define XB_SPIN(cond, bar) do { unsigned _sp = 0; while (cond) { __builtin_amdgcn_s_sleep(1); \
    if ((++_sp & 255u) == 0u) { if (xb_ld(&(bar)[XB_TMO])) break; if (_sp > XB_SPIN_CAP) { atomicAdd(&(bar)[XB_TMO], 1u); break; } } } } while (0)
struct XcdBarrier { unsigned* bar; unsigned x; volatile LAS unsigned* st; };
__device__ __forceinline__ XcdBarrier xcd_barrier_post(unsigned* bar, volatile LAS unsigned* st) {
    XcdBarrier b; b.bar = bar; b.x = xb_xcc_id(); b.st = st;
    if (threadIdx.x == 0) (void)xb_add(&bar[XB_XCNT(b.x)], 1u);
    return b;
}
__device__ __forceinline__ void xcd_barrier_complete(unsigned* bar, unsigned x, unsigned& nloc, unsigned& nx) {
    const unsigned G = gridDim.x * gridDim.y * gridDim.z;
    unsigned sum, cnt, mine, sp = 0u;
    for (;;) {
        sum = 0u; cnt = 0u; mine = 0u;
#pragma unroll
        for (unsigned j = 0; j < 16; ++j) { const unsigned c = xb_ld(&bar[XB_XCNT(j)]); sum += c; cnt += (c > 0u) ? 1u : 0u; mine = (j == x) ? c : mine; }
        if (sum == G) break;
        __builtin_amdgcn_s_sleep(1);
        if ((++sp & 255u) == 0u) { if (xb_ld(&bar[XB_TMO])) break; if (sp > XB_SPIN_CAP) { atomicAdd(&bar[XB_TMO], 1u); break; } }
    }
    nloc = mine > 0u ? mine : 1u; nx = cnt > 0u ? cnt : 1u;
}
__device__ __forceinline__ void xcd_barrier(const XcdBarrier& b) {
    asm volatile("s_waitcnt vmcnt(0)" ::: "memory");
    __syncthreads();
    if (threadIdx.x == 0) {
        unsigned* bar = b.bar;
        __builtin_amdgcn_s_waitcnt(0);
        unsigned nloc = b.st[0], nx = b.st[1];
        if (nloc == 0u) { xcd_barrier_complete(bar, b.x, nloc, nx); b.st[0] = nloc; b.st[1] = nx; }
        const unsigned old = xb_add(&bar[XB_XSUB(b.x)], 1u);
        const unsigned gen = old / nloc;
        if (old + 1u == (gen + 1u) * nloc) {
            __builtin_amdgcn_fence(__ATOMIC_RELEASE, "agent");
            asm volatile("s_waitcnt vmcnt(0)" ::: "memory");
            const unsigned og = xb_add(&bar[XB_TOP], 1u);
            const unsigned tg = og / nx;
            if (og + 1u == (tg + 1u) * nx) xb_add(&bar[XB_TOPGEN], 1u);
            else XB_SPIN(xb_ld(&bar[XB_TOPGEN]) == tg, bar);
            __builtin_amdgcn_fence(__ATOMIC_ACQUIRE, "agent");
            xb_add(&bar[XB_XGEN(b.x)], 1u);
            asm volatile("s_waitcnt vmcnt(0)" ::: "memory");
        } else {
            XB_SPIN(xb_ld(&bar[XB_XGEN(b.x)]) == gen, bar);
            __builtin_amdgcn_fence(__ATOMIC_ACQUIRE, "agent");
            asm volatile("s_waitcnt vmcnt(0)" ::: "memory");
        }
    }
    __syncthreads();
}

constexpr int NPHASE = 9;
__global__ void __launch_bounds__(NWAVES * 64, 2) fwd_kernel(Args args) {
    extern __shared__ __attribute__((aligned(16))) unsigned char lds_raw[];
    Frame F;
    F.lds = (LAS unsigned char*)lds_raw;
    F.tid = threadIdx.x; F.lane = F.tid & 63; F.wave = __builtin_amdgcn_readfirstlane(F.tid >> 6);
    F.G = gridDim.x; { const int bx = blockIdx.x; F.vcu = (F.G % 8 == 0) ? (bx % 8) * (F.G / 8) + bx / 8 : bx; }
#pragma unroll
    for (int i = 0; i < 20; ++i) F.in[i] = args.in[i];
    F.out = args.out; F.ws = args.ws; unsigned char* ws = args.ws;
    F.mod = (float*)(ws + WS_MOD); F.rope = (f32x2*)(ws + WS_ROPE); F.bias1 = (float*)(ws + WS_BIAS1); F.wgt = (float*)(ws + WS_WGT); F.gates = (float*)(ws + WS_G);
    F.rowsq1 = (float*)(ws + WS_ROWSQ1); F.rowsq2 = (float*)(ws + WS_ROWSQ2);
    F.WinT = (bf16*)(ws + WS_WIN); F.WoT = (bf16*)(ws + WS_WO); F.W1T = (bf16*)(ws + WS_W1); F.W2T = (bf16*)(ws + WS_W2);
    F.XM = (bf16*)(ws + WS_XM); F.A2 = (bf16*)(ws + WS_XM);
    F.Qd = (bf16*)(ws + WS_Q); F.Kd = (bf16*)(ws + WS_K); F.Vd = (bf16*)(ws + WS_V); F.MQ = (bf16*)(ws + WS_MQ); F.MK = (bf16*)(ws + WS_MK); F.MV = (bf16*)(ws + WS_MV); F.MO = (bf16*)(ws + WS_MO);
    F.HF = (float*)(ws + WS_DC); F.HB = (float*)(ws + WS_DC + 64 * MiB);
    F.MIX = (bf16*)(ws + WS_CIN);
    F.Hh = (bf16*)(ws + WS_H);
    const int lo = args.ph_lo, hi = args.ph_hi;
    for (int u = F.tid; u < (LDS_BYTES - 131072) / 4; u += NWAVES * 64) ((LAS unsigned*)(F.lds + 131072))[u] = 0u;
    __syncthreads();
    XcdBarrier bar = xcd_barrier_post((unsigned*)(ws + WS_CTL) + CW_BAR + args.li * XCD_BAR_WORDS, (volatile LAS unsigned*)(F.lds + MISC_OFF));
#define IN(k) (refresh_ids(F), (lo <= (k) && (k) < hi))
#define SEAM(k) do { if (IN(k) && IN((k) + 1)) xcd_barrier(bar); } while (0)
    if (IN(0)) p0_prologue(F);
    SEAM(0);
    if (IN(1)) p1_rows(F);
    SEAM(1);
#if FAST_GEMM & 1
    if (IN(2)) { pg8::Gemm g{F.XM, F.WinT, MROWS, INP, D}; pg8::StaticOrder S; S.init(MROWS, INP, F.G, (int)blockIdx.x);
        EpiInproj E{F.Qd, F.Kd, F.Vd, F.MQ, F.MK, F.MV, F.MO, F.rope}; pg8::gemm_phase<EpiInproj, pg8::StaticOrder, true, true>(F.lds, g, S, E); }
#else
    if (IN(2)) naive_gemm(F, F.XM, D, MROWS, F.in[I_WIN], INC, INP, D, NaiveInprojEpi{});
#endif
    SEAM(2);
    if (IN(3)) naive_mlstm(F);
    SEAM(3);
#if FAST_ATTN
    if (IN(4)) { fast_attn(F); refresh_ids(F); naive_mlstm_combine(F); }
#else
    if (IN(4)) { naive_attn(F); naive_mlstm_combine(F); }
#endif
    SEAM(4);
#if FAST_GEMM & 2
    if (IN(5)) { pg8::Gemm g{F.MIX, F.WoT, NTOK, D, D}; pg8::StaticOrder S; S.init(NTOK, D, F.G, (int)blockIdx.x);
        EpiOutproj E{F.in[I_X], F.out, F.A2, F.mod, F.in[I_N2G], F.rowsq1}; pg8::gemm_phase<EpiOutproj, pg8::StaticOrder, true, true>(F.lds, g, S, E); }
#else
    if (IN(5)) naive_gemm(F, F.MIX, D, NTOK, F.in[I_WOUT], D, D, D, NaiveOutprojEpi{});
#endif
    SEAM(5);
#if FAST_GEMM & 4
    if (IN(6)) { pg8::Gemm g{F.A2, F.W1T, NTOK, FF, D}; pg8::StaticOrder S; S.init(NTOK, FF, F.G, (int)blockIdx.x);
        EpiFc1 E{F.Hh, F.bias1, F.rowsq1}; pg8::gemm_phase<EpiFc1, pg8::StaticOrder, true, true>(F.lds, g, S, E); }
#else
    if (IN(6)) naive_gemm(F, F.A2, D, NTOK, F.in[I_WFC1], FF, FF, D, NaiveFc1Epi{});
#endif
    SEAM(6);
#if FAST_GEMM & 8
    if (IN(7)) { pg8::Gemm g{F.Hh, F.W2T, NTOK, D, FF}; pg8::StaticOrder S; S.init(NTOK, D, F.G, (int)blockIdx.x);
        EpiFc2 E{F.out, F.mod, F.rowsq2}; pg8::gemm_phase<EpiFc2, pg8::StaticOrder, true, true>(F.lds, g, S, E); }
#else
    if (IN(7)) naive_gemm(F, F.Hh, FF, NTOK, F.in[I_WFC2], D, D, FF, NaiveFc2Epi{});
#endif
    SEAM(7);
    if (IN(8)) p_final(F);
#undef IN
#undef SEAM
}

extern "C" void kernel_launch(void* const* d_in, const int* in_sizes, int n_in, void* d_out, int out_size, void* d_ws, size_t ws_size, hipStream_t stream) {
    static int grid = 0;
    if (grid == 0) {
        if (n_in != 20 || in_sizes[0] != NTOK * D || out_size != NTOK * D || ws_size < WS_END) { fprintf(stderr, "kernel_launch: unexpected shapes n_in %d in0 %d out %d ws %zu\n", n_in, n_in > 0 ? in_sizes[0] : -1, out_size, ws_size); grid = -1; return; }
        int dev = 0, cus = 0, per_cu = 0;
        if (hipGetDevice(&dev) != hipSuccess || hipDeviceGetAttribute(&cus, hipDeviceAttributeMultiprocessorCount, dev) != hipSuccess) { grid = -1; return; }
        if (hipFuncSetAttribute((const void*)fwd_kernel, hipFuncAttributeMaxDynamicSharedMemorySize, LDS_BYTES) != hipSuccess) { fprintf(stderr, "kernel_launch: hipFuncSetAttribute failed\n"); grid = -1; return; }
        if (hipOccupancyMaxActiveBlocksPerMultiprocessor(&per_cu, (const void*)fwd_kernel, NWAVES * 64, LDS_BYTES) != hipSuccess || per_cu < 1) { fprintf(stderr, "kernel_launch: occupancy query says %d\n", per_cu); per_cu = 1; }
        (void)hipGetLastError();
        grid = cus;
    }
    if (grid < 0) return;
    (void)hipMemsetAsync((char*)d_ws + WS_CTL, 0, CTL_ZERO_BYTES, stream);
    Args a{};
    for (int i = 0; i < 20; ++i) a.in[i] = (const float*)d_in[i];
    a.out = (float*)d_out; a.ws = (unsigned char*)d_ws;
    a.ph_lo = 0; a.ph_hi = NPHASE; a.li = 0;
    hipLaunchKernelGGL(fwd_kernel, dim3(grid), dim3(NWAVES * 64), LDS_BYTES, stream, a);
}
```

```cpp
#include <hip/hip_runtime.h>
#include <cstdio>
#include <cstdint>

constexpr int NB = 4, T = 8192, CT = 256, TK = T + CT, D = 1024, FF = 4096, NH = 4;
constexpr int NTOK = NB * T, NCTX = NB * CT, MROWS = NTOK + NCTX;
constexpr int INC = 3088, INP = 3072;
constexpr float EPS = 1e-6f;
constexpr float LAMBDA_INIT = 0.2f;
constexpr float C2 = 0.125f * 1.4426950408889634f;

constexpr size_t MiB = 1u << 20;
constexpr size_t WS_CTL = 0, CTL_ZERO_BYTES = 1 * MiB;
constexpr size_t WS_ROWSQ1 = 256 * 1024, WS_ROWSQ2 = 384 * 1024;
constexpr size_t WS_MOD = 1 * MiB;
constexpr size_t WS_ROPE = WS_MOD + 128 * 1024;
constexpr size_t WS_BIAS1 = WS_ROPE + 32 * 1024;
constexpr size_t WS_WGT = WS_BIAS1 + 64 * 1024;
constexpr size_t WS_SCL = WS_WGT + 64 * 1024;
constexpr size_t WS_MIN = WS_SCL + 64 * 1024;
constexpr size_t WS_WIN = 2 * MiB, WS_WO = 9 * MiB, WS_W1 = 11 * MiB, WS_W2 = 19 * MiB;
constexpr size_t WS_G = 27 * MiB;
constexpr size_t WS_XM = 32 * MiB;
constexpr size_t WS_Q = 98 * MiB, WS_K = 130 * MiB, WS_V = 163 * MiB, WS_MQ = 196 * MiB, WS_MK = 213 * MiB, WS_MV = 230 * MiB, WS_MO = 263 * MiB;
constexpr size_t WS_DC = 296 * MiB;
constexpr size_t WS_CIN = 430 * MiB;
constexpr size_t WS_MIX = 296 * MiB + 0;
constexpr size_t WS_H = 98 * MiB;
constexpr size_t WS_END = 512 * MiB;

typedef unsigned short bf16;
typedef unsigned v4u __attribute__((ext_vector_type(4)));
typedef unsigned v2u __attribute__((ext_vector_type(2)));
typedef float f32x4 __attribute__((ext_vector_type(4)));
typedef float f32x2 __attribute__((ext_vector_type(2)));
#define LAS __attribute__((address_space(3)))

__device__ __forceinline__ unsigned f2bf(float f) { unsigned u = __builtin_bit_cast(unsigned, f); return (u + 0x7fffu + ((u >> 16) & 1u)) >> 16; }
__device__ __forceinline__ unsigned pk2(float lo, float hi) { return f2bf(lo) | (f2bf(hi) << 16); }
__device__ __forceinline__ float bf2f(unsigned short b) { return __builtin_bit_cast(float, (unsigned)b << 16); }
__device__ __forceinline__ float bflo(unsigned w) { return __builtin_bit_cast(float, w << 16); }
__device__ __forceinline__ float bfhi(unsigned w) { return __builtin_bit_cast(float, w & 0xffff0000u); }
__device__ __forceinline__ float wave_sum(float v) {
#pragma unroll
    for (int o = 1; o < 64; o <<= 1) v += __shfl_xor(v, o);
    return v;
}
__device__ __forceinline__ float wave_max(float v) {
#pragma unroll
    for (int o = 1; o < 64; o <<= 1) v = fmaxf(v, __shfl_xor(v, o));
    return v;
}

#ifndef FAST_MLSTM
#define FAST_MLSTM 1
#endif
#ifndef FAST_ATTN
#define FAST_ATTN 1
#endif
#ifndef FAST_GEMM
#define FAST_GEMM 15
#endif
constexpr int NWAVES = 8;
constexpr int LDS_BYTES = 147456;

struct Args {
    const float* in[20]; float* out; unsigned char* ws; int ph_lo, ph_hi, li, pad;
};
enum { I_X = 0, I_C, I_CTX, I_CCTX, I_WADA, I_BADA, I_N1G, I_N2G, I_WIN, I_BGATE, I_LQ1, I_LK1, I_LQ2, I_LK2, I_SUBLN, I_MLNG, I_WOUT, I_WFC1, I_WFC2, I_FING };

struct Frame {
    LAS unsigned char* lds;
    int tid, lane, wave, vcu, G;
    const float* in[20]; float* out; unsigned char* ws;
    float* mod; f32x2* rope; float* bias1; float* wgt; float* gates; float* rowsq1; float* rowsq2;
    bf16 *WinT, *WoT, *W1T, *W2T, *XM, *Qd, *Kd, *Vd, *MQ, *MK, *MV, *MO, *MIX, *A2, *Hh;
    float *HF, *HB;
};

__device__ __forceinline__ void refresh_ids(Frame& F) { int l = (int)__builtin_amdgcn_mbcnt_hi(~0u, __builtin_amdgcn_mbcnt_lo(~0u, 0u)); asm volatile("" : "+v"(l)); F.lane = l; F.tid = F.wave * 64 + l; }

__device__ __forceinline__ void gemv_item(Frame& F, const LAS float* a, int R, const float* W, int ldw, int col0, const float* bias, float* out, int ldo, LAS float* red) {
    const int w = F.wave, lane = F.lane, c = lane & 31, kp = lane >> 5;
    float acc[5] = {0.f, 0.f, 0.f, 0.f, 0.f};
    const float* wp = W + (size_t)(128 * w + kp) * ldw + col0 + c;
#pragma unroll 8
    for (int kk = 0; kk < 64; ++kk) {
        const float wv = wp[(size_t)(2 * kk) * ldw];
        const int k = 128 * w + 2 * kk + kp;
#pragma unroll
        for (int r = 0; r < 5; ++r) if (r < R) acc[r] += a[r * 1024 + k] * wv;
    }
#pragma unroll
    for (int r = 0; r < 5; ++r) acc[r] += __shfl_xor(acc[r], 32);
    if (lane < 32) {
#pragma unroll
        for (int r = 0; r < 5; ++r) red[(w * 5 + r) * 32 + lane] = acc[r];
    }
    __syncthreads();
    if (F.tid < R * 32) {
        const int r = F.tid >> 5, cc = F.tid & 31; float s = 0.f;
#pragma unroll
        for (int ww = 0; ww < 8; ++ww) s += red[(ww * 5 + r) * 32 + cc];
        out[(size_t)r * ldo + col0 + cc] = s + (bias ? bias[col0 + cc] : 0.f);
    }
    __syncthreads();
}

__device__ __forceinline__ void p0_transpose_item(const float* W, int K, int ldw, int nblk, bf16* WT, LAS float* scr, int item, int lane) {
    const int kb = item / nblk, nb = item % nblk, k0 = 64 * kb, n0 = 32 * nb;
#pragma unroll 8
    for (int i = 0; i < 32; ++i) { const int kk = 2 * i + (lane >> 5); scr[kk * 33 + (lane & 31)] = W[(size_t)(k0 + kk) * ldw + n0 + (lane & 31)]; }
    asm volatile("s_waitcnt lgkmcnt(0)" ::: "memory");
    const int c = lane & 7;
#pragma unroll
    for (int j = 0; j < 4; ++j) { const int n = (lane >> 3) + 8 * j; const LAS float* s = scr + (8 * c) * 33 + n;
        v4u o; o.x = pk2(s[0 * 33], s[1 * 33]); o.y = pk2(s[2 * 33], s[3 * 33]); o.z = pk2(s[4 * 33], s[5 * 33]); o.w = pk2(s[6 * 33], s[7 * 33]);
        *(v4u*)(WT + (size_t)(n0 + n) * K + k0 + 8 * c) = o; }
    asm volatile("s_waitcnt lgkmcnt(0)" ::: "memory");
}

__device__ __forceinline__ void p0_prologue(Frame& F) {
    LAS float* sa = (LAS float*)F.lds;
    LAS float* red = sa + 5 * 1024;
    for (int i = F.tid; i < 5 * 1024; i += 512) { const int r = i >> 10, k = i & 1023; const float c = r < 4 ? F.in[I_C][r * 1024 + k] : F.in[I_CCTX][k]; sa[i] = c / (1.f + __expf(-c)); }
    __syncthreads();
    for (int item = F.vcu; item < 192; item += F.G) gemv_item(F, sa, 5, F.in[I_WADA], 6 * D, item * 32, F.in[I_BADA], F.mod, 6 * D, red);
    LAS float* scr = (LAS float*)(F.lds + 32768 + F.wave * 8448);
    const int gw = F.vcu * NWAVES + F.wave, NGW = F.G * NWAVES;
    constexpr int I_IN = (D / 64) * (INP / 32), I_O = (D / 64) * (D / 32), I_1 = (D / 64) * (FF / 32), I_2 = (FF / 64) * (D / 32);
    for (int it = gw; it < I_IN + I_O + I_1 + I_2; it += NGW) {
        int r = it;
        if (r < I_IN) { p0_transpose_item(F.in[I_WIN], D, INC, INP / 32, F.WinT, scr, r, F.lane); continue; } r -= I_IN;
        if (r < I_O) { p0_transpose_item(F.in[I_WOUT], D, D, D / 32, F.WoT, scr, r, F.lane); continue; } r -= I_O;
        if (r < I_1) { p0_transpose_item(F.in[I_WFC1], D, FF, FF / 32, F.W1T, scr, r, F.lane); continue; } r -= I_1;
        p0_transpose_item(F.in[I_WFC2], FF, D, D / 32, F.W2T, scr, r, F.lane);
    }
    const int gt = F.vcu * 512 + F.tid, NGT = F.G * 512;
    for (int idx = gt; idx < 192 * 16; idx += NGT) {
        const int p = idx >> 4, j = idx & 15; const int pos = p < 128 ? p : p - 128;
        double inv = 1.0; for (int q = 0; q < j; ++q) inv *= 0.5623413251903491;
        const float ang = (float)pos * (float)inv;
        double a = (double)ang; const double TWO_PI = 6.283185307179586476925;
        const double n = __builtin_rint(a / TWO_PI); a -= n * TWO_PI;
        const double a2 = a * a; double sn = 0.0, cs = 0.0, ts = a, tc = 1.0;
        for (int q = 0; q < 14; ++q) { sn += ts; cs += tc; tc = -tc * a2 / (double)((2 * q + 1) * (2 * q + 2)); ts = -ts * a2 / (double)((2 * q + 2) * (2 * q + 3)); }
        F.rope[idx] = (f32x2){(float)cs, (float)sn};
    }
    for (int idx = gt; idx < 16 * 1024; idx += NGT) { const int g = idx >> 10, k = idx & 1023; F.wgt[idx] = F.in[I_WIN][(size_t)k * INC + INP + g]; }
}

__device__ __forceinline__ float log_sigmoid(float x) { return fminf(x, 0.f) - log1pf(__expf(-fabsf(x))); }
__device__ __forceinline__ void p1_rows(Frame& F) {
    LAS float* wg = (LAS float*)F.lds;
    LAS float* sa = (LAS float*)(F.lds + 65536);
    LAS float* red = (LAS float*)(F.lds + 65536 + 16384);
    for (int i = F.tid; i < 16 * 1024; i += 512) wg[i] = F.wgt[i];
    for (int i = F.tid; i < 4 * 1024; i += 512) sa[i] = F.mod[(i >> 10) * 6 * D + 3 * D + (i & 1023)];
    __syncthreads();
    for (int item = F.vcu; item < 128; item += F.G) gemv_item(F, sa, 4, F.in[I_WFC1], FF, item * 32, nullptr, F.bias1, FF, red);
    const int gw = F.vcu * NWAVES + F.wave, NGW = F.G * NWAVES, lane = F.lane;
    const float* g1n = F.in[I_N1G];
    for (int row = gw; row < MROWS; row += NGW) {
        const bool lat = row < NTOK; const int b5 = lat ? (row >> 13) : 4;
        const float* src = lat ? F.in[I_X] + (size_t)row * D : F.in[I_CTX] + (size_t)(row - NTOK) * D;
        const float* modr = F.mod + (size_t)b5 * 6 * D;
        f32x4 v[4]; float ss = 0.f;
#pragma unroll
        for (int j = 0; j < 4; ++j) { v[j] = *(const f32x4*)(src + 4 * lane + 256 * j); ss += (v[j].x * v[j].x + v[j].y * v[j].y) + (v[j].z * v[j].z + v[j].w * v[j].w); }
        const float rstd = 1.0f / sqrtf(wave_sum(ss) * (1.f / D) + EPS);
        float acc[16]; f32x4 xm[4];
#pragma unroll
        for (int j = 0; j < 4; ++j) {
            const int col = 4 * lane + 256 * j;
            const f32x4 gg = *(const f32x4*)(g1n + col), sc = *(const f32x4*)(modr + D + col), sh = *(const f32x4*)(modr + col);
            xm[j] = (v[j] * rstd) * gg * (sc + 1.0f) + sh;
            v2u o; o.x = pk2(xm[j].x, xm[j].y); o.y = pk2(xm[j].z, xm[j].w);
            *(v2u*)(F.XM + (size_t)row * D + col) = o;
        }
#pragma unroll
        for (int g = 0; g < 16; ++g) {
            float a = 0.f;
#pragma unroll
            for (int j = 0; j < 4; ++j) { const f32x4 w = *(const LAS f32x4*)(wg + g * 1024 + 4 * lane + 256 * j); a += (xm[j].x * w.x + xm[j].y * w.y) + (xm[j].z * w.z + xm[j].w * w.w); }
            acc[g] = a;
            asm volatile("" ::: "memory");
        }
#pragma unroll
        for (int i = 0; i < 8; ++i) { const bool hi = lane & 32; const float mine = hi ? acc[i + 8] : acc[i], send = hi ? acc[i] : acc[i + 8]; acc[i] = mine + __shfl_xor(send, 32); }
#pragma unroll
        for (int i = 0; i < 4; ++i) { const bool hi = lane & 16; const float mine = hi ? acc[i + 4] : acc[i], send = hi ? acc[i] : acc[i + 4]; acc[i] = mine + __shfl_xor(send, 16); }
#pragma unroll
        for (int i = 0; i < 2; ++i) { const bool hi = lane & 8; const float mine = hi ? acc[i + 2] : acc[i], send = hi ? acc[i] : acc[i + 2]; acc[i] = mine + __shfl_xor(send, 8); }
        { const bool hi = lane & 4; const float mine = hi ? acc[1] : acc[0], send = hi ? acc[0] : acc[1]; acc[0] = mine + __shfl_xor(send, 4); }
        acc[0] += __shfl_xor(acc[0], 2); acc[0] += __shfl_xor(acc[0], 1);
        if ((lane & 3) == 0) {
            const int g = ((lane >> 5) & 1) * 8 + ((lane >> 4) & 1) * 4 + ((lane >> 3) & 1) * 2 + ((lane >> 2) & 1);
            const float val = acc[0] + F.in[I_BGATE][g]; const int type = g >> 2, h = g & 3;
            const float o = (type & 1) ? log_sigmoid(val) : val;
            const int b = lat ? (row >> 13) : ((row - NTOK) >> 8), kidx = lat ? (CT + (row & (T - 1))) : ((row - NTOK) & (CT - 1));
            F.gates[((size_t)(b * NH + h) * TK + kidx) * 4 + type] = o;
        }
    }
}

template <class Epi>
__device__ __forceinline__ void naive_gemm(Frame& F, const bf16* A, int lda, int M, const float* W, int ldw, int N, int K, const Epi& E) {
    LAS float* As = (LAS float*)F.lds;
    LAS float* Ws = As + 16 * 132;
    LAS float* Ct = (LAS float*)(F.lds + 32768);
    const int tid = F.tid, ty = tid >> 4, tx = tid & 15;
    const int tn_n = N / 128, ntiles = (M / 128) * tn_n;
    for (int tile = F.vcu; tile < ntiles; tile += F.G) {
        const int tm = tile / tn_n, tn = tile % tn_n;
        float acc[4][8];
#pragma unroll
        for (int i = 0; i < 4; ++i)
#pragma unroll
            for (int j = 0; j < 8; ++j) acc[i][j] = 0.f;
        const int ar = tid >> 2, ak = (tid & 3) * 4, wk = tid >> 5, wn = (tid & 31) * 4;
        const bf16* ap = A + (size_t)(tm * 128 + ar) * lda + ak;
        const float* wp = W + (size_t)wk * ldw + tn * 128 + wn;
        for (int k0 = 0; k0 < K; k0 += 16) {
            const v2u av = *(const v2u*)(ap + k0);
            const f32x4 wv = *(const f32x4*)(wp + (size_t)k0 * ldw);
            As[(ak + 0) * 132 + ar] = bflo(av.x); As[(ak + 1) * 132 + ar] = bfhi(av.x); As[(ak + 2) * 132 + ar] = bflo(av.y); As[(ak + 3) * 132 + ar] = bfhi(av.y);
            *(LAS f32x4*)(Ws + wk * 128 + wn) = wv;
            __syncthreads();
#pragma unroll
            for (int kk = 0; kk < 16; ++kk) {
                const f32x4 a = *(const LAS f32x4*)(As + kk * 132 + ty * 4);
                const f32x4 w0 = *(const LAS f32x4*)(Ws + kk * 128 + tx * 8), w1 = *(const LAS f32x4*)(Ws + kk * 128 + tx * 8 + 4);
                const float aa[4] = {a.x, a.y, a.z, a.w}; const float ww[8] = {w0.x, w0.y, w0.z, w0.w, w1.x, w1.y, w1.z, w1.w};
#pragma unroll
                for (int i = 0; i < 4; ++i)
#pragma unroll
                    for (int j = 0; j < 8; ++j) acc[i][j] += aa[i] * ww[j];
            }
            __syncthreads();
        }
#pragma unroll
        for (int i = 0; i < 4; ++i)
#pragma unroll
            for (int j = 0; j < 8; ++j) Ct[(ty * 4 + i) * 129 + tx * 8 + j] = acc[i][j];
        __syncthreads();
        E.tile(F, Ct, tm * 128, tn * 128);
        __syncthreads();
    }
}

__device__ __forceinline__ void row_decode(int row, bool& lat, int& b, int& t, int& kidx) {
    lat = row < NTOK;
    if (lat) { b = row >> 13; t = row & (T - 1); kidx = CT + t; } else { const int j = row - NTOK; b = j >> 8; t = -1; kidx = j & (CT - 1); }
}

struct NaiveInprojEpi {
    __device__ __forceinline__ void tile(Frame& F, const LAS float* Ct, int row0, int col0) const {
        for (int idx = F.tid; idx < 128 * 128; idx += 512) {
            const int r = idx >> 7, c = idx & 127, row = row0 + r, col = col0 + c;
            bool lat; int b, t, kidx; row_decode(row, lat, b, t, kidx);
            float val = Ct[r * 129 + c];
            if (col < 1024) {
                const bool isq = col < 512; const int cc = col & 511, h = cc >> 7, within = cc & 127, i = within & 63;
                if (isq && !lat) continue;
                if (lat) {
                    const bool lowhalf = (i & 31) < 16; const float partner = Ct[r * 129 + (lowhalf ? c + 16 : c - 16)];
                    const int pos = (i < 32) ? (t >> 6) : (128 + (t & 63)); const f32x2 cs = F.rope[pos * 16 + (i & 15)];
                    val = val * cs.x + (lowhalf ? -partner : partner) * cs.y;
                }
                if (isq) F.Qd[((size_t)(b * NH + h) * T + t) * 128 + within] = (bf16)f2bf(val * C2);
                else F.Kd[((size_t)(b * NH + h) * TK + kidx) * 128 + within] = (bf16)f2bf(val);
            } else if (col < 1536) { const int cc = col - 1024, h = cc >> 7, within = cc & 127; F.Vd[((size_t)(b * NH + h) * TK + kidx) * 128 + within] = (bf16)f2bf(val);
            } else if (col < 1792) { const int cc = col - 1536, h = cc >> 6, i = cc & 63; F.MQ[((size_t)(b * NH + h) * TK + kidx) * 64 + i] = (bf16)f2bf(val);
            } else if (col < 2048) { const int cc = col - 1792, h = cc >> 6, i = cc & 63; F.MK[((size_t)(b * NH + h) * TK + kidx) * 64 + i] = (bf16)f2bf(val * 0.125f);
            } else if (col < 2560) { const int cc = col - 2048, h = cc >> 7, within = cc & 127; F.MV[((size_t)(b * NH + h) * TK + kidx) * 128 + within] = (bf16)f2bf(val);
            } else { if (!lat) continue; F.MO[(size_t)row * 512 + (col - 2560)] = (bf16)f2bf(1.f / (1.f + __expf(-val))); }
        }
    }
};
struct NaiveOutprojEpi {
    __device__ __forceinline__ void tile(Frame& F, const LAS float* Ct, int row0, int col0) const {
        for (int rr = 0; rr < 16; ++rr) {
            const int r = F.wave * 16 + rr, row = row0 + r, b = row >> 13; const float* modr = F.mod + (size_t)b * 6 * D;
            float ss = 0.f;
#pragma unroll
            for (int e = 0; e < 2; ++e) { const int c = F.lane + 64 * e, col = col0 + c;
                const float x1 = F.in[I_X][(size_t)row * D + col] + modr[2 * D + col] * Ct[r * 129 + c];
                F.out[(size_t)row * D + col] = x1; ss += x1 * x1;
                F.A2[(size_t)row * D + col] = (bf16)f2bf(x1 * F.in[I_N2G][col] * (1.f + modr[4 * D + col])); }
            ss = wave_sum(ss); if (F.lane == 0) atomicAdd(F.rowsq1 + row, ss);
        }
    }
};
struct NaiveFc1Epi {
    __device__ __forceinline__ void tile(Frame& F, const LAS float* Ct, int row0, int col0) const {
        for (int idx = F.tid; idx < 128 * 128; idx += 512) {
            const int r = idx >> 7, c = idx & 127, row = row0 + r, col = col0 + c, b = row >> 13;
            const float rstd = 1.0f / sqrtf(F.rowsq1[row] * (1.f / D) + EPS);
            float v = rstd * Ct[r * 129 + c] + F.bias1[b * FF + col]; v = fmaxf(v, 0.f);
            F.Hh[(size_t)row * FF + col] = (bf16)f2bf(v * v);
        }
    }
};
struct NaiveFc2Epi {
    __device__ __forceinline__ void tile(Frame& F, const LAS float* Ct, int row0, int col0) const {
        for (int rr = 0; rr < 16; ++rr) {
            const int r = F.wave * 16 + rr, row = row0 + r, b = row >> 13; const float* modr = F.mod + (size_t)b * 6 * D;
            float ss = 0.f;
#pragma unroll
            for (int e = 0; e < 2; ++e) { const int c = F.lane + 64 * e, col = col0 + c;
                const float x2 = F.out[(size_t)row * D + col] + modr[5 * D + col] * Ct[r * 129 + c];
                F.out[(size_t)row * D + col] = x2; ss += x2 * x2; }
            ss = wave_sum(ss); if (F.lane == 0) atomicAdd(F.rowsq2 + row, ss);
        }
    }
};


namespace pg8 {
#define PG8_LAS __attribute__((address_space(3)))
typedef unsigned short bf16_t;
typedef short bf16x8 __attribute__((ext_vector_type(8)));
typedef float f32x4 __attribute__((ext_vector_type(4)));
typedef unsigned u32x4 __attribute__((ext_vector_type(4)));
constexpr int BM = 256, BK = 64, HALF = 128, HTB = HALF * BK * 2  , STAGE_BYTES = 8 * HTB, NXCD = 8, WGM = 8;

__host__ __device__ __forceinline__ int lds_byte(int r, int c) { const int st = (r >> 4) * 2 + (c >> 5), rr = r & 15, cc = c & 31, ob = rr * 64 + cc * 2; return st * 1024 + (ob ^ (((ob >> 9) & 1) << 5)); }
__host__ __device__ __forceinline__ void stage_rc(int b, int& R, int& C) { const int st = b / 1024, sb = b % 1024, swz = sb ^ (((sb >> 9) & 1) << 5); R = (st >> 1) * 16 + swz / 64; C = (st & 1) * 32 + (swz % 64) / 2; }
__host__ __device__ __forceinline__ int perm32(int rho) { const int n = rho >> 4, i = rho & 15; return 8 * (i >> 2) + 4 * n + (i & 3); }

struct Unit { int pm, pn; };
struct Gemm { const bf16_t* A; const bf16_t* Bt; int M, N, K; };

struct StaticOrder {
    int nM, nN, nwg, G, c;
    __host__ __device__ void init(int M, int N, int G_, int c_) { nM = M / BM; nN = N / BM; nwg = nM * nN; G = G_; c = c_; }
    __host__ __device__ bool next(int i, Unit& u) const {
        const long L = (long)i * G + c; if (L >= nwg) return false;
        int wgid = (int)L; { const int q = nwg / NXCD, r = nwg % NXCD, xcd = wgid % NXCD, off = wgid / NXCD; wgid = (xcd < r ? xcd * (q + 1) : r * (q + 1) + (xcd - r) * q) + off; }
        const int nig = WGM * nN, gid = wgid / nig, fm = gid * WGM, gsz = (nM - fm) < WGM ? (nM - fm) : WGM;
        u.pm = fm + ((wgid % nig) % gsz); u.pn = (wgid % nig) / gsz; return true;
    }
    __device__ __forceinline__ void a_ready(const Unit&) const {}
    __device__ __forceinline__ void done(const Unit&) const {}
};

__device__ __forceinline__ unsigned cvt_pk_bf16(float lo, float hi) { unsigned r; asm volatile("v_cvt_pk_bf16_f32 %0, %1, %2" : "=v"(r) : "v"(lo), "v"(hi)); return r; }
template <class Epi, class Sched, bool ALIGN_EPI = false, bool SP2 = false>
__device__ __forceinline__ void gemm_phase(PG8_LAS unsigned char* lds, const Gemm g, const Sched& S, const Epi& E) {
    const int tid = threadIdx.x, wid = __builtin_amdgcn_readfirstlane(tid >> 6), lane = tid & 63, wr = wid >> 2, wc = wid & 3, fr = lane & 15, fq = lane >> 4;
    const int K = g.K, nt = K / BK;
    unsigned voffA[2], voffB[2];
#pragma unroll
    for (int i = 0; i < 2; ++i) { int R, C; stage_rc(tid * 16 + i * 8192, R, C); const int Rb = Epi::PERM ? ((R & ~31) + perm32(R & 31)) : R;
        voffA[i] = (unsigned)(R * K + C) * 2u; voffB[i] = (unsigned)(Rb * K + C) * 2u; }
    const size_t kstep = (size_t)(BK * 2);
    const size_t hstep = (size_t)HALF * K * 2;
    const size_t tstep = 2 * hstep;
    const unsigned ldsw = (unsigned)wid * 1024u;
    const int aoff = lds_byte(wr * 64 + fr, fq * 8), boff = lds_byte(wc * 32 + fr, fq * 8);
#define PG8_SA(b, h) (((b) * 2 + (h)) * HTB)
#define PG8_SB(b, h) ((4 + (b) * 2 + (h)) * HTB)
#define PG8_STAGE(bufoff, gbase, voff) do { _Pragma("unroll") for (int _i = 0; _i < 2; ++_i) \
        __builtin_amdgcn_global_load_lds((const unsigned*)((const char*)(gbase) + (voff)[_i]), (PG8_LAS unsigned*)(lds + (bufoff) + ldsw + _i * 8192), 16, 0, 0); } while (0)
#define PG8_LDA(dst, b, h) do { _Pragma("unroll") for (int m = 0; m < 4; ++m) _Pragma("unroll") for (int k = 0; k < 2; ++k) dst[m][k] = *(const PG8_LAS bf16x8*)(lds + PG8_SA(b, h) + aoff + m * 2048 + k * 1024); } while (0)
#define PG8_LDB(dst, b, h) do { _Pragma("unroll") for (int n = 0; n < 2; ++n) _Pragma("unroll") for (int k = 0; k < 2; ++k) dst[n][k] = *(const PG8_LAS bf16x8*)(lds + PG8_SB(b, h) + boff + n * 2048 + k * 1024); } while (0)
#define PG8_MMA(ai, bj, At, Bt) do { __builtin_amdgcn_s_setprio(1); _Pragma("unroll") for (int m = 0; m < 4; ++m) _Pragma("unroll") for (int n = 0; n < 2; ++n) _Pragma("unroll") for (int k = 0; k < 2; ++k) \
        acc[ai][bj][m][n] = __builtin_amdgcn_mfma_f32_16x16x32_bf16(Bt[n][k], At[m][k], acc[ai][bj][m][n], 0, 0, 0); __builtin_amdgcn_s_setprio(0); } while (0)
#define PG8_WAIT_V(n) asm volatile("s_waitcnt vmcnt(" #n ")" ::: "memory")
#define PG8_WAIT_L(n) asm volatile("s_waitcnt lgkmcnt(" #n ")" ::: "memory")
#define PG8_BAR __builtin_amdgcn_s_barrier()
#define PG8_SCHED __builtin_amdgcn_sched_barrier(0)
    Unit cur, nxt; int ui = 0;
    if (!S.next(0, cur)) return;
    f32x4 acc[2][2][4][2];
#pragma unroll
    for (int a = 0; a < 2; ++a)
#pragma unroll
        for (int b = 0; b < 2; ++b)
#pragma unroll
            for (int m = 0; m < 4; ++m)
#pragma unroll
                for (int n = 0; n < 2; ++n) acc[a][b][m][n] = (f32x4){0.f, 0.f, 0.f, 0.f};
    bf16x8 At[4][2], B0[2][2], B1[2][2];
    const char* cA = (const char*)g.A + (size_t)cur.pm * tstep; const char* cB = (const char*)g.Bt + (size_t)cur.pn * tstep;
    S.a_ready(cur);
    if constexpr (SP2) {
        PG8_STAGE(PG8_SB(0, 0), cB, voffB); PG8_STAGE(PG8_SB(0, 1), cB + hstep, voffB); PG8_STAGE(PG8_SA(0, 0), cA, voffA); PG8_STAGE(PG8_SA(0, 1), cA + hstep, voffA);
        if (wr == 1) PG8_BAR;
        PG8_WAIT_V(2); PG8_BAR;
        PG8_STAGE(PG8_SB(1, 0), cB + kstep, voffB); PG8_STAGE(PG8_SA(1, 0), cA + kstep, voffA); PG8_STAGE(PG8_SB(1, 1), cB + hstep + kstep, voffB);
        PG8_WAIT_V(6); PG8_BAR;
    } else {
        PG8_STAGE(PG8_SB(0, 0), cB, voffB); PG8_STAGE(PG8_SA(0, 0), cA, voffA); PG8_STAGE(PG8_SB(0, 1), cB + hstep, voffB); PG8_STAGE(PG8_SA(0, 1), cA + hstep, voffA);
        if (wr == 1) PG8_BAR;
        PG8_WAIT_V(4); PG8_BAR;
        PG8_STAGE(PG8_SB(1, 0), cB + kstep, voffB); PG8_STAGE(PG8_SA(1, 0), cA + kstep, voffA); PG8_STAGE(PG8_SB(1, 1), cB + hstep + kstep, voffB);
        PG8_WAIT_V(6); PG8_BAR;
    }
    for (;;) {
        const bool has_next = S.next(ui + 1, nxt);
        const char* nA = has_next ? (const char*)g.A + (size_t)nxt.pm * tstep : cA; const char* nB = has_next ? (const char*)g.Bt + (size_t)nxt.pn * tstep : cB;
        for (int t = 0; t < nt; t += 2) {
            const bool last = (t == nt - 2);
            const char* a1 = cA + (size_t)(t + 1) * kstep;
            const char* a2 = last ? nA : cA + (size_t)(t + 2) * kstep; const char* b2 = last ? nB : cB + (size_t)(t + 2) * kstep;
            const char* a3 = a2 + kstep; const char* b3 = b2 + kstep;
            if (last && has_next) S.a_ready(nxt);
            if constexpr (SP2) {
            PG8_LDB(B0, 0, 0); PG8_LDB(B1, 0, 1); PG8_SCHED; PG8_LDA(At, 0, 0); PG8_STAGE(PG8_SA(1, 1), a1 + hstep, voffA);
            PG8_WAIT_V(8); PG8_WAIT_L(0); PG8_BAR; PG8_MMA(0, 0, At, B0); PG8_MMA(0, 1, At, B1); PG8_BAR; PG8_SCHED;
            PG8_LDA(At, 0, 1); PG8_STAGE(PG8_SB(0, 0), b2, voffB); PG8_STAGE(PG8_SB(0, 1), b2 + hstep, voffB); PG8_STAGE(PG8_SA(0, 0), a2, voffA);
            PG8_WAIT_V(8); PG8_WAIT_L(0); PG8_BAR; PG8_MMA(1, 0, At, B0); PG8_MMA(1, 1, At, B1); PG8_BAR; PG8_SCHED;
            PG8_LDB(B0, 1, 0); PG8_LDB(B1, 1, 1); PG8_SCHED; PG8_LDA(At, 1, 0); PG8_STAGE(PG8_SA(0, 1), a2 + hstep, voffA);
            PG8_WAIT_V(8); PG8_WAIT_L(0); PG8_BAR; PG8_MMA(0, 0, At, B0); PG8_MMA(0, 1, At, B1); PG8_BAR; PG8_SCHED;
            PG8_LDA(At, 1, 1); PG8_STAGE(PG8_SB(1, 0), b3, voffB); PG8_STAGE(PG8_SB(1, 1), b3 + hstep, voffB); PG8_STAGE(PG8_SA(1, 0), a3, voffA);
            PG8_WAIT_V(8); PG8_WAIT_L(0); PG8_BAR; PG8_MMA(1, 0, At, B0); PG8_MMA(1, 1, At, B1); PG8_BAR; PG8_SCHED;
            } else {
            PG8_LDB(B0, 0, 0); PG8_SCHED; PG8_LDA(At, 0, 0); PG8_STAGE(PG8_SA(1, 1), a1 + hstep, voffA);
            PG8_WAIT_L(8); PG8_BAR; PG8_WAIT_L(0); PG8_MMA(0, 0, At, B0); PG8_BAR; PG8_SCHED;
            PG8_LDB(B1, 0, 1); PG8_STAGE(PG8_SB(0, 0), b2, voffB);
            PG8_BAR; PG8_WAIT_L(0); PG8_MMA(0, 1, At, B1); PG8_BAR;
            PG8_LDA(At, 0, 1); PG8_STAGE(PG8_SA(0, 0), a2, voffA);
            PG8_BAR; PG8_WAIT_L(0); PG8_MMA(1, 0, At, B0); PG8_BAR; PG8_SCHED;
            PG8_STAGE(PG8_SB(0, 1), b2 + hstep, voffB);
            PG8_WAIT_V(6); PG8_BAR; PG8_MMA(1, 1, At, B1); PG8_BAR;
            PG8_LDB(B0, 1, 0); PG8_SCHED; PG8_LDA(At, 1, 0); PG8_STAGE(PG8_SA(0, 1), a2 + hstep, voffA);
            PG8_WAIT_L(8); PG8_BAR; PG8_WAIT_L(0); PG8_MMA(0, 0, At, B0); PG8_BAR; PG8_SCHED;
            PG8_LDB(B1, 1, 1); PG8_STAGE(PG8_SB(1, 0), b3, voffB);
            PG8_BAR; PG8_WAIT_L(0); PG8_MMA(0, 1, At, B1); PG8_BAR;
            PG8_LDA(At, 1, 1); PG8_STAGE(PG8_SA(1, 0), a3, voffA);
            PG8_BAR; PG8_WAIT_L(0); PG8_MMA(1, 0, At, B0); PG8_BAR; PG8_SCHED;
            PG8_STAGE(PG8_SB(1, 1), b3 + hstep, voffB);
            PG8_WAIT_V(6); PG8_BAR; PG8_MMA(1, 1, At, B1); PG8_BAR;
            }
        }
        if constexpr (ALIGN_EPI) { if (wr == 0) PG8_BAR; }
        if constexpr (!Epi::AFTER_DRAIN) { E(acc, cur, wr, wc, fr, fq); S.done(cur); }
        if (!has_next) break;
#pragma unroll
        for (int a = 0; a < 2; ++a)
#pragma unroll
            for (int b = 0; b < 2; ++b)
#pragma unroll
                for (int m = 0; m < 4; ++m)
#pragma unroll
                    for (int n = 0; n < 2; ++n) acc[a][b][m][n] = (f32x4){0.f, 0.f, 0.f, 0.f};
        cur = nxt; cA = nA; cB = nB; ++ui;
        if constexpr (ALIGN_EPI) { if (wr == 1) PG8_BAR; }
    }
    PG8_WAIT_V(0);
    if constexpr (!ALIGN_EPI) { if (wr == 0) PG8_BAR; }
    PG8_BAR;
    if constexpr (Epi::AFTER_DRAIN) { E.fused(acc, cur, wr, wc, fr, fq, lds, wid, lane); S.done(cur); }
#undef PG8_SA
#undef PG8_SB
#undef PG8_STAGE
#undef PG8_LDA
#undef PG8_LDB
#undef PG8_MMA
#undef PG8_WAIT_V
#undef PG8_WAIT_L
#undef PG8_BAR
#undef PG8_SCHED
}
}

__device__ __forceinline__ v4u pack8(const f32x4& a, const f32x4& b) { v4u w; w.x = pg8::cvt_pk_bf16(a[0], a[1]); w.y = pg8::cvt_pk_bf16(a[2], a[3]); w.z = pg8::cvt_pk_bf16(b[0], b[1]); w.w = pg8::cvt_pk_bf16(b[2], b[3]); return w; }
struct EpiInproj {
    static constexpr bool PERM = true, AFTER_DRAIN = false;
    bf16 *Qd, *Kd, *Vd, *MQ, *MK, *MV, *MO; const f32x2* rope;
    __device__ __forceinline__ void operator()(const f32x4 (&acc)[2][2][4][2], const pg8::Unit& u, int wr, int wc, int fr, int fq) const {
        const int pn = u.pn; const bool lat = u.pm < 128;
        if (!lat && (pn < 2 || pn >= 10)) return;
        const int b = lat ? (u.pm >> 5) : (u.pm - 128);
        const int tbase = lat ? ((u.pm & 31) * 256) : 0;
        const int within0 = wc * 32 + fq * 8;
        if (pn < 4) {
            const bool isq = pn < 2; const int hb = (pn & 1) * 2; const bool rowaxis = (wc & 1) == 0, low = fq < 2; const int j0 = (fq & 1) * 8;
#pragma unroll
            for (int ai = 0; ai < 2; ++ai)
#pragma unroll
                for (int m = 0; m < 4; ++m) {
                    const int rloc = ai * 128 + wr * 64 + m * 16 + fr, t = tbase + rloc;
                    f32x4 cs[4];
                    if (lat) { const int pos = rowaxis ? (t >> 6) : (128 + (t & 63)); const f32x4* rp = (const f32x4*)(rope + pos * 16 + j0);
#pragma unroll
                        for (int q = 0; q < 4; ++q) cs[q] = rp[q]; }
#pragma unroll
                    for (int bj = 0; bj < 2; ++bj) {
                        f32x4 v0 = acc[ai][bj][m][0], v1 = acc[ai][bj][m][1];
                        if (lat) {
                            f32x4 p0, p1;
#pragma unroll
                            for (int e = 0; e < 4; ++e) { p0[e] = __shfl_xor(v0[e], 32); p1[e] = __shfl_xor(v1[e], 32); }
                            if (low) { p0 = -p0; p1 = -p1; }
                            v0[0] = v0[0] * cs[0][0] + p0[0] * cs[0][1]; v0[1] = v0[1] * cs[0][2] + p0[1] * cs[0][3];
                            v0[2] = v0[2] * cs[1][0] + p0[2] * cs[1][1]; v0[3] = v0[3] * cs[1][2] + p0[3] * cs[1][3];
                            v1[0] = v1[0] * cs[2][0] + p1[0] * cs[2][1]; v1[1] = v1[1] * cs[2][2] + p1[1] * cs[2][3];
                            v1[2] = v1[2] * cs[3][0] + p1[2] * cs[3][1]; v1[3] = v1[3] * cs[3][2] + p1[3] * cs[3][3];
                        }
                        if (isq) { v0 = v0 * C2; v1 = v1 * C2; *(v4u*)(Qd + ((size_t)(b * NH + hb + bj) * T + t) * 128 + within0) = pack8(v0, v1); }
                        else *(v4u*)(Kd + ((size_t)(b * NH + hb + bj) * TK + (lat ? CT + t : rloc)) * 128 + within0) = pack8(v0, v1);
                    }
                }
        } else if (pn == 6 || pn == 7) {
            bf16* dst = pn == 6 ? MQ : MK; const float sc = pn == 6 ? 1.f : 0.125f; const int i0 = 32 * (wc & 1) + 8 * fq;
#pragma unroll
            for (int ai = 0; ai < 2; ++ai)
#pragma unroll
                for (int m = 0; m < 4; ++m) { const int rloc = ai * 128 + wr * 64 + m * 16 + fr, kidx = lat ? CT + tbase + rloc : rloc;
#pragma unroll
                    for (int bj = 0; bj < 2; ++bj) { const int h = 2 * bj + (wc >> 1);
                        *(v4u*)(dst + ((size_t)(b * NH + h) * TK + kidx) * 64 + i0) = pack8(acc[ai][bj][m][0] * sc, acc[ai][bj][m][1] * sc); } }
        } else if (pn < 10) {
            bf16* dst = pn < 6 ? Vd : MV; const int hb = (pn & 1) * 2;
#pragma unroll
            for (int ai = 0; ai < 2; ++ai)
#pragma unroll
                for (int m = 0; m < 4; ++m) { const int rloc = ai * 128 + wr * 64 + m * 16 + fr, kidx = lat ? CT + tbase + rloc : rloc;
#pragma unroll
                    for (int bj = 0; bj < 2; ++bj)
                        *(v4u*)(dst + ((size_t)(b * NH + hb + bj) * TK + kidx) * 128 + within0) = pack8(acc[ai][bj][m][0], acc[ai][bj][m][1]); }
        } else {
#pragma unroll
            for (int ai = 0; ai < 2; ++ai)
#pragma unroll
                for (int m = 0; m < 4; ++m) { const int row = u.pm * 256 + ai * 128 + wr * 64 + m * 16 + fr;
#pragma unroll
                    for (int bj = 0; bj < 2; ++bj) { f32x4 v0 = acc[ai][bj][m][0], v1 = acc[ai][bj][m][1];
#pragma unroll
                        for (int e = 0; e < 4; ++e) { v0[e] = __builtin_amdgcn_rcpf(1.f + __expf(-v0[e])); v1[e] = __builtin_amdgcn_rcpf(1.f + __expf(-v1[e])); }
                        *(v4u*)(MO + (size_t)row * 512 + (pn - 10) * 256 + bj * 128 + within0) = pack8(v0, v1); } }
        }
    }
};
struct EpiOutproj {
    static constexpr bool PERM = true, AFTER_DRAIN = false;
    const float* x; float* out; bf16* A2; const float* mod; const float* n2g; float* rowsq;
    __device__ __forceinline__ void operator()(const f32x4 (&acc)[2][2][4][2], const pg8::Unit& u, int wr, int wc, int fr, int fq) const {
        const int b = u.pm >> 5; const float* modr = mod + (size_t)b * 6 * D; const int col0 = u.pn * 256 + wc * 32 + fq * 8;
        f32x4 g1v[2][2], gs2[2][2];
#pragma unroll
        for (int bj = 0; bj < 2; ++bj)
#pragma unroll
            for (int n = 0; n < 2; ++n) { const int c = col0 + bj * 128 + 4 * n; g1v[bj][n] = *(const f32x4*)(modr + 2 * D + c);
                gs2[bj][n] = *(const f32x4*)(n2g + c) * (*(const f32x4*)(modr + 4 * D + c) + 1.0f); }
#pragma unroll
        for (int ai = 0; ai < 2; ++ai)
#pragma unroll
            for (int m = 0; m < 4; ++m) { const int row = u.pm * 256 + ai * 128 + wr * 64 + m * 16 + fr; float ss = 0.f;
#pragma unroll
                for (int bj = 0; bj < 2; ++bj) { const size_t o = (size_t)row * D + col0 + bj * 128;
                    const f32x4 x0 = *(const f32x4*)(x + o) + g1v[bj][0] * acc[ai][bj][m][0], x1 = *(const f32x4*)(x + o + 4) + g1v[bj][1] * acc[ai][bj][m][1];
                    *(f32x4*)(out + o) = x0; *(f32x4*)(out + o + 4) = x1;
                    ss += (x0[0] * x0[0] + x0[1] * x0[1]) + (x0[2] * x0[2] + x0[3] * x0[3]) + (x1[0] * x1[0] + x1[1] * x1[1]) + (x1[2] * x1[2] + x1[3] * x1[3]);
                    *(v4u*)(A2 + o) = pack8(x0 * gs2[bj][0], x1 * gs2[bj][1]); }
                ss += __shfl_xor(ss, 16); ss += __shfl_xor(ss, 32);
                if (fq == 0) atomicAdd(rowsq + row, ss); }
    }
};
struct EpiFc1 {
    static constexpr bool PERM = true, AFTER_DRAIN = false;
    bf16* Hh; const float* bias1; const float* rowsq;
    __device__ __forceinline__ void operator()(const f32x4 (&acc)[2][2][4][2], const pg8::Unit& u, int wr, int wc, int fr, int fq) const {
        const int b = u.pm >> 5; const int col0 = u.pn * 256 + wc * 32 + fq * 8;
        f32x4 bv[2][2];
#pragma unroll
        for (int bj = 0; bj < 2; ++bj)
#pragma unroll
            for (int n = 0; n < 2; ++n) bv[bj][n] = *(const f32x4*)(bias1 + (size_t)b * FF + col0 + bj * 128 + 4 * n);
#pragma unroll
        for (int ai = 0; ai < 2; ++ai)
#pragma unroll
            for (int m = 0; m < 4; ++m) { const int row = u.pm * 256 + ai * 128 + wr * 64 + m * 16 + fr;
                const float rstd = 1.0f / sqrtf(rowsq[row] * (1.f / D) + EPS);
#pragma unroll
                for (int bj = 0; bj < 2; ++bj) { f32x4 v0 = acc[ai][bj][m][0] * rstd + bv[bj][0], v1 = acc[ai][bj][m][1] * rstd + bv[bj][1];
#pragma unroll
                    for (int e = 0; e < 4; ++e) { const float a0 = fmaxf(v0[e], 0.f), a1 = fmaxf(v1[e], 0.f); v0[e] = a0 * a0; v1[e] = a1 * a1; }
                    *(v4u*)(Hh + (size_t)row * FF + col0 + bj * 128) = pack8(v0, v1); } }
    }
};
struct EpiFc2 {
    static constexpr bool PERM = true, AFTER_DRAIN = false;
    float* out; const float* mod; float* rowsq;
    __device__ __forceinline__ void operator()(const f32x4 (&acc)[2][2][4][2], const pg8::Unit& u, int wr, int wc, int fr, int fq) const {
        const int b = u.pm >> 5; const float* modr = mod + (size_t)b * 6 * D; const int col0 = u.pn * 256 + wc * 32 + fq * 8;
        f32x4 g2v[2][2];
#pragma unroll
        for (int bj = 0; bj < 2; ++bj)
#pragma unroll
            for (int n = 0; n < 2; ++n) g2v[bj][n] = *(const f32x4*)(modr + 5 * D + col0 + bj * 128 + 4 * n);
#pragma unroll
        for (int ai = 0; ai < 2; ++ai)
#pragma unroll
            for (int m = 0; m < 4; ++m) { const int row = u.pm * 256 + ai * 128 + wr * 64 + m * 16 + fr; float ss = 0.f;
#pragma unroll
                for (int bj = 0; bj < 2; ++bj) { const size_t o = (size_t)row * D + col0 + bj * 128;
                    const f32x4 x0 = *(const f32x4*)(out + o) + g2v[bj][0] * acc[ai][bj][m][0], x1 = *(const f32x4*)(out + o + 4) + g2v[bj][1] * acc[ai][bj][m][1];
                    *(f32x4*)(out + o) = x0; *(f32x4*)(out + o + 4) = x1;
                    ss += (x0[0] * x0[0] + x0[1] * x0[1]) + (x0[2] * x0[2] + x0[3] * x0[3]) + (x1[0] * x1[0] + x1[1] * x1[1]) + (x1[2] * x1[2] + x1[3] * x1[3]); }
                ss += __shfl_xor(ss, 16); ss += __shfl_xor(ss, 32);
                if (fq == 0) atomicAdd(rowsq + row, ss); }
    }
};

__device__ __forceinline__ void naive_mlstm(Frame& F) {
    LAS float* ks = (LAS float*)F.lds;
    LAS float* qs = ks + 64 * 64;
    LAS float* vs = qs + 64 * 64;
    LAS float* fg = vs + 64 * 128;
    LAS float* ig = fg + 64;
    const int tid = F.tid, v = tid >> 2, dq = (tid & 3) * 16;
    for (int item = F.vcu; item < 32; item += F.G) {
        const int bh = item >> 1, dir = item & 1;
        float C[16], n[16];
#pragma unroll
        for (int e = 0; e < 16; ++e) { C[e] = 0.f; n[e] = 0.f; }
        float* Hout = (dir ? F.HB : F.HF) + (size_t)bh * T * 128;
        for (int blk = 0; blk < TK / 64; ++blk) {
            int c;
            if (!dir) c = blk; else c = (blk < 4) ? (3 - blk) : (TK / 64 - 1 - (blk - 4));
            const int kidx0 = c * 64; const bool lat = c >= 4;
            const size_t base64 = ((size_t)bh * TK + kidx0) * 64, base128 = ((size_t)bh * TK + kidx0) * 128;
            for (int i = tid; i < 64 * 64; i += 512) { ks[i] = bf2f(F.MK[base64 + i]); qs[i] = bf2f(F.MQ[base64 + i]); }
            for (int i = tid; i < 64 * 128; i += 512) vs[i] = bf2f(F.MV[base128 + i]);
            if (tid < 64) { const float* g = F.gates + ((size_t)bh * TK + kidx0 + tid) * 4 + dir * 2; ig[tid] = __expf(g[0]); fg[tid] = __expf(g[1]); }
            __syncthreads();
            for (int step = 0; step < 64; ++step) {
                const int s = dir ? 63 - step : step;
                const float f = fg[s], iw = ig[s], vv = vs[s * 128 + v] * iw;
                float num = 0.f, den = 0.f;
#pragma unroll
                for (int e = 0; e < 16; ++e) { const float kk = ks[s * 64 + dq + e], qq = qs[s * 64 + dq + e];
                    C[e] = f * C[e] + vv * kk; n[e] = f * n[e] + iw * kk; num += C[e] * qq; den += n[e] * qq; }
                if (lat) {
                    num += __shfl_xor(num, 1); num += __shfl_xor(num, 2); den += __shfl_xor(den, 1); den += __shfl_xor(den, 2);
                    if ((tid & 3) == 0) Hout[(size_t)(kidx0 - CT + s) * 128 + v] = num / fmaxf(fabsf(den), 1.f);
                }
            }
            __syncthreads();
        }
    }
}
__device__ __forceinline__ void naive_mlstm_combine(Frame& F) {
    const int gw = F.vcu * NWAVES + F.wave, NGW = F.G * NWAVES, lane = F.lane;
    for (int rid = gw; rid < NTOK * NH; rid += NGW) {
        const int row = rid >> 2, h = rid & 3, b = row >> 13, t = row & (T - 1);
        const size_t o = ((size_t)(b * NH + h) * T + t) * 128 + 2 * lane;
        const float a0 = F.HF[o] + F.HB[o], a1 = F.HF[o + 1] + F.HB[o + 1];
        const float r = 1.0f / sqrtf(wave_sum(a0 * a0 + a1 * a1) * (1.f / 128.f) + EPS);
        const float* g = F.in[I_MLNG] + h * 128 + 2 * lane;
        const unsigned mo = *(const unsigned*)(F.MO + (size_t)row * 512 + h * 128 + 2 * lane);
        *(unsigned*)(F.MIX + (size_t)row * D + 512 + h * 128 + 2 * lane) = pk2(a0 * r * g[0] * bflo(mo), a1 * r * g[1] * bfhi(mo));
    }
}

__device__ __forceinline__ void naive_attn(Frame& F) {
    LAS float* qs = (LAS float*)F.lds + F.wave * 64;
    const int gw = F.vcu * NWAVES + F.wave, NGW = F.G * NWAVES, lane = F.lane;
    float lam;
    { const float s1 = wave_sum(F.in[I_LQ1][lane] * F.in[I_LK1][lane]), s2 = wave_sum(F.in[I_LQ2][lane] * F.in[I_LK2][lane]); lam = __expf(s1) - __expf(s2) + LAMBDA_INIT; }
    for (int rid = gw; rid < NB * NH * T; rid += NGW) {
        const int bh = rid >> 13, t = rid & (T - 1), b = bh >> 2, h = bh & 3;
        float o0 = 0.f, o1 = 0.f;
        for (int map = 0; map < 2; ++map) {
            qs[lane] = bf2f(F.Qd[((size_t)bh * T + t) * 128 + map * 64 + lane]);
            asm volatile("s_waitcnt lgkmcnt(0)" ::: "memory");
            float m = -1e30f, l = 0.f, a0 = 0.f, a1 = 0.f;
            for (int ch = 0; ch < TK / 64; ++ch) {
                const bf16* kp = F.Kd + ((size_t)bh * TK + ch * 64 + lane) * 128 + map * 64;
                float s = 0.f;
#pragma unroll
                for (int d8 = 0; d8 < 8; ++d8) { const v4u kv = *(const v4u*)(kp + d8 * 8); const f32x4 qa = *(const LAS f32x4*)(qs + d8 * 8), qb = *(const LAS f32x4*)(qs + d8 * 8 + 4);
                    s += bflo(kv.x) * qa.x + bfhi(kv.x) * qa.y + bflo(kv.y) * qa.z + bfhi(kv.y) * qa.w + bflo(kv.z) * qb.x + bfhi(kv.z) * qb.y + bflo(kv.w) * qb.z + bfhi(kv.w) * qb.w; }
                const float mn = fmaxf(m, wave_max(s)), alpha = exp2f(m - mn), p = exp2f(s - mn);
                l = l * alpha + wave_sum(p); a0 *= alpha; a1 *= alpha; m = mn;
                const bf16* vp = F.Vd + ((size_t)bh * TK + ch * 64) * 128 + 2 * lane;
#pragma unroll 8
                for (int kk = 0; kk < 64; ++kk) { const float pk = __shfl(p, kk); const unsigned vv = *(const unsigned*)(vp + (size_t)kk * 128); a0 += pk * bflo(vv); a1 += pk * bfhi(vv); }
            }
            const float il = 1.f / l;
            if (map == 0) { o0 = a0 * il; o1 = a1 * il; } else { o0 -= lam * a0 * il; o1 -= lam * a1 * il; }
        }
        const float r = 1.0f / sqrtf(wave_sum(o0 * o0 + o1 * o1) * (1.f / 128.f) + EPS);
        const float* g = F.in[I_SUBLN] + 2 * lane;
        *(unsigned*)(F.MIX + (size_t)(b * T + t) * D + h * 128 + 2 * lane) = pk2(o0 * r * g[0] * (1.f - LAMBDA_INIT), o1 * r * g[1] * (1.f - LAMBDA_INIT));
    }
}


namespace da {
using bf16x8 = __attribute__((ext_vector_type(8))) short;
using s16x4  = __attribute__((ext_vector_type(4))) short;
using f32x16 = __attribute__((ext_vector_type(16))) float;
using u32x4  = __attribute__((ext_vector_type(4))) unsigned;
constexpr int KVBLK = 64;
constexpr size_t SHM_V = KVBLK * 128 * 2, SHM_K = KVBLK * 128 * 2;
constexpr float THR2 = 8.f * 1.4426950408889634f;
#define KSWZ(row, colB) ((row) * 256 + ((colB) ^ (((row) & 7) << 4)))
#define SBAR() __builtin_amdgcn_sched_barrier(0)
__device__ __forceinline__ int crow(int r, int hi) { return (r & 3) + 8 * (r >> 2) + 4 * hi; }
__device__ __forceinline__ unsigned cvtpk(float lo, float hi) { unsigned r; asm volatile("v_cvt_pk_bf16_f32 %0, %1, %2" : "=v"(r) : "v"(lo), "v"(hi)); return r; }
__device__ __forceinline__ void partialSM(f32x16& p0, f32x16& p1, float& m_reg, float& mn, float& alpha) {
  float pmax = p0[0]; for (int r = 1; r < 16; ++r) pmax = fmaxf(pmax, p0[r]); for (int r = 0; r < 16; ++r) pmax = fmaxf(pmax, p1[r]);
  { auto rr = __builtin_amdgcn_permlane32_swap(__float_as_uint(pmax), __float_as_uint(pmax), false, false);
    pmax = fmaxf(__uint_as_float(rr[0]), __uint_as_float(rr[1])); }
  if (__builtin_expect(__all(pmax - m_reg <= THR2), 1)) { mn = m_reg; alpha = 1.f; }
  else { mn = fmaxf(m_reg, pmax); alpha = __builtin_amdgcn_exp2f(m_reg - mn); m_reg = mn; }
  for (int r = 0; r < 16; ++r) p0[r] = p0[r] - mn; for (int r = 0; r < 16; ++r) p1[r] = p1[r] - mn;
  for (int r = 0; r < 16; ++r) p0[r] = __builtin_amdgcn_exp2f(p0[r]);
}
__device__ __forceinline__ void finishSM(f32x16& p0, f32x16& p1, float alpha, float& l_reg, bf16x8& pa0, bf16x8& pa1, bf16x8& pa2, bf16x8& pa3) {
  for (int r = 0; r < 16; ++r) p1[r] = __builtin_amdgcn_exp2f(p1[r]);
  float ps = 0; for (int r = 0; r < 16; ++r) ps += p0[r]; for (int r = 0; r < 16; ++r) ps += p1[r];
  { auto rr = __builtin_amdgcn_permlane32_swap(__float_as_uint(ps), __float_as_uint(ps), false, false);
    ps = __uint_as_float(rr[0]) + __uint_as_float(rr[1]); }
  l_reg = l_reg * alpha + ps;
#define PK4(P, BASE, OUT) do { unsigned a0 = cvtpk(P[BASE + 0], P[BASE + 1]), a1 = cvtpk(P[BASE + 2], P[BASE + 3]);   \
    unsigned b0 = cvtpk(P[BASE + 4], P[BASE + 5]), b1 = cvtpk(P[BASE + 6], P[BASE + 7]);                              \
    auto r0 = __builtin_amdgcn_permlane32_swap(a0, b0, false, false); auto r1 = __builtin_amdgcn_permlane32_swap(a1, b1, false, false); \
    u32x4 w = {r0[0], r1[0], r0[1], r1[1]}; OUT = *reinterpret_cast<bf16x8*>(&w); } while (0)
  PK4(p0, 0, pa0); PK4(p0, 8, pa1); PK4(p1, 0, pa2); PK4(p1, 8, pa3);
#undef PK4
}
__device__ __forceinline__ void qkt(f32x16& p0, f32x16& p1, const char* Ks, const bf16x8* qr, int r32, int hi, int mapB) {
  p0 = f32x16{}; p1 = f32x16{};
  for (int d0 = 0; d0 < 4; ++d0) { int cb = mapB + (d0 * 16 + hi * 8) * 2;
    bf16x8 b0 = *reinterpret_cast<const bf16x8*>(Ks + KSWZ(r32, cb));
    bf16x8 b1 = *reinterpret_cast<const bf16x8*>(Ks + KSWZ(32 + r32, cb));
    p0 = __builtin_amdgcn_mfma_f32_32x32x16_bf16(b0, qr[d0], p0, 0, 0, 0);
    p1 = __builtin_amdgcn_mfma_f32_32x32x16_bf16(b1, qr[d0], p1, 0, 0, 0); }
}
__device__ __forceinline__ int v_st(int k, int c) { const int kk = (k & ~0xC) | ((k & 4) << 1) | ((k & 8) >> 1); return ((kk >> 3) * 4 + (c >> 5)) * 512 + ((kk & 7) * 32 + (c & 31)) * 2; }
__device__ __forceinline__ int v_rd_base(int lane) { return ((lane & 3) << 3) | (((lane >> 2) & 3) << 6) | (((lane >> 4) & 1) << 5) | (((lane >> 5) & 1) << 8); }
constexpr int v_rd_off(int d0, int ks, int half) { return d0 * 512 + ks * 4096 + half * 2048; }
template <int OFF> __device__ __forceinline__ s16x4 tr_read(int vb) {
  s16x4 r; asm volatile("ds_read_b64_tr_b16 %0, %1 offset:%2" : "=&v"(r) : "v"(vb), "i"(OFF) : "memory"); return r;
}
template <int D0> __device__ __forceinline__ void pv_one(f32x16& od, int vb, bf16x8 pa0, bf16x8 pa1, bf16x8 pa2, bf16x8 pa3) {
  const s16x4 l0 = tr_read<v_rd_off(D0, 0, 0)>(vb), h0 = tr_read<v_rd_off(D0, 0, 1)>(vb), l1 = tr_read<v_rd_off(D0, 1, 0)>(vb), h1 = tr_read<v_rd_off(D0, 1, 1)>(vb);
  const s16x4 l2 = tr_read<v_rd_off(D0, 2, 0)>(vb), h2 = tr_read<v_rd_off(D0, 2, 1)>(vb), l3 = tr_read<v_rd_off(D0, 3, 0)>(vb), h3 = tr_read<v_rd_off(D0, 3, 1)>(vb);
  asm volatile("s_waitcnt lgkmcnt(0)" ::: "memory"); SBAR();
#define PK(L, H) (bf16x8){L[0], L[1], L[2], L[3], H[0], H[1], H[2], H[3]}
  od = __builtin_amdgcn_mfma_f32_32x32x16_bf16(pa0, PK(l0, h0), od, 0, 0, 0);
  od = __builtin_amdgcn_mfma_f32_32x32x16_bf16(pa1, PK(l1, h1), od, 0, 0, 0);
  od = __builtin_amdgcn_mfma_f32_32x32x16_bf16(pa2, PK(l2, h2), od, 0, 0, 0);
  od = __builtin_amdgcn_mfma_f32_32x32x16_bf16(pa3, PK(l3, h3), od, 0, 0, 0);
#undef PK
}
__device__ __forceinline__ void pv_d0(f32x16* o, int vb, bf16x8 pa0, bf16x8 pa1, bf16x8 pa2, bf16x8 pa3) {
  pv_one<0>(o[0], vb, pa0, pa1, pa2, pa3); pv_one<1>(o[1], vb, pa0, pa1, pa2, pa3); pv_one<2>(o[2], vb, pa0, pa1, pa2, pa3); pv_one<3>(o[3], vb, pa0, pa1, pa2, pa3);
}
__device__ __forceinline__ void da_unit(const bf16* __restrict__ Qb, const bf16* __restrict__ Kh, const bf16* __restrict__ Vh, bf16* __restrict__ Mx,
                                        const float* __restrict__ subg, float lam, int seq, char* lds) {
  const int tid = threadIdx.x, wid = tid >> 6, lane = tid & 63, r32 = lane & 31, hi = lane >> 5, map = wid >> 2, wq = wid & 3;
  bf16* V_lds = (bf16*)lds; bf16* K_lds = (bf16*)(lds + 2 * SHM_V);
  float* ws = (float*)(lds + 2 * SHM_V + 2 * SHM_K) + wid * 64; float* li_l = ws; float* al_l = ws + 32;
  float m_reg = -1e30f, l_reg = 0; f32x16 o[4] = {}; bf16x8 qr[4];
  const bf16* Qw = Qb + (long)(wq * 32 + r32) * 128 + map * 64 + hi * 8;
#pragma unroll
  for (int d0 = 0; d0 < 4; ++d0) qr[d0] = *reinterpret_cast<const bf16x8*>(Qw + d0 * 16);
  const int mapB = map * 128;
  const int sr = tid >> 4, sc = (tid & 15) * 8, vst0 = v_st(sr, sc), vst1 = v_st(32 + sr, sc);
  const int vb0 = (int)(uintptr_t)V_lds + v_rd_base(lane);
  struct { bf16x8 vs0, vs1, ks0, ks1; } sr_[1];
#define SLOAD(i, k0) do { sr_[i].vs0 = *reinterpret_cast<const bf16x8*>(&Vh[(long)((k0) + sr) * 128 + sc]); sr_[i].vs1 = *reinterpret_cast<const bf16x8*>(&Vh[(long)((k0) + 32 + sr) * 128 + sc]); \
    sr_[i].ks0 = *reinterpret_cast<const bf16x8*>(&Kh[(long)((k0) + sr) * 128 + sc]); sr_[i].ks1 = *reinterpret_cast<const bf16x8*>(&Kh[(long)((k0) + 32 + sr) * 128 + sc]); } while (0)
#define SWRITE(b, i) do { *(bf16x8*)((char*)V_lds + (b) * SHM_V + vst0) = sr_[i].vs0;          \
    *(bf16x8*)((char*)V_lds + (b) * SHM_V + vst1) = sr_[i].vs1; int kc = sc * 2;               \
    *(bf16x8*)((char*)K_lds + (b) * SHM_K + KSWZ(sr, kc)) = sr_[i].ks0;                       \
    *(bf16x8*)((char*)K_lds + (b) * SHM_K + KSWZ(32 + sr, kc)) = sr_[i].ks1; } while (0)
#define SWAIT() asm volatile("s_waitcnt vmcnt(0)" ::: "memory")
#define RESC(a) do { if (__any((a) < 1.f)) { if (hi == 0) al_l[r32] = (a); asm volatile("s_waitcnt lgkmcnt(0)" ::: "memory"); \
    for (int d = 0; d < 4; ++d) for (int r = 0; r < 16; ++r) o[d][r] *= al_l[crow(r, hi)]; } } while (0)
  f32x16 pA0, pA1, pB0, pB1; float mnA, mnB, alA, alB; bf16x8 pa0, pa1, pa2, pa3; const int NT = seq / KVBLK;
  constexpr int SE = 0, SO = 0;
  SLOAD(SE, 0); asm volatile("s_waitcnt vmcnt(0)" ::: "memory"); SWRITE(0, SE); __syncthreads();
  qkt(pA0, pA1, (const char*)K_lds, qr, r32, hi, mapB); partialSM(pA0, pA1, m_reg, mnA, alA);
  SLOAD(SO, KVBLK);
  SWAIT(); SWRITE(1, SO); __syncthreads();
  for (int j = 1; j + 1 < NT; j += 2) {
    SBAR(); qkt(pB0, pB1, (const char*)K_lds + SHM_K, qr, r32, hi, mapB);
    finishSM(pA0, pA1, alA, l_reg, pa0, pa1, pa2, pa3); SBAR();
    SLOAD(SO, (j + 1) * KVBLK); SBAR();
    pv_d0(o, vb0, pa0, pa1, pa2, pa3); partialSM(pB0, pB1, m_reg, mnB, alB);
    __syncthreads(); SWAIT(); SWRITE(0, SE);
    RESC(alB); __syncthreads();
    SBAR(); qkt(pA0, pA1, (const char*)K_lds, qr, r32, hi, mapB);
    finishSM(pB0, pB1, alB, l_reg, pa0, pa1, pa2, pa3); SBAR();
    SLOAD(SE, (j + 2) * KVBLK); SBAR();
    pv_d0(o, vb0 + (int)SHM_V, pa0, pa1, pa2, pa3); partialSM(pA0, pA1, m_reg, mnA, alA);
    __syncthreads(); SWAIT(); SWRITE(1, SO);
    RESC(alA); __syncthreads();
  }
  SBAR(); qkt(pB0, pB1, (const char*)K_lds + SHM_K, qr, r32, hi, mapB);
  finishSM(pA0, pA1, alA, l_reg, pa0, pa1, pa2, pa3); SBAR();
  pv_d0(o, vb0, pa0, pa1, pa2, pa3); partialSM(pB0, pB1, m_reg, mnB, alB);
  __syncthreads(); RESC(alB);
  finishSM(pB0, pB1, alB, l_reg, pa0, pa1, pa2, pa3); SBAR();
  pv_d0(o, vb0 + (int)SHM_V, pa0, pa1, pa2, pa3);
  int lane_e = threadIdx.x & 63; asm volatile("" : "+v"(lane_e));
  if (hi == 0) li_l[r32] = l_reg; asm volatile("s_waitcnt lgkmcnt(0)" ::: "memory");
  float rli[16];
#pragma unroll
  for (int r = 0; r < 16; ++r) rli[r] = __builtin_amdgcn_rcpf(li_l[crow(r, hi)]);
  __syncthreads();
  float* X = (float*)lds + (wq * 64 + lane_e) * 64;
  if (map == 1) {
#pragma unroll
    for (int d0 = 0; d0 < 4; ++d0)
#pragma unroll
      for (int r = 0; r < 16; ++r) X[d0 * 16 + r] = o[d0][r] * rli[r] * lam;
  }
  __syncthreads();
  if (map == 0) {
    float ssq[16];
#pragma unroll
    for (int r = 0; r < 16; ++r) ssq[r] = 0.f;
#pragma unroll
    for (int d0 = 0; d0 < 4; ++d0)
#pragma unroll
      for (int r = 0; r < 16; ++r) { o[d0][r] = o[d0][r] * rli[r] - X[d0 * 16 + r]; ssq[r] += o[d0][r] * o[d0][r]; }
#pragma unroll
    for (int r = 0; r < 16; ++r) {
#pragma unroll
      for (int off = 1; off < 32; off <<= 1) ssq[r] += __shfl_xor(ssq[r], off);
      ssq[r] = (1.f - LAMBDA_INIT) / sqrtf(ssq[r] * (1.f / 128.f) + EPS);
    }
    char* st = lds + 65536 + 2048 + wq * 8704;
#pragma unroll
    for (int d0 = 0; d0 < 4; ++d0) { const float g = subg[d0 * 32 + (lane_e & 31)];
#pragma unroll
      for (int r = 0; r < 16; ++r) *(bf16*)(st + crow(r, lane_e >> 5) * 272 + (d0 * 32 + (lane_e & 31)) * 2) = (bf16)f2bf(o[d0][r] * ssq[r] * g); }
    asm volatile("s_waitcnt lgkmcnt(0)" ::: "memory");
    bf16* Mw = Mx + (long)(wq * 32 + (lane_e >> 4)) * D + (lane_e & 15) * 8;
#pragma unroll
    for (int it = 0; it < 8; ++it) { const u32x4 v = *(const u32x4*)(st + (it * 4 + (lane_e >> 4)) * 272 + (lane_e & 15) * 16); *(u32x4*)(Mw + (long)(it * 4) * D) = v; }
  }
  __syncthreads();
#undef SLOAD
#undef SWRITE
#undef SWAIT
#undef RESC
}
#undef KSWZ
#undef SBAR
}

__device__ __forceinline__ void fast_attn(Frame& F) {
    float lam;
    { const int l = F.lane; const float s1 = wave_sum(F.in[I_LQ1][l] * F.in[I_LK1][l]), s2 = wave_sum(F.in[I_LQ2][l] * F.in[I_LK2][l]); lam = __expf(s1) - __expf(s2) + LAMBDA_INIT; lam = __builtin_bit_cast(float, __builtin_amdgcn_readfirstlane(__builtin_bit_cast(int, lam))); }
    for (int u = F.vcu * 4; u < NB * NH * (T / 128); u += F.G * 4)
        for (int i = 0; i < 4; ++i) {
            const int uu = u + i, bh = uu >> 6, qb = uu & 63, b = bh >> 2, h = bh & 3;
            da::da_unit(F.Qd + ((size_t)bh * T + qb * 128) * 128, F.Kd + (size_t)bh * TK * 128, F.Vd + (size_t)bh * TK * 128,
                        F.MIX + ((size_t)b * T + qb * 128) * D + h * 128, F.in[I_SUBLN], lam, TK, (char*)(F.lds));
        }
}


namespace ml {
using da::bf16x8; using da::s16x4; using da::f32x16; using da::u32x4; using da::crow; using da::cvtpk; using da::v_st; using da::v_rd_base; using da::tr_read; using da::v_rd_off;
constexpr int NCH = TK / 64;
constexpr int CE = 129 * 64;
constexpr float LOG2E = 1.4426950408889634f;
#define KSWZ64(row, colB) ((row) * 128 + ((colB) ^ ((((row) >> 1) & 7) << 4)))
__device__ __forceinline__ float scan_add(float v, int lane) {
#pragma unroll
    for (int o = 1; o < 64; o <<= 1) { const float t = __shfl_up(v, o); if (lane >= o) v += t; }
    return v;
}
__device__ __forceinline__ float scan_max(float v, int lane) {
#pragma unroll
    for (int o = 1; o < 64; o <<= 1) { const float t = __shfl_up(v, o); if (lane >= o) v = fmaxf(v, t); }
    return v;
}
__device__ __forceinline__ int pos_of(int dir, int c) { return dir ? (c < 4 ? 3 - c : 135 - c) : c; }
__device__ __forceinline__ v4u scale8(v4u x, float w) { v4u o; o.x = pk2(bflo(x.x) * w, bfhi(x.x) * w); o.y = pk2(bflo(x.y) * w, bfhi(x.y) * w); o.z = pk2(bflo(x.z) * w, bfhi(x.z) * w); o.w = pk2(bflo(x.w) * w, bfhi(x.w) * w); return o; }
#define ML_PK(L, H) (bf16x8){L[0], L[1], L[2], L[3], H[0], H[1], H[2], H[3]}

__device__ __forceinline__ void phase_a(Frame& F, float* DC, float* SCL) {
    char* lds = (char*)F.lds; const int VI = 0, KW = 16384; float* WL = (float*)(lds + 32768);
    const int tid = F.tid, lane = F.lane, wid = F.wave, r32 = lane & 31, hi = lane >> 5;
    const int dir = wid >> 2, dt = (wid >> 1) & 1, vs = wid & 1;
    const int ldsb = (int)(uintptr_t)lds;
    for (int u = F.vcu; u < NB * NH * NCH; u += F.G) {
        const int bh = u / NCH, c = u % NCH, kidx0 = c * 64;
        if (wid < 2) {
            const int d = wid, s = d ? 63 - lane : lane;
            const float* g4 = F.gates + ((size_t)bh * TK + kidx0 + s) * 4 + d * 2;
            const float li = g4[0], lf = g4[1];
            const float b = scan_add(lf, lane), bl = __shfl(b, 63), g = bl - b + li, m = wave_max(g);
            WL[d * 64 + s] = __expf(g - m);
            if (lane == 0) { float* sp = SCL + ((size_t)(bh * 2 + d) * NCH + pos_of(d, c)) * 2; sp[0] = bl; sp[1] = m; }
        }
        const int krow = tid >> 3, kch = tid & 7, sr = tid >> 4, sc = (tid & 15) * 8;
        const v4u kv = *(const v4u*)(F.MK + ((size_t)bh * TK + kidx0 + krow) * 64 + kch * 8);
        const v4u v0 = *(const v4u*)(F.MV + ((size_t)bh * TK + kidx0 + sr) * 128 + sc), v1 = *(const v4u*)(F.MV + ((size_t)bh * TK + kidx0 + 32 + sr) * 128 + sc);
        __syncthreads();
        *(v4u*)(lds + KW + v_st(krow, kch * 8)) = scale8(kv, WL[krow]);
        *(v4u*)(lds + KW + v_st(krow, 64 + kch * 8)) = scale8(kv, WL[64 + krow]);
        *(v4u*)(lds + VI + v_st(sr, sc)) = v0; *(v4u*)(lds + VI + v_st(32 + sr, sc)) = v1;
        __syncthreads();
        bf16x8 kw[4];
        { const int vb = ldsb + KW + v_rd_base(lane) + (2 * dir + dt) * 512;
          const s16x4 l0 = tr_read<v_rd_off(0, 0, 0)>(vb), h0 = tr_read<v_rd_off(0, 0, 1)>(vb), l1 = tr_read<v_rd_off(0, 1, 0)>(vb), h1 = tr_read<v_rd_off(0, 1, 1)>(vb);
          const s16x4 l2 = tr_read<v_rd_off(0, 2, 0)>(vb), h2 = tr_read<v_rd_off(0, 2, 1)>(vb), l3 = tr_read<v_rd_off(0, 3, 0)>(vb), h3 = tr_read<v_rd_off(0, 3, 1)>(vb);
          asm volatile("s_waitcnt lgkmcnt(0)" ::: "memory"); __builtin_amdgcn_sched_barrier(0);
          kw[0] = ML_PK(l0, h0); kw[1] = ML_PK(l1, h1); kw[2] = ML_PK(l2, h2); kw[3] = ML_PK(l3, h3); }
        float* dcb = DC + ((size_t)(bh * 2 + dir) * NCH + pos_of(dir, c)) * CE + dt * 32 + r32;
#pragma unroll
        for (int t = 0; t < 2; ++t) {
            const int vt = 2 * vs + t; const int vb = ldsb + VI + v_rd_base(lane) + vt * 512;
            const s16x4 l0 = tr_read<v_rd_off(0, 0, 0)>(vb), h0 = tr_read<v_rd_off(0, 0, 1)>(vb), l1 = tr_read<v_rd_off(0, 1, 0)>(vb), h1 = tr_read<v_rd_off(0, 1, 1)>(vb);
            const s16x4 l2 = tr_read<v_rd_off(0, 2, 0)>(vb), h2 = tr_read<v_rd_off(0, 2, 1)>(vb), l3 = tr_read<v_rd_off(0, 3, 0)>(vb), h3 = tr_read<v_rd_off(0, 3, 1)>(vb);
            asm volatile("s_waitcnt lgkmcnt(0)" ::: "memory"); __builtin_amdgcn_sched_barrier(0);
            f32x16 acc = {};
            acc = __builtin_amdgcn_mfma_f32_32x32x16_bf16(ML_PK(l0, h0), kw[0], acc, 0, 0, 0);
            acc = __builtin_amdgcn_mfma_f32_32x32x16_bf16(ML_PK(l1, h1), kw[1], acc, 0, 0, 0);
            acc = __builtin_amdgcn_mfma_f32_32x32x16_bf16(ML_PK(l2, h2), kw[2], acc, 0, 0, 0);
            acc = __builtin_amdgcn_mfma_f32_32x32x16_bf16(ML_PK(l3, h3), kw[3], acc, 0, 0, 0);
#pragma unroll
            for (int r = 0; r < 16; ++r) dcb[(size_t)(vt * 32 + crow(r, hi)) * 64] = acc[r];
        }
        if (vs == 0) {
            const short one = (r32 == 0) ? (short)0x3F80 : (short)0; const bf16x8 ones = {one, one, one, one, one, one, one, one};
            f32x16 acc = {};
#pragma unroll
            for (int ks = 0; ks < 4; ++ks) acc = __builtin_amdgcn_mfma_f32_32x32x16_bf16(ones, kw[ks], acc, 0, 0, 0);
            if (hi == 0) dcb[(size_t)128 * 64] = acc[0];
        }
        __syncthreads();
    }
}

__device__ __forceinline__ void phase_b(Frame& F, const float* DC, const float* SCL, bf16* CIN, float* MINV) {
    const int NPAIR = CE / 2, TOTAL = NB * NH * 2 * NPAIR;
    for (int pr = F.vcu * 512 + F.tid; pr < TOTAL; pr += F.G * 512) {
        const int cd = pr / NPAIR, e = pr % NPAIR;
        const float* dcp = DC + (size_t)cd * NCH * CE + 2 * e; const float* scp = SCL + (size_t)cd * NCH * 2;
        bf16* cop = CIN + (size_t)cd * 128 * CE + 2 * e;
        float M = 0.f, c0 = 0.f, c1 = 0.f;
#pragma unroll 4
        for (int pos = 0; pos < NCH; ++pos) {
            const f32x2 dc = *(const f32x2*)(dcp + (size_t)pos * CE);
            const f32x2 sl = *(const f32x2*)(scp + pos * 2);
            if (pos >= 4) { *(unsigned*)(cop + (size_t)(pos - 4) * CE) = pk2(c0, c1); if (e == 0) MINV[cd * 128 + pos - 4] = M; }
            const float Mn = fmaxf(sl.x + M, sl.y), a = __expf(sl.x + M - Mn), cc = __expf(sl.y - Mn);
            c0 = a * c0 + cc * dc.x; c1 = a * c1 + cc * dc.y; M = Mn;
        }
    }
}

__device__ __forceinline__ void phase_c(Frame& F, const bf16* CIN, const float* MINV) {
    char* lds = (char*)F.lds; const int ldsb = (int)(uintptr_t)lds;
    constexpr int KI = 0, VIo = 16384, CI = 49152, NLo = 81920, AAo = 82432, MMo = 82944, WIo = 83456, CFo = 83968, SCWo = 84480, SSQo = 86528, XO = 0, STO = 32768;
    float* NL = (float*)(lds + NLo); float* AA = (float*)(lds + AAo); float* MM = (float*)(lds + MMo); float* WI = (float*)(lds + WIo); float* CF = (float*)(lds + CFo);
    float* SSQ = (float*)(lds + SSQo); float* X = (float*)(lds + XO);
    const int wid = F.wave;
    const int dir = wid >> 2, rb = (wid >> 1) & 1, vh = wid & 1;
    float* SCW = (float*)(lds + SCWo) + wid * 64;
    float* ST = (float*)(lds + STO) + (rb * 2 + vh) * 2048;
    for (int u = F.vcu * 8; u < NB * NH * 128; u += F.G * 8)
      for (int ui = 0; ui < 8; ++ui) {
        int lane = F.lane; asm volatile("" : "+v"(lane));
        const int tid = wid * 64 + lane, r32 = lane & 31, hi = lane >> 5;
        const int uu = u + ui, bh = uu >> 7, cl = uu & 127, b = bh >> 2, h = bh & 3, t0 = cl * 64, kidx0 = CT + t0;
        if (wid < 2) {
            const int d = wid, s = d ? 63 - lane : lane, cpos = d ? 127 - cl : cl;
            const float* g4 = F.gates + ((size_t)bh * TK + kidx0 + s) * 4 + d * 2;
            const float li = g4[0], lf = g4[1];
            const float bq = scan_add(lf, lane), aa = li - bq, pm = scan_max(aa, lane);
            const float M = MINV[(bh * 2 + d) * 128 + cpos], mm = fmaxf(M, pm);
            AA[d * 64 + lane] = aa * LOG2E; MM[d * 64 + lane] = mm * LOG2E; WI[d * 64 + lane] = __expf(M - mm); CF[d * 64 + lane] = __expf(-(bq + mm));
        }
        {
            const int krow = tid >> 3, kch = tid & 7, sr = tid >> 4, sc = (tid & 15) * 8;
            const v4u kv = *(const v4u*)(F.MK + ((size_t)bh * TK + kidx0 + krow) * 64 + kch * 8);
            const v4u v0 = *(const v4u*)(F.MV + ((size_t)bh * TK + kidx0 + sr) * 128 + sc), v1 = *(const v4u*)(F.MV + ((size_t)bh * TK + kidx0 + 32 + sr) * 128 + sc);
            const bf16* cf = CIN + ((size_t)(bh * 2 + 0) * 128 + cl) * CE; const bf16* cb = CIN + ((size_t)(bh * 2 + 1) * 128 + (127 - cl)) * CE;
            const v4u c0 = *(const v4u*)(cf + krow * 64 + kch * 8), c1 = *(const v4u*)(cf + (64 + krow) * 64 + kch * 8);
            const v4u c2 = *(const v4u*)(cb + krow * 64 + kch * 8), c3 = *(const v4u*)(cb + (64 + krow) * 64 + kch * 8);
            if (tid < 128) { const int d = tid >> 6, j = tid & 63; NL[d * 64 + j] = bf2f((d ? cb : cf)[128 * 64 + j]); }
            *(v4u*)(lds + KI + KSWZ64(krow, kch * 16)) = kv; *(v4u*)(lds + KI + 8192 + KSWZ64(63 - krow, kch * 16)) = kv;
            *(v4u*)(lds + VIo + v_st(sr, sc)) = v0; *(v4u*)(lds + VIo + v_st(32 + sr, sc)) = v1;
            *(v4u*)(lds + VIo + 16384 + v_st(63 - sr, sc)) = v0; *(v4u*)(lds + VIo + 16384 + v_st(31 - sr, sc)) = v1;
            *(v4u*)(lds + CI + KSWZ64(krow, kch * 16)) = c0; *(v4u*)(lds + CI + KSWZ64(64 + krow, kch * 16)) = c1;
            *(v4u*)(lds + CI + 16384 + KSWZ64(krow, kch * 16)) = c2; *(v4u*)(lds + CI + 16384 + KSWZ64(64 + krow, kch * 16)) = c3;
        }
        const int prow = rb * 32 + r32, srow = dir ? 63 - prow : prow;
        bf16x8 qr[4];
        { const bf16* qp = F.MQ + ((size_t)bh * TK + kidx0 + srow) * 64 + hi * 8;
#pragma unroll
          for (int d0 = 0; d0 < 4; ++d0) qr[d0] = *reinterpret_cast<const bf16x8*>(qp + d0 * 16); }
        __syncthreads();
        f32x16 p0 = {}, p1 = {};
        { const char* Ks = lds + KI + dir * 8192;
#pragma unroll
          for (int d0 = 0; d0 < 4; ++d0) { const int cbb = (d0 * 16 + hi * 8) * 2;
            const bf16x8 b0 = *reinterpret_cast<const bf16x8*>(Ks + KSWZ64(r32, cbb)), b1 = *reinterpret_cast<const bf16x8*>(Ks + KSWZ64(32 + r32, cbb));
            p0 = __builtin_amdgcn_mfma_f32_32x32x16_bf16(b0, qr[d0], p0, 0, 0, 0); p1 = __builtin_amdgcn_mfma_f32_32x32x16_bf16(b1, qr[d0], p1, 0, 0, 0); } }
        const float mmp = MM[dir * 64 + prow], wip = WI[dir * 64 + prow];
#pragma unroll
        for (int r = 0; r < 16; ++r) { const int k0 = crow(r, hi), k1 = 32 + k0;
            const float e0 = __builtin_amdgcn_exp2f(AA[dir * 64 + k0] - mmp), e1 = __builtin_amdgcn_exp2f(AA[dir * 64 + k1] - mmp);
            p0[r] *= (k0 <= prow) ? e0 : 0.f; p1[r] *= (k1 <= prow) ? e1 : 0.f; }
        float ps = 0.f;
#pragma unroll
        for (int r = 0; r < 16; ++r) ps += p0[r] + p1[r];
        float nq = 0.f;
#pragma unroll
        for (int d0 = 0; d0 < 4; ++d0)
#pragma unroll
            for (int j = 0; j < 8; ++j) nq += bf2f((unsigned short)qr[d0][j]) * NL[dir * 64 + d0 * 16 + hi * 8 + j];
        { auto rr = __builtin_amdgcn_permlane32_swap(__float_as_uint(ps), __float_as_uint(ps), false, false); ps = __uint_as_float(rr[0]) + __uint_as_float(rr[1]); }
        { auto rr = __builtin_amdgcn_permlane32_swap(__float_as_uint(nq), __float_as_uint(nq), false, false); nq = __uint_as_float(rr[0]) + __uint_as_float(rr[1]); }
        const float den = ps + wip * nq, rscale = 1.0f / fmaxf(fabsf(den), CF[dir * 64 + prow]);
        if (hi == 0) SCW[r32] = rscale;
        bf16x8 pa0, pa1, pa2, pa3;
#define PK4(P, BASE, OUT) do { unsigned a0 = cvtpk(P[BASE + 0], P[BASE + 1]), a1 = cvtpk(P[BASE + 2], P[BASE + 3]);   \
    unsigned b0 = cvtpk(P[BASE + 4], P[BASE + 5]), b1 = cvtpk(P[BASE + 6], P[BASE + 7]);                              \
    auto r0 = __builtin_amdgcn_permlane32_swap(a0, b0, false, false); auto r1 = __builtin_amdgcn_permlane32_swap(a1, b1, false, false); \
    u32x4 w = {r0[0], r1[0], r0[1], r1[1]}; OUT = *reinterpret_cast<bf16x8*>(&w); } while (0)
        PK4(p0, 0, pa0); PK4(p0, 8, pa1); PK4(p1, 0, pa2); PK4(p1, 8, pa3);
#undef PK4
        f32x16 o[2] = {};
        { const int vb = ldsb + VIo + dir * 16384 + v_rd_base(lane) + (2 * vh) * 512;
          da::pv_one<0>(o[0], vb, pa0, pa1, pa2, pa3); da::pv_one<1>(o[1], vb, pa0, pa1, pa2, pa3); }
        bf16x8 qs[4];
#pragma unroll
        for (int d0 = 0; d0 < 4; ++d0) { u32x4 w;
            w[0] = cvtpk(bf2f((unsigned short)qr[d0][0]) * wip, bf2f((unsigned short)qr[d0][1]) * wip); w[1] = cvtpk(bf2f((unsigned short)qr[d0][2]) * wip, bf2f((unsigned short)qr[d0][3]) * wip);
            w[2] = cvtpk(bf2f((unsigned short)qr[d0][4]) * wip, bf2f((unsigned short)qr[d0][5]) * wip); w[3] = cvtpk(bf2f((unsigned short)qr[d0][6]) * wip, bf2f((unsigned short)qr[d0][7]) * wip);
            qs[d0] = *reinterpret_cast<bf16x8*>(&w); }
        { const char* Cs = lds + CI + dir * 16384;
#pragma unroll
          for (int t = 0; t < 2; ++t)
#pragma unroll
            for (int ks = 0; ks < 4; ++ks) { const bf16x8 cfr = *reinterpret_cast<const bf16x8*>(Cs + KSWZ64((2 * vh + t) * 32 + r32, (ks * 16 + hi * 8) * 2));
                o[t] = __builtin_amdgcn_mfma_f32_32x32x16_bf16(qs[ks], cfr, o[t], 0, 0, 0); } }
        asm volatile("s_waitcnt lgkmcnt(0)" ::: "memory");
#pragma unroll
        for (int r = 0; r < 16; ++r) { const float sv = SCW[crow(r, hi)]; o[0][r] *= sv; o[1][r] *= sv; }
        __syncthreads();
        if (dir == 1) {
#pragma unroll
            for (int t = 0; t < 2; ++t)
#pragma unroll
                for (int r = 0; r < 16; ++r) X[(63 - (rb * 32 + crow(r, hi))) * 128 + (2 * vh + t) * 32 + r32] = o[t][r];
        }
        __syncthreads();
        float ssq[16];
        if (dir == 0) {
#pragma unroll
            for (int r = 0; r < 16; ++r) { float a = 0.f;
#pragma unroll
                for (int t = 0; t < 2; ++t) { o[t][r] += X[(rb * 32 + crow(r, hi)) * 128 + (2 * vh + t) * 32 + r32]; a += o[t][r] * o[t][r]; }
#pragma unroll
                for (int off = 1; off < 32; off <<= 1) a += __shfl_xor(a, off);
                ssq[r] = a; if (r32 == 0) SSQ[(rb * 2 + vh) * 32 + crow(r, hi)] = a; }
        }
        __syncthreads();
        if (dir == 0) {
            const float* gn = F.in[I_MLNG] + h * 128 + vh * 64;
#pragma unroll
            for (int r = 0; r < 16; ++r) { const float tot = ssq[r] + SSQ[(rb * 2 + (1 - vh)) * 32 + crow(r, hi)]; const float rs = 1.0f / sqrtf(tot * (1.f / 128.f) + EPS);
#pragma unroll
                for (int t = 0; t < 2; ++t) ST[crow(r, hi) * 64 + t * 32 + r32] = o[t][r] * rs * gn[t * 32 + r32]; }
            asm volatile("s_waitcnt lgkmcnt(0)" ::: "memory");
            const size_t row0 = (size_t)b * T + t0 + rb * 32;
#pragma unroll
            for (int it = 0; it < 4; ++it) { const int row = it * 8 + (lane >> 3), ch = lane & 7;
                const f32x4 y0 = *(const f32x4*)(ST + row * 64 + ch * 8), y1 = *(const f32x4*)(ST + row * 64 + ch * 8 + 4);
                const v4u mo = *(const v4u*)(F.MO + (row0 + row) * 512 + h * 128 + vh * 64 + ch * 8);
                v4u ov; ov.x = pk2(y0[0] * bflo(mo.x), y0[1] * bfhi(mo.x)); ov.y = pk2(y0[2] * bflo(mo.y), y0[3] * bfhi(mo.y)); ov.z = pk2(y1[0] * bflo(mo.z), y1[1] * bfhi(mo.z)); ov.w = pk2(y1[2] * bflo(mo.w), y1[3] * bfhi(mo.w));
                *(v4u*)(F.MIX + (row0 + row) * D + 512 + h * 128 + vh * 64 + ch * 8) = ov; }
        }
        __syncthreads();
      }
}
#undef KSWZ64
#undef ML_PK
}

__device__ __forceinline__ void p_final(Frame& F) {
    const int gw = F.vcu * NWAVES + F.wave, NGW = F.G * NWAVES, lane = F.lane;
    for (int row = gw; row < NTOK; row += NGW) {
        const float rstd = 1.0f / sqrtf(F.rowsq2[row] * (1.f / D) + EPS);
#pragma unroll
        for (int j = 0; j < 4; ++j) { const int col = 4 * lane + 256 * j; f32x4* p = (f32x4*)(F.out + (size_t)row * D + col);
            const f32x4 g = *(const f32x4*)(F.in[I_FING] + col); *p = (*p * rstd) * g; }
    }
}


#define XB_TMO      128
#define XB_XCNT(j)  (256  + 64 * (j))
#define XB_XSUB(j)  (1280 + 64 * (j))
#define XB_XGEN(j)  (2304 + 64 * (j))
#define XB_TOP      3328
#define XB_TOPGEN   3392
#define XCD_BAR_WORDS 3456
#define XB_SPIN_CAP (1u << 22)
constexpr int CW_BAR = 4096;
constexpr int MISC_OFF = 131072 + 320;
__device__ __forceinline__ unsigned xb_ld(unsigned* p)              { return __hip_atomic_load(p, __ATOMIC_RELAXED, __HIP_MEMORY_SCOPE_AGENT); }
__device__ __forceinline__ unsigned xb_add(unsigned* p, unsigned v) { return __hip_atomic_fetch_add(p, v, __ATOMIC_RELAXED, __HIP_MEMORY_SCOPE_AGENT); }
__device__ __forceinline__ unsigned xb_xcc_id() { return (unsigned)__builtin_amdgcn_s_getreg((3 << 11) | 20) & 0xFu; }
#define XB_SPIN(cond, bar) do { unsigned _sp = 0; while (cond) { __builtin_amdgcn_s_sleep(1); \
    if ((++_sp & 255u) == 0u) { if (xb_ld(&(bar)[XB_TMO])) break; if (_sp > XB_SPIN_CAP) { atomicAdd(&(bar)[XB_TMO], 1u); break; } } } } while (0)
struct XcdBarrier { unsigned* bar; unsigned x; volatile LAS unsigned* st; };
__device__ __forceinline__ XcdBarrier xcd_barrier_post(unsigned* bar, volatile LAS unsigned* st) {
    XcdBarrier b; b.bar = bar; b.x = xb_xcc_id(); b.st = st;
    if (threadIdx.x == 0) (void)xb_add(&bar[XB_XCNT(b.x)], 1u);
    return b;
}
__device__ __forceinline__ void xcd_barrier_complete(unsigned* bar, unsigned x, unsigned& nloc, unsigned& nx) {
    const unsigned G = gridDim.x * gridDim.y * gridDim.z;
    unsigned sum, cnt, mine, sp = 0u;
    for (;;) {
        sum = 0u; cnt = 0u; mine = 0u;
#pragma unroll
        for (unsigned j = 0; j < 16; ++j) { const unsigned c = xb_ld(&bar[XB_XCNT(j)]); sum += c; cnt += (c > 0u) ? 1u : 0u; mine = (j == x) ? c : mine; }
        if (sum == G) break;
        __builtin_amdgcn_s_sleep(1);
        if ((++sp & 255u) == 0u) { if (xb_ld(&bar[XB_TMO])) break; if (sp > XB_SPIN_CAP) { atomicAdd(&bar[XB_TMO], 1u); break; } }
    }
    nloc = mine > 0u ? mine : 1u; nx = cnt > 0u ? cnt : 1u;
}
__device__ __forceinline__ void xcd_barrier(const XcdBarrier& b) {
    asm volatile("s_waitcnt vmcnt(0)" ::: "memory");
    __syncthreads();
    if (threadIdx.x == 0) {
        unsigned* bar = b.bar;
        __builtin_amdgcn_s_waitcnt(0);
        unsigned nloc = b.st[0], nx = b.st[1];
        if (nloc == 0u) { xcd_barrier_complete(bar, b.x, nloc, nx); b.st[0] = nloc; b.st[1] = nx; }
        const unsigned old = xb_add(&bar[XB_XSUB(b.x)], 1u);
        const unsigned gen = old / nloc;
        if (old + 1u == (gen + 1u) * nloc) {
            __builtin_amdgcn_fence(__ATOMIC_RELEASE, "agent");
            asm volatile("s_waitcnt vmcnt(0)" ::: "memory");
            const unsigned og = xb_add(&bar[XB_TOP], 1u);
            const unsigned tg = og / nx;
            if (og + 1u == (tg + 1u) * nx) xb_add(&bar[XB_TOPGEN], 1u);
            else XB_SPIN(xb_ld(&bar[XB_TOPGEN]) == tg, bar);
            __builtin_amdgcn_fence(__ATOMIC_ACQUIRE, "agent");
            xb_add(&bar[XB_XGEN(b.x)], 1u);
            asm volatile("s_waitcnt vmcnt(0)" ::: "memory");
        } else {
            XB_SPIN(xb_ld(&bar[XB_XGEN(b.x)]) == gen, bar);
            __builtin_amdgcn_fence(__ATOMIC_ACQUIRE, "agent");
            asm volatile("s_waitcnt vmcnt(0)" ::: "memory");
        }
    }
    __syncthreads();
}

constexpr int NPHASE = 10;
__global__ void __launch_bounds__(NWAVES * 64, 2) fwd_kernel(Args args) {
    extern __shared__ __attribute__((aligned(16))) unsigned char lds_raw[];
    Frame F;
    F.lds = (LAS unsigned char*)lds_raw;
    F.tid = threadIdx.x; F.lane = F.tid & 63; F.wave = __builtin_amdgcn_readfirstlane(F.tid >> 6);
    F.G = gridDim.x; { const int bx = blockIdx.x; F.vcu = (F.G % 8 == 0) ? (bx % 8) * (F.G / 8) + bx / 8 : bx; }
#pragma unroll
    for (int i = 0; i < 20; ++i) F.in[i] = args.in[i];
    F.out = args.out; F.ws = args.ws; unsigned char* ws = args.ws;
    F.mod = (float*)(ws + WS_MOD); F.rope = (f32x2*)(ws + WS_ROPE); F.bias1 = (float*)(ws + WS_BIAS1); F.wgt = (float*)(ws + WS_WGT); F.gates = (float*)(ws + WS_G);
    F.rowsq1 = (float*)(ws + WS_ROWSQ1); F.rowsq2 = (float*)(ws + WS_ROWSQ2);
    F.WinT = (bf16*)(ws + WS_WIN); F.WoT = (bf16*)(ws + WS_WO); F.W1T = (bf16*)(ws + WS_W1); F.W2T = (bf16*)(ws + WS_W2);
    F.XM = (bf16*)(ws + WS_XM); F.A2 = (bf16*)(ws + WS_XM);
    F.Qd = (bf16*)(ws + WS_Q); F.Kd = (bf16*)(ws + WS_K); F.Vd = (bf16*)(ws + WS_V); F.MQ = (bf16*)(ws + WS_MQ); F.MK = (bf16*)(ws + WS_MK); F.MV = (bf16*)(ws + WS_MV); F.MO = (bf16*)(ws + WS_MO);
    F.HF = (float*)(ws + WS_DC); F.HB = (float*)(ws + WS_DC + 64 * MiB);
#if FAST_MLSTM
    F.MIX = (bf16*)(ws + WS_DC);
#else
    F.MIX = (bf16*)(ws + WS_CIN);
#endif
    F.Hh = (bf16*)(ws + WS_H);
    const int lo = args.ph_lo, hi = args.ph_hi;
    for (int u = F.tid; u < (LDS_BYTES - 131072) / 4; u += NWAVES * 64) ((LAS unsigned*)(F.lds + 131072))[u] = 0u;
    __syncthreads();
    XcdBarrier bar = xcd_barrier_post((unsigned*)(ws + WS_CTL) + CW_BAR + args.li * XCD_BAR_WORDS, (volatile LAS unsigned*)(F.lds + MISC_OFF));
#define IN(k) (refresh_ids(F), (lo <= (k) && (k) < hi))
#define SEAM(k) do { if (IN(k) && IN((k) + 1)) xcd_barrier(bar); } while (0)
    if (IN(0)) p0_prologue(F);
    SEAM(0);
    if (IN(1)) p1_rows(F);
    SEAM(1);
#if FAST_GEMM & 1
    if (IN(2)) { pg8::Gemm g{F.XM, F.WinT, MROWS, INP, D}; pg8::StaticOrder S; S.init(MROWS, INP, F.G, (int)blockIdx.x);
        EpiInproj E{F.Qd, F.Kd, F.Vd, F.MQ, F.MK, F.MV, F.MO, F.rope}; pg8::gemm_phase<EpiInproj, pg8::StaticOrder, true, true>(F.lds, g, S, E); }
#else
    if (IN(2)) naive_gemm(F, F.XM, D, MROWS, F.in[I_WIN], INC, INP, D, NaiveInprojEpi{});
#endif
    SEAM(2);
#if FAST_MLSTM
    if (IN(3)) ml::phase_a(F, (float*)(ws + WS_DC), (float*)(ws + WS_SCL));
    SEAM(3);
    if (IN(4)) ml::phase_b(F, (const float*)(ws + WS_DC), (const float*)(ws + WS_SCL), (bf16*)(ws + WS_CIN), (float*)(ws + WS_MIN));
    SEAM(4);
    if (IN(5)) { fast_attn(F); refresh_ids(F); ml::phase_c(F, (const bf16*)(ws + WS_CIN), (const float*)(ws + WS_MIN)); }
#else
    if (IN(3)) naive_mlstm(F);
    SEAM(3);
    SEAM(4);
    if (IN(5)) { fast_attn(F); refresh_ids(F); naive_mlstm_combine(F); }
#endif
    SEAM(5);
#if FAST_GEMM & 2
    if (IN(6)) { pg8::Gemm g{F.MIX, F.WoT, NTOK, D, D}; pg8::StaticOrder S; S.init(NTOK, D, F.G, (int)blockIdx.x);
        EpiOutproj E{F.in[I_X], F.out, F.A2, F.mod, F.in[I_N2G], F.rowsq1}; pg8::gemm_phase<EpiOutproj, pg8::StaticOrder, true, true>(F.lds, g, S, E); }
#else
    if (IN(6)) naive_gemm(F, F.MIX, D, NTOK, F.in[I_WOUT], D, D, D, NaiveOutprojEpi{});
#endif
    SEAM(6);
#if FAST_GEMM & 4
    if (IN(7)) { pg8::Gemm g{F.A2, F.W1T, NTOK, FF, D}; pg8::StaticOrder S; S.init(NTOK, FF, F.G, (int)blockIdx.x);
        EpiFc1 E{F.Hh, F.bias1, F.rowsq1}; pg8::gemm_phase<EpiFc1, pg8::StaticOrder, true, true>(F.lds, g, S, E); }
#else
    if (IN(7)) naive_gemm(F, F.A2, D, NTOK, F.in[I_WFC1], FF, FF, D, NaiveFc1Epi{});
#endif
    SEAM(7);
#if FAST_GEMM & 8
    if (IN(8)) { pg8::Gemm g{F.Hh, F.W2T, NTOK, D, FF}; pg8::StaticOrder S; S.init(NTOK, D, F.G, (int)blockIdx.x);
        EpiFc2 E{F.out, F.mod, F.rowsq2}; pg8::gemm_phase<EpiFc2, pg8::StaticOrder, true, true>(F.lds, g, S, E); }
#else
    if (IN(8)) naive_gemm(F, F.Hh, FF, NTOK, F.in[I_WFC2], D, D, FF, NaiveFc2Epi{});
#endif
    SEAM(8);
    if (IN(9)) p_final(F);
#undef IN
#undef SEAM
}

extern "C" void kernel_launch(void* const* d_in, const int* in_sizes, int n_in, void* d_out, int out_size, void* d_ws, size_t ws_size, hipStream_t stream) {
    static int grid = 0;
    if (grid == 0) {
        if (n_in != 20 || in_sizes[0] != NTOK * D || out_size != NTOK * D || ws_size < WS_END) { fprintf(stderr, "kernel_launch: unexpected shapes n_in %d in0 %d out %d ws %zu\n", n_in, n_in > 0 ? in_sizes[0] : -1, out_size, ws_size); grid = -1; return; }
        int dev = 0, cus = 0, per_cu = 0;
        if (hipGetDevice(&dev) != hipSuccess || hipDeviceGetAttribute(&cus, hipDeviceAttributeMultiprocessorCount, dev) != hipSuccess) { grid = -1; return; }
        if (hipFuncSetAttribute((const void*)fwd_kernel, hipFuncAttributeMaxDynamicSharedMemorySize, LDS_BYTES) != hipSuccess) { fprintf(stderr, "kernel_launch: hipFuncSetAttribute failed\n"); grid = -1; return; }
        if (hipOccupancyMaxActiveBlocksPerMultiprocessor(&per_cu, (const void*)fwd_kernel, NWAVES * 64, LDS_BYTES) != hipSuccess || per_cu < 1) { fprintf(stderr, "kernel_launch: occupancy query says %d\n", per_cu); per_cu = 1; }
        (void)hipGetLastError();
        grid = cus;
    }
    if (grid < 0) return;
    (void)hipMemsetAsync((char*)d_ws + WS_CTL, 0, CTL_ZERO_BYTES, stream);
    Args a{};
    for (int i = 0; i < 20; ++i) a.in[i] = (const float*)d_in[i];
    a.out = (float*)d_out; a.ws = (unsigned char*)d_ws;
    a.ph_lo = 0; a.ph_hi = NPHASE; a.li = 0;
    hipLaunchKernelGGL(fwd_kernel, dim3(grid), dim3(NWAVES * 64), LDS_BYTES, stream, a);
}
```

```cpp
#include <hip/hip_runtime.h>
#include <cstdio>
#include <cstdint>

constexpr int NB = 4, T = 8192, CT = 256, TK = T + CT, D = 1024, FF = 4096, NH = 4;
constexpr int NTOK = NB * T, NCTX = NB * CT, MROWS = NTOK + NCTX;
constexpr int INC = 3088, INP = 3072;
constexpr float EPS = 1e-6f;
constexpr float LAMBDA_INIT = 0.2f;
constexpr float C2 = 0.125f * 1.4426950408889634f;

constexpr size_t MiB = 1u << 20;
constexpr size_t WS_CTL = 0, CTL_ZERO_BYTES = 1 * MiB;
constexpr size_t WS_ROWSQ1 = 256 * 1024, WS_ROWSQ2 = 384 * 1024;
constexpr size_t WS_MOD = 1 * MiB;
constexpr size_t WS_ROPE = WS_MOD + 128 * 1024;
constexpr size_t WS_BIAS1 = WS_ROPE + 32 * 1024;
constexpr size_t WS_WGT = WS_BIAS1 + 64 * 1024;
constexpr size_t WS_SCL = WS_WGT + 64 * 1024;
constexpr size_t WS_MIN = WS_SCL + 64 * 1024;
constexpr size_t WS_WIN = 2 * MiB, WS_WO = 9 * MiB, WS_W1 = 11 * MiB, WS_W2 = 19 * MiB;
constexpr size_t WS_G = 27 * MiB;
constexpr size_t WS_XM = 32 * MiB;
constexpr size_t WS_Q = 98 * MiB, WS_K = 130 * MiB, WS_V = 163 * MiB, WS_MQ = 196 * MiB, WS_MK = 213 * MiB, WS_MV = 230 * MiB, WS_MO = 263 * MiB;
constexpr size_t WS_DC = 296 * MiB;
constexpr size_t WS_CIN = 430 * MiB;
constexpr size_t WS_MIX = 296 * MiB + 0;
constexpr size_t WS_H = 98 * MiB;
constexpr size_t WS_END = 512 * MiB;

typedef unsigned short bf16;
typedef unsigned v4u __attribute__((ext_vector_type(4)));
typedef unsigned v2u __attribute__((ext_vector_type(2)));
typedef float f32x4 __attribute__((ext_vector_type(4)));
typedef float f32x2 __attribute__((ext_vector_type(2)));
#define LAS __attribute__((address_space(3)))

__device__ __forceinline__ unsigned f2bf(float f) { unsigned u = __builtin_bit_cast(unsigned, f); return (u + 0x7fffu + ((u >> 16) & 1u)) >> 16; }
__device__ __forceinline__ unsigned pk2(float lo, float hi) { return f2bf(lo) | (f2bf(hi) << 16); }
__device__ __forceinline__ float bf2f(unsigned short b) { return __builtin_bit_cast(float, (unsigned)b << 16); }
__device__ __forceinline__ float bflo(unsigned w) { return __builtin_bit_cast(float, w << 16); }
__device__ __forceinline__ float bfhi(unsigned w) { return __builtin_bit_cast(float, w & 0xffff0000u); }
__device__ __forceinline__ float wave_sum(float v) {
#pragma unroll
    for (int o = 1; o < 64; o <<= 1) v += __shfl_xor(v, o);
    return v;
}
__device__ __forceinline__ float wave_max(float v) {
#pragma unroll
    for (int o = 1; o < 64; o <<= 1) v = fmaxf(v, __shfl_xor(v, o));
    return v;
}

#ifndef DOUBLE_MASK
#define DOUBLE_MASK 0
#endif
#ifndef FAST_MLSTM
#define FAST_MLSTM 1
#endif
#ifndef FAST_ATTN
#define FAST_ATTN 1
#endif
#ifndef FAST_GEMM
#define FAST_GEMM 15
#endif
constexpr int NWAVES = 8;
constexpr int LDS_BYTES = 147456;

struct Args {
    const float* in[20]; float* out; unsigned char* ws; int ph_lo, ph_hi, li, pad;
};
enum { I_X = 0, I_C, I_CTX, I_CCTX, I_WADA, I_BADA, I_N1G, I_N2G, I_WIN, I_BGATE, I_LQ1, I_LK1, I_LQ2, I_LK2, I_SUBLN, I_MLNG, I_WOUT, I_WFC1, I_WFC2, I_FING };

struct Frame {
    LAS unsigned char* lds;
    int tid, lane, wave, vcu, G;
    const float* in[20]; float* out; unsigned char* ws;
    float* mod; f32x2* rope; float* bias1; float* wgt; float* gates; float* rowsq1; float* rowsq2;
    bf16 *WinT, *WoT, *W1T, *W2T, *XM, *Qd, *Kd, *Vd, *MQ, *MK, *MV, *MO, *MIX, *A2, *Hh;
    float *HF, *HB;
};

__device__ __forceinline__ void refresh_ids(Frame& F) { int l = (int)__builtin_amdgcn_mbcnt_hi(~0u, __builtin_amdgcn_mbcnt_lo(~0u, 0u)); asm volatile("" : "+v"(l)); F.lane = l; F.tid = F.wave * 64 + l; }

__device__ __forceinline__ void gemv_item(Frame& F, const LAS float* a, int R, const float* W, int ldw, int col0, const float* bias, float* out, int ldo, LAS float* red) {
    const int w = F.wave, lane = F.lane, c = lane & 31, kp = lane >> 5;
    float acc[5] = {0.f, 0.f, 0.f, 0.f, 0.f};
    const float* wp = W + (size_t)(128 * w + kp) * ldw + col0 + c;
#pragma unroll 8
    for (int kk = 0; kk < 64; ++kk) {
        const float wv = wp[(size_t)(2 * kk) * ldw];
        const int k = 128 * w + 2 * kk + kp;
#pragma unroll
        for (int r = 0; r < 5; ++r) if (r < R) acc[r] += a[r * 1024 + k] * wv;
    }
#pragma unroll
    for (int r = 0; r < 5; ++r) acc[r] += __shfl_xor(acc[r], 32);
    if (lane < 32) {
#pragma unroll
        for (int r = 0; r < 5; ++r) red[(w * 5 + r) * 32 + lane] = acc[r];
    }
    __syncthreads();
    if (F.tid < R * 32) {
        const int r = F.tid >> 5, cc = F.tid & 31; float s = 0.f;
#pragma unroll
        for (int ww = 0; ww < 8; ++ww) s += red[(ww * 5 + r) * 32 + cc];
        out[(size_t)r * ldo + col0 + cc] = s + (bias ? bias[col0 + cc] : 0.f);
    }
    __syncthreads();
}

__device__ __forceinline__ void p0_transpose_item(const float* W, int K, int ldw, int nblk, bf16* WT, LAS float* scr, int item, int lane) {
    const int kb = item / nblk, nb = item % nblk, k0 = 64 * kb, n0 = 32 * nb;
#pragma unroll 8
    for (int i = 0; i < 32; ++i) { const int kk = 2 * i + (lane >> 5); scr[kk * 33 + (lane & 31)] = W[(size_t)(k0 + kk) * ldw + n0 + (lane & 31)]; }
    asm volatile("s_waitcnt lgkmcnt(0)" ::: "memory");
    const int c = lane & 7;
#pragma unroll
    for (int j = 0; j < 4; ++j) { const int n = (lane >> 3) + 8 * j; const LAS float* s = scr + (8 * c) * 33 + n;
        v4u o; o.x = pk2(s[0 * 33], s[1 * 33]); o.y = pk2(s[2 * 33], s[3 * 33]); o.z = pk2(s[4 * 33], s[5 * 33]); o.w = pk2(s[6 * 33], s[7 * 33]);
        *(v4u*)(WT + (size_t)(n0 + n) * K + k0 + 8 * c) = o; }
    asm volatile("s_waitcnt lgkmcnt(0)" ::: "memory");
}

__device__ __forceinline__ void p0_prologue(Frame& F) {
    LAS float* sa = (LAS float*)F.lds;
    LAS float* red = sa + 5 * 1024;
    for (int i = F.tid; i < 5 * 1024; i += 512) { const int r = i >> 10, k = i & 1023; const float c = r < 4 ? F.in[I_C][r * 1024 + k] : F.in[I_CCTX][k]; sa[i] = c / (1.f + __expf(-c)); }
    __syncthreads();
    for (int item = F.vcu; item < 192; item += F.G) gemv_item(F, sa, 5, F.in[I_WADA], 6 * D, item * 32, F.in[I_BADA], F.mod, 6 * D, red);
    LAS float* scr = (LAS float*)(F.lds + 32768 + F.wave * 8448);
    const int gw = F.vcu * NWAVES + F.wave, NGW = F.G * NWAVES;
    constexpr int I_IN = (D / 64) * (INP / 32), I_O = (D / 64) * (D / 32), I_1 = (D / 64) * (FF / 32), I_2 = (FF / 64) * (D / 32);
    for (int it = gw; it < I_IN + I_O + I_1 + I_2; it += NGW) {
        int r = it;
        if (r < I_IN) { p0_transpose_item(F.in[I_WIN], D, INC, INP / 32, F.WinT, scr, r, F.lane); continue; } r -= I_IN;
        if (r < I_O) { p0_transpose_item(F.in[I_WOUT], D, D, D / 32, F.WoT, scr, r, F.lane); continue; } r -= I_O;
        if (r < I_1) { p0_transpose_item(F.in[I_WFC1], D, FF, FF / 32, F.W1T, scr, r, F.lane); continue; } r -= I_1;
        p0_transpose_item(F.in[I_WFC2], FF, D, D / 32, F.W2T, scr, r, F.lane);
    }
    const int gt = F.vcu * 512 + F.tid, NGT = F.G * 512;
    for (int idx = gt; idx < 192 * 16; idx += NGT) {
        const int p = idx >> 4, j = idx & 15; const int pos = p < 128 ? p : p - 128;
        double inv = 1.0; for (int q = 0; q < j; ++q) inv *= 0.5623413251903491;
        const float ang = (float)pos * (float)inv;
        double a = (double)ang; const double TWO_PI = 6.283185307179586476925;
        const double n = __builtin_rint(a / TWO_PI); a -= n * TWO_PI;
        const double a2 = a * a; double sn = 0.0, cs = 0.0, ts = a, tc = 1.0;
        for (int q = 0; q < 14; ++q) { sn += ts; cs += tc; tc = -tc * a2 / (double)((2 * q + 1) * (2 * q + 2)); ts = -ts * a2 / (double)((2 * q + 2) * (2 * q + 3)); }
        F.rope[idx] = (f32x2){(float)cs, (float)sn};
    }
    for (int idx = gt; idx < 16 * 1024; idx += NGT) { const int g = idx >> 10, k = idx & 1023; F.wgt[idx] = F.in[I_WIN][(size_t)k * INC + INP + g]; }
}

__device__ __forceinline__ float log_sigmoid(float x) { return fminf(x, 0.f) - log1pf(__expf(-fabsf(x))); }
__device__ __forceinline__ void p1_rows(Frame& F) {
    LAS float* wg = (LAS float*)F.lds;
    LAS float* sa = (LAS float*)(F.lds + 65536);
    LAS float* red = (LAS float*)(F.lds + 65536 + 16384);
    for (int i = F.tid; i < 16 * 1024; i += 512) wg[i] = F.wgt[i];
    for (int i = F.tid; i < 4 * 1024; i += 512) sa[i] = F.mod[(i >> 10) * 6 * D + 3 * D + (i & 1023)];
    __syncthreads();
    for (int item = F.vcu; item < 128; item += F.G) gemv_item(F, sa, 4, F.in[I_WFC1], FF, item * 32, nullptr, F.bias1, FF, red);
    const int gw = F.vcu * NWAVES + F.wave, NGW = F.G * NWAVES, lane = F.lane;
    const float* g1n = F.in[I_N1G];
    f32x4 vn[4];
    if (gw < MROWS) { const float* src = gw < NTOK ? F.in[I_X] + (size_t)gw * D : F.in[I_CTX] + (size_t)(gw - NTOK) * D;
#pragma unroll
        for (int j = 0; j < 4; ++j) vn[j] = *(const f32x4*)(src + 4 * lane + 256 * j); }
    for (int row = gw; row < MROWS; row += NGW) {
        const bool lat = row < NTOK; const int b5 = lat ? (row >> 13) : 4;
        const float* modr = F.mod + (size_t)b5 * 6 * D;
        f32x4 v[4]; float ss = 0.f;
#pragma unroll
        for (int j = 0; j < 4; ++j) { v[j] = vn[j]; ss += (v[j].x * v[j].x + v[j].y * v[j].y) + (v[j].z * v[j].z + v[j].w * v[j].w); }
        { const int nrow = row + NGW;
          if (nrow < MROWS) { const float* src = nrow < NTOK ? F.in[I_X] + (size_t)nrow * D : F.in[I_CTX] + (size_t)(nrow - NTOK) * D;
#pragma unroll
            for (int j = 0; j < 4; ++j) vn[j] = *(const f32x4*)(src + 4 * lane + 256 * j); } }
        const float rstd = 1.0f / sqrtf(wave_sum(ss) * (1.f / D) + EPS);
        float acc[16]; f32x4 xm[4];
#pragma unroll
        for (int j = 0; j < 4; ++j) {
            const int col = 4 * lane + 256 * j;
            const f32x4 gg = *(const f32x4*)(g1n + col), sc = *(const f32x4*)(modr + D + col), sh = *(const f32x4*)(modr + col);
            xm[j] = (v[j] * rstd) * gg * (sc + 1.0f) + sh;
            v2u o; o.x = pk2(xm[j].x, xm[j].y); o.y = pk2(xm[j].z, xm[j].w);
            *(v2u*)(F.XM + (size_t)row * D + col) = o;
        }
#pragma unroll
        for (int g = 0; g < 16; ++g) {
            float a = 0.f;
#pragma unroll
            for (int j = 0; j < 4; ++j) { const f32x4 w = *(const LAS f32x4*)(wg + g * 1024 + 4 * lane + 256 * j); a += (xm[j].x * w.x + xm[j].y * w.y) + (xm[j].z * w.z + xm[j].w * w.w); }
            acc[g] = a;
            asm volatile("" ::: "memory");
        }
#pragma unroll
        for (int i = 0; i < 8; ++i) { const bool hi = lane & 32; const float mine = hi ? acc[i + 8] : acc[i], send = hi ? acc[i] : acc[i + 8]; acc[i] = mine + __shfl_xor(send, 32); }
#pragma unroll
        for (int i = 0; i < 4; ++i) { const bool hi = lane & 16; const float mine = hi ? acc[i + 4] : acc[i], send = hi ? acc[i] : acc[i + 4]; acc[i] = mine + __shfl_xor(send, 16); }
#pragma unroll
        for (int i = 0; i < 2; ++i) { const bool hi = lane & 8; const float mine = hi ? acc[i + 2] : acc[i], send = hi ? acc[i] : acc[i + 2]; acc[i] = mine + __shfl_xor(send, 8); }
        { const bool hi = lane & 4; const float mine = hi ? acc[1] : acc[0], send = hi ? acc[0] : acc[1]; acc[0] = mine + __shfl_xor(send, 4); }
        acc[0] += __shfl_xor(acc[0], 2); acc[0] += __shfl_xor(acc[0], 1);
        if ((lane & 3) == 0) {
            const int g = ((lane >> 5) & 1) * 8 + ((lane >> 4) & 1) * 4 + ((lane >> 3) & 1) * 2 + ((lane >> 2) & 1);
            const float val = acc[0] + F.in[I_BGATE][g]; const int type = g >> 2, h = g & 3;
            const float o = (type & 1) ? log_sigmoid(val) : val;
            const int b = lat ? (row >> 13) : ((row - NTOK) >> 8), kidx = lat ? (CT + (row & (T - 1))) : ((row - NTOK) & (CT - 1));
            F.gates[((size_t)(b * NH + h) * TK + kidx) * 4 + type] = o;
        }
    }
}

template <class Epi>
__device__ __forceinline__ void naive_gemm(Frame& F, const bf16* A, int lda, int M, const float* W, int ldw, int N, int K, const Epi& E) {
    LAS float* As = (LAS float*)F.lds;
    LAS float* Ws = As + 16 * 132;
    LAS float* Ct = (LAS float*)(F.lds + 32768);
    const int tid = F.tid, ty = tid >> 4, tx = tid & 15;
    const int tn_n = N / 128, ntiles = (M / 128) * tn_n;
    for (int tile = F.vcu; tile < ntiles; tile += F.G) {
        const int tm = tile / tn_n, tn = tile % tn_n;
        float acc[4][8];
#pragma unroll
        for (int i = 0; i < 4; ++i)
#pragma unroll
            for (int j = 0; j < 8; ++j) acc[i][j] = 0.f;
        const int ar = tid >> 2, ak = (tid & 3) * 4, wk = tid >> 5, wn = (tid & 31) * 4;
        const bf16* ap = A + (size_t)(tm * 128 + ar) * lda + ak;
        const float* wp = W + (size_t)wk * ldw + tn * 128 + wn;
        for (int k0 = 0; k0 < K; k0 += 16) {
            const v2u av = *(const v2u*)(ap + k0);
            const f32x4 wv = *(const f32x4*)(wp + (size_t)k0 * ldw);
            As[(ak + 0) * 132 + ar] = bflo(av.x); As[(ak + 1) * 132 + ar] = bfhi(av.x); As[(ak + 2) * 132 + ar] = bflo(av.y); As[(ak + 3) * 132 + ar] = bfhi(av.y);
            *(LAS f32x4*)(Ws + wk * 128 + wn) = wv;
            __syncthreads();
#pragma unroll
            for (int kk = 0; kk < 16; ++kk) {
                const f32x4 a = *(const LAS f32x4*)(As + kk * 132 + ty * 4);
                const f32x4 w0 = *(const LAS f32x4*)(Ws + kk * 128 + tx * 8), w1 = *(const LAS f32x4*)(Ws + kk * 128 + tx * 8 + 4);
                const float aa[4] = {a.x, a.y, a.z, a.w}; const float ww[8] = {w0.x, w0.y, w0.z, w0.w, w1.x, w1.y, w1.z, w1.w};
#pragma unroll
                for (int i = 0; i < 4; ++i)
#pragma unroll
                    for (int j = 0; j < 8; ++j) acc[i][j] += aa[i] * ww[j];
            }
            __syncthreads();
        }
#pragma unroll
        for (int i = 0; i < 4; ++i)
#pragma unroll
            for (int j = 0; j < 8; ++j) Ct[(ty * 4 + i) * 129 + tx * 8 + j] = acc[i][j];
        __syncthreads();
        E.tile(F, Ct, tm * 128, tn * 128);
        __syncthreads();
    }
}

__device__ __forceinline__ void row_decode(int row, bool& lat, int& b, int& t, int& kidx) {
    lat = row < NTOK;
    if (lat) { b = row >> 13; t = row & (T - 1); kidx = CT + t; } else { const int j = row - NTOK; b = j >> 8; t = -1; kidx = j & (CT - 1); }
}

struct NaiveInprojEpi {
    __device__ __forceinline__ void tile(Frame& F, const LAS float* Ct, int row0, int col0) const {
        for (int idx = F.tid; idx < 128 * 128; idx += 512) {
            const int r = idx >> 7, c = idx & 127, row = row0 + r, col = col0 + c;
            bool lat; int b, t, kidx; row_decode(row, lat, b, t, kidx);
            float val = Ct[r * 129 + c];
            if (col < 1024) {
                const bool isq = col < 512; const int cc = col & 511, h = cc >> 7, within = cc & 127, i = within & 63;
                if (isq && !lat) continue;
                if (lat) {
                    const bool lowhalf = (i & 31) < 16; const float partner = Ct[r * 129 + (lowhalf ? c + 16 : c - 16)];
                    const int pos = (i < 32) ? (t >> 6) : (128 + (t & 63)); const f32x2 cs = F.rope[pos * 16 + (i & 15)];
                    val = val * cs.x + (lowhalf ? -partner : partner) * cs.y;
                }
                if (isq) F.Qd[((size_t)(b * NH + h) * T + t) * 128 + within] = (bf16)f2bf(val * C2);
                else F.Kd[((size_t)(b * NH + h) * TK + kidx) * 128 + within] = (bf16)f2bf(val);
            } else if (col < 1536) { const int cc = col - 1024, h = cc >> 7, within = cc & 127; F.Vd[((size_t)(b * NH + h) * TK + kidx) * 128 + within] = (bf16)f2bf(val);
            } else if (col < 1792) { const int cc = col - 1536, h = cc >> 6, i = cc & 63; F.MQ[((size_t)(b * NH + h) * TK + kidx) * 64 + i] = (bf16)f2bf(val);
            } else if (col < 2048) { const int cc = col - 1792, h = cc >> 6, i = cc & 63; F.MK[((size_t)(b * NH + h) * TK + kidx) * 64 + i] = (bf16)f2bf(val * 0.125f);
            } else if (col < 2560) { const int cc = col - 2048, h = cc >> 7, within = cc & 127; F.MV[((size_t)(b * NH + h) * TK + kidx) * 128 + within] = (bf16)f2bf(val);
            } else { if (!lat) continue; F.MO[(size_t)row * 512 + (col - 2560)] = (bf16)f2bf(1.f / (1.f + __expf(-val))); }
        }
    }
};
struct NaiveOutprojEpi {
    __device__ __forceinline__ void tile(Frame& F, const LAS float* Ct, int row0, int col0) const {
        for (int rr = 0; rr < 16; ++rr) {
            const int r = F.wave * 16 + rr, row = row0 + r, b = row >> 13; const float* modr = F.mod + (size_t)b * 6 * D;
            float ss = 0.f;
#pragma unroll
            for (int e = 0; e < 2; ++e) { const int c = F.lane + 64 * e, col = col0 + c;
                const float x1 = F.in[I_X][(size_t)row * D + col] + modr[2 * D + col] * Ct[r * 129 + c];
                F.out[(size_t)row * D + col] = x1; ss += x1 * x1;
                F.A2[(size_t)row * D + col] = (bf16)f2bf(x1 * F.in[I_N2G][col] * (1.f + modr[4 * D + col])); }
            ss = wave_sum(ss); if (F.lane == 0) atomicAdd(F.rowsq1 + row, ss);
        }
    }
};
struct NaiveFc1Epi {
    __device__ __forceinline__ void tile(Frame& F, const LAS float* Ct, int row0, int col0) const {
        for (int idx = F.tid; idx < 128 * 128; idx += 512) {
            const int r = idx >> 7, c = idx & 127, row = row0 + r, col = col0 + c, b = row >> 13;
            const float rstd = 1.0f / sqrtf(F.rowsq1[row] * (1.f / D) + EPS);
            float v = rstd * Ct[r * 129 + c] + F.bias1[b * FF + col]; v = fmaxf(v, 0.f);
            F.Hh[(size_t)row * FF + col] = (bf16)f2bf(v * v);
        }
    }
};
struct NaiveFc2Epi {
    __device__ __forceinline__ void tile(Frame& F, const LAS float* Ct, int row0, int col0) const {
        for (int rr = 0; rr < 16; ++rr) {
            const int r = F.wave * 16 + rr, row = row0 + r, b = row >> 13; const float* modr = F.mod + (size_t)b * 6 * D;
            float ss = 0.f;
#pragma unroll
            for (int e = 0; e < 2; ++e) { const int c = F.lane + 64 * e, col = col0 + c;
                const float x2 = F.out[(size_t)row * D + col] + modr[5 * D + col] * Ct[r * 129 + c];
                F.out[(size_t)row * D + col] = x2; ss += x2 * x2; }
            ss = wave_sum(ss); if (F.lane == 0) atomicAdd(F.rowsq2 + row, ss);
        }
    }
};


namespace pg8 {
#define PG8_LAS __attribute__((address_space(3)))
typedef unsigned short bf16_t;
typedef short bf16x8 __attribute__((ext_vector_type(8)));
typedef float f32x4 __attribute__((ext_vector_type(4)));
typedef unsigned u32x4 __attribute__((ext_vector_type(4)));
constexpr int BM = 256, BK = 64, HALF = 128, HTB = HALF * BK * 2  , STAGE_BYTES = 8 * HTB, NXCD = 8, WGM = 8;

__host__ __device__ __forceinline__ int lds_byte(int r, int c) { const int st = (r >> 4) * 2 + (c >> 5), rr = r & 15, cc = c & 31, ob = rr * 64 + cc * 2; return st * 1024 + (ob ^ (((ob >> 9) & 1) << 5)); }
__host__ __device__ __forceinline__ void stage_rc(int b, int& R, int& C) { const int st = b / 1024, sb = b % 1024, swz = sb ^ (((sb >> 9) & 1) << 5); R = (st >> 1) * 16 + swz / 64; C = (st & 1) * 32 + (swz % 64) / 2; }
__host__ __device__ __forceinline__ int perm32(int rho) { const int n = rho >> 4, i = rho & 15; return 8 * (i >> 2) + 4 * n + (i & 3); }

struct Unit { int pm, pn; };
struct Gemm { const bf16_t* A; const bf16_t* Bt; int M, N, K; };

struct StaticOrder {
    int nM, nN, nwg, G, c;
    __host__ __device__ void init(int M, int N, int G_, int c_) { nM = M / BM; nN = N / BM; nwg = nM * nN; G = G_; c = c_; }
    __host__ __device__ bool next(int i, Unit& u) const {
        const long L = (long)i * G + c; if (L >= nwg) return false;
        int wgid = (int)L; { const int q = nwg / NXCD, r = nwg % NXCD, xcd = wgid % NXCD, off = wgid / NXCD; wgid = (xcd < r ? xcd * (q + 1) : r * (q + 1) + (xcd - r) * q) + off; }
        const int nig = WGM * nN, gid = wgid / nig, fm = gid * WGM, gsz = (nM - fm) < WGM ? (nM - fm) : WGM;
        u.pm = fm + ((wgid % nig) % gsz); u.pn = (wgid % nig) / gsz; return true;
    }
    __device__ __forceinline__ void a_ready(const Unit&) const {}
    __device__ __forceinline__ void done(const Unit&) const {}
};

__device__ __forceinline__ unsigned cvt_pk_bf16(float lo, float hi) { unsigned r; asm volatile("v_cvt_pk_bf16_f32 %0, %1, %2" : "=v"(r) : "v"(lo), "v"(hi)); return r; }
template <class Epi, class Sched, bool ALIGN_EPI = false, bool SP2 = false>
__device__ __forceinline__ void gemm_phase(PG8_LAS unsigned char* lds, const Gemm g, const Sched& S, const Epi& E) {
    const int tid = threadIdx.x, wid = __builtin_amdgcn_readfirstlane(tid >> 6), lane = tid & 63, wr = wid >> 2, wc = wid & 3, fr = lane & 15, fq = lane >> 4;
    const int K = g.K, nt = K / BK;
    unsigned voffA[2], voffB[2];
#pragma unroll
    for (int i = 0; i < 2; ++i) { int R, C; stage_rc(tid * 16 + i * 8192, R, C); const int Rb = Epi::PERM ? ((R & ~31) + perm32(R & 31)) : R;
        voffA[i] = (unsigned)(R * K + C) * 2u; voffB[i] = (unsigned)(Rb * K + C) * 2u; }
    const size_t kstep = (size_t)(BK * 2);
    const size_t hstep = (size_t)HALF * K * 2;
    const size_t tstep = 2 * hstep;
    const unsigned ldsw = (unsigned)wid * 1024u;
    const int aoff = lds_byte(wr * 64 + fr, fq * 8), boff = lds_byte(wc * 32 + fr, fq * 8);
#define PG8_SA(b, h) (((b) * 2 + (h)) * HTB)
#define PG8_SB(b, h) ((4 + (b) * 2 + (h)) * HTB)
#define PG8_STAGE(bufoff, gbase, voff) do { _Pragma("unroll") for (int _i = 0; _i < 2; ++_i) \
        __builtin_amdgcn_global_load_lds((const unsigned*)((const char*)(gbase) + (voff)[_i]), (PG8_LAS unsigned*)(lds + (bufoff) + ldsw + _i * 8192), 16, 0, 0); } while (0)
#define PG8_LDA(dst, b, h) do { _Pragma("unroll") for (int m = 0; m < 4; ++m) _Pragma("unroll") for (int k = 0; k < 2; ++k) dst[m][k] = *(const PG8_LAS bf16x8*)(lds + PG8_SA(b, h) + aoff + m * 2048 + k * 1024); } while (0)
#define PG8_LDB(dst, b, h) do { _Pragma("unroll") for (int n = 0; n < 2; ++n) _Pragma("unroll") for (int k = 0; k < 2; ++k) dst[n][k] = *(const PG8_LAS bf16x8*)(lds + PG8_SB(b, h) + boff + n * 2048 + k * 1024); } while (0)
#define PG8_MMA(ai, bj, At, Bt) do { __builtin_amdgcn_s_setprio(1); _Pragma("unroll") for (int m = 0; m < 4; ++m) _Pragma("unroll") for (int n = 0; n < 2; ++n) _Pragma("unroll") for (int k = 0; k < 2; ++k) \
        acc[ai][bj][m][n] = __builtin_amdgcn_mfma_f32_16x16x32_bf16(Bt[n][k], At[m][k], acc[ai][bj][m][n], 0, 0, 0); __builtin_amdgcn_s_setprio(0); } while (0)
#define PG8_WAIT_V(n) asm volatile("s_waitcnt vmcnt(" #n ")" ::: "memory")
#define PG8_WAIT_L(n) asm volatile("s_waitcnt lgkmcnt(" #n ")" ::: "memory")
#define PG8_BAR __builtin_amdgcn_s_barrier()
#define PG8_SCHED __builtin_amdgcn_sched_barrier(0)
    Unit cur, nxt; int ui = 0;
    if (!S.next(0, cur)) return;
    f32x4 acc[2][2][4][2];
#pragma unroll
    for (int a = 0; a < 2; ++a)
#pragma unroll
        for (int b = 0; b < 2; ++b)
#pragma unroll
            for (int m = 0; m < 4; ++m)
#pragma unroll
                for (int n = 0; n < 2; ++n) acc[a][b][m][n] = (f32x4){0.f, 0.f, 0.f, 0.f};
    bf16x8 At[4][2], B0[2][2], B1[2][2];
    const char* cA = (const char*)g.A + (size_t)cur.pm * tstep; const char* cB = (const char*)g.Bt + (size_t)cur.pn * tstep;
    S.a_ready(cur);
    if constexpr (SP2) {
        PG8_STAGE(PG8_SB(0, 0), cB, voffB); PG8_STAGE(PG8_SB(0, 1), cB + hstep, voffB); PG8_STAGE(PG8_SA(0, 0), cA, voffA); PG8_STAGE(PG8_SA(0, 1), cA + hstep, voffA);
        if (wr == 1) PG8_BAR;
        PG8_WAIT_V(2); PG8_BAR;
        PG8_STAGE(PG8_SB(1, 0), cB + kstep, voffB); PG8_STAGE(PG8_SA(1, 0), cA + kstep, voffA); PG8_STAGE(PG8_SB(1, 1), cB + hstep + kstep, voffB);
        PG8_WAIT_V(6); PG8_BAR;
    } else {
        PG8_STAGE(PG8_SB(0, 0), cB, voffB); PG8_STAGE(PG8_SA(0, 0), cA, voffA); PG8_STAGE(PG8_SB(0, 1), cB + hstep, voffB); PG8_STAGE(PG8_SA(0, 1), cA + hstep, voffA);
        if (wr == 1) PG8_BAR;
        PG8_WAIT_V(4); PG8_BAR;
        PG8_STAGE(PG8_SB(1, 0), cB + kstep, voffB); PG8_STAGE(PG8_SA(1, 0), cA + kstep, voffA); PG8_STAGE(PG8_SB(1, 1), cB + hstep + kstep, voffB);
        PG8_WAIT_V(6); PG8_BAR;
    }
    for (;;) {
        const bool has_next = S.next(ui + 1, nxt);
        const char* nA = has_next ? (const char*)g.A + (size_t)nxt.pm * tstep : cA; const char* nB = has_next ? (const char*)g.Bt + (size_t)nxt.pn * tstep : cB;
        for (int t = 0; t < nt; t += 2) {
            const bool last = (t == nt - 2);
            const char* a1 = cA + (size_t)(t + 1) * kstep;
            const char* a2 = last ? nA : cA + (size_t)(t + 2) * kstep; const char* b2 = last ? nB : cB + (size_t)(t + 2) * kstep;
            const char* a3 = a2 + kstep; const char* b3 = b2 + kstep;
            if (last && has_next) S.a_ready(nxt);
            if constexpr (SP2) {
            PG8_LDB(B0, 0, 0); PG8_LDB(B1, 0, 1); PG8_SCHED; PG8_LDA(At, 0, 0); PG8_STAGE(PG8_SA(1, 1), a1 + hstep, voffA);
            PG8_WAIT_V(8); PG8_WAIT_L(0); PG8_BAR; PG8_MMA(0, 0, At, B0); PG8_MMA(0, 1, At, B1); PG8_BAR; PG8_SCHED;
            PG8_LDA(At, 0, 1); PG8_STAGE(PG8_SB(0, 0), b2, voffB); PG8_STAGE(PG8_SB(0, 1), b2 + hstep, voffB); PG8_STAGE(PG8_SA(0, 0), a2, voffA);
            PG8_WAIT_V(8); PG8_WAIT_L(0); PG8_BAR; PG8_MMA(1, 0, At, B0); PG8_MMA(1, 1, At, B1); PG8_BAR; PG8_SCHED;
            PG8_LDB(B0, 1, 0); PG8_LDB(B1, 1, 1); PG8_SCHED; PG8_LDA(At, 1, 0); PG8_STAGE(PG8_SA(0, 1), a2 + hstep, voffA);
            PG8_WAIT_V(8); PG8_WAIT_L(0); PG8_BAR; PG8_MMA(0, 0, At, B0); PG8_MMA(0, 1, At, B1); PG8_BAR; PG8_SCHED;
            PG8_LDA(At, 1, 1); PG8_STAGE(PG8_SB(1, 0), b3, voffB); PG8_STAGE(PG8_SB(1, 1), b3 + hstep, voffB); PG8_STAGE(PG8_SA(1, 0), a3, voffA);
            PG8_WAIT_V(8); PG8_WAIT_L(0); PG8_BAR; PG8_MMA(1, 0, At, B0); PG8_MMA(1, 1, At, B1); PG8_BAR; PG8_SCHED;
            } else {
            PG8_LDB(B0, 0, 0); PG8_SCHED; PG8_LDA(At, 0, 0); PG8_STAGE(PG8_SA(1, 1), a1 + hstep, voffA);
            PG8_WAIT_L(8); PG8_BAR; PG8_WAIT_L(0); PG8_MMA(0, 0, At, B0); PG8_BAR; PG8_SCHED;
            PG8_LDB(B1, 0, 1); PG8_STAGE(PG8_SB(0, 0), b2, voffB);
            PG8_BAR; PG8_WAIT_L(0); PG8_MMA(0, 1, At, B1); PG8_BAR;
            PG8_LDA(At, 0, 1); PG8_STAGE(PG8_SA(0, 0), a2, voffA);
            PG8_BAR; PG8_WAIT_L(0); PG8_MMA(1, 0, At, B0); PG8_BAR; PG8_SCHED;
            PG8_STAGE(PG8_SB(0, 1), b2 + hstep, voffB);
            PG8_WAIT_V(6); PG8_BAR; PG8_MMA(1, 1, At, B1); PG8_BAR;
            PG8_LDB(B0, 1, 0); PG8_SCHED; PG8_LDA(At, 1, 0); PG8_STAGE(PG8_SA(0, 1), a2 + hstep, voffA);
            PG8_WAIT_L(8); PG8_BAR; PG8_WAIT_L(0); PG8_MMA(0, 0, At, B0); PG8_BAR; PG8_SCHED;
            PG8_LDB(B1, 1, 1); PG8_STAGE(PG8_SB(1, 0), b3, voffB);
            PG8_BAR; PG8_WAIT_L(0); PG8_MMA(0, 1, At, B1); PG8_BAR;
            PG8_LDA(At, 1, 1); PG8_STAGE(PG8_SA(1, 0), a3, voffA);
            PG8_BAR; PG8_WAIT_L(0); PG8_MMA(1, 0, At, B0); PG8_BAR; PG8_SCHED;
            PG8_STAGE(PG8_SB(1, 1), b3 + hstep, voffB);
            PG8_WAIT_V(6); PG8_BAR; PG8_MMA(1, 1, At, B1); PG8_BAR;
            }
        }
        if constexpr (ALIGN_EPI) { if (wr == 0) PG8_BAR; }
        if constexpr (!Epi::AFTER_DRAIN) { E(acc, cur, wr, wc, fr, fq); S.done(cur); }
        if (!has_next) break;
#pragma unroll
        for (int a = 0; a < 2; ++a)
#pragma unroll
            for (int b = 0; b < 2; ++b)
#pragma unroll
                for (int m = 0; m < 4; ++m)
#pragma unroll
                    for (int n = 0; n < 2; ++n) acc[a][b][m][n] = (f32x4){0.f, 0.f, 0.f, 0.f};
        cur = nxt; cA = nA; cB = nB; ++ui;
        if constexpr (ALIGN_EPI) { if (wr == 1) PG8_BAR; }
    }
    PG8_WAIT_V(0);
    if constexpr (!ALIGN_EPI) { if (wr == 0) PG8_BAR; }
    PG8_BAR;
    if constexpr (Epi::AFTER_DRAIN) { E.fused(acc, cur, wr, wc, fr, fq, lds, wid, lane); S.done(cur); }
#undef PG8_SA
#undef PG8_SB
#undef PG8_STAGE
#undef PG8_LDA
#undef PG8_LDB
#undef PG8_MMA
#undef PG8_WAIT_V
#undef PG8_WAIT_L
#undef PG8_BAR
#undef PG8_SCHED
}
}

__device__ __forceinline__ v4u pack8(const f32x4& a, const f32x4& b) { v4u w; w.x = pg8::cvt_pk_bf16(a[0], a[1]); w.y = pg8::cvt_pk_bf16(a[2], a[3]); w.z = pg8::cvt_pk_bf16(b[0], b[1]); w.w = pg8::cvt_pk_bf16(b[2], b[3]); return w; }
struct EpiInproj {
    static constexpr bool PERM = true, AFTER_DRAIN = false;
    bf16 *Qd, *Kd, *Vd, *MQ, *MK, *MV, *MO; const f32x2* rope;
    __device__ __forceinline__ void operator()(const f32x4 (&acc)[2][2][4][2], const pg8::Unit& u, int wr, int wc, int fr, int fq) const {
        const int pn = u.pn; const bool lat = u.pm < 128;
        if (!lat && (pn < 2 || pn >= 10)) return;
        const int b = lat ? (u.pm >> 5) : (u.pm - 128);
        const int tbase = lat ? ((u.pm & 31) * 256) : 0;
        const int within0 = wc * 32 + fq * 8;
        if (pn < 4) {
            const bool isq = pn < 2; const int hb = (pn & 1) * 2; const bool rowaxis = (wc & 1) == 0, low = fq < 2; const int j0 = (fq & 1) * 8;
#pragma unroll
            for (int ai = 0; ai < 2; ++ai)
#pragma unroll
                for (int m = 0; m < 4; ++m) {
                    const int rloc = ai * 128 + wr * 64 + m * 16 + fr, t = tbase + rloc;
                    f32x4 cs[4];
                    if (lat) { const int pos = rowaxis ? (t >> 6) : (128 + (t & 63)); const f32x4* rp = (const f32x4*)(rope + pos * 16 + j0);
#pragma unroll
                        for (int q = 0; q < 4; ++q) cs[q] = rp[q]; }
#pragma unroll
                    for (int bj = 0; bj < 2; ++bj) {
                        f32x4 v0 = acc[ai][bj][m][0], v1 = acc[ai][bj][m][1];
                        if (lat) {
                            f32x4 p0, p1;
#pragma unroll
                            for (int e = 0; e < 4; ++e) { p0[e] = __shfl_xor(v0[e], 32); p1[e] = __shfl_xor(v1[e], 32); }
                            if (low) { p0 = -p0; p1 = -p1; }
                            v0[0] = v0[0] * cs[0][0] + p0[0] * cs[0][1]; v0[1] = v0[1] * cs[0][2] + p0[1] * cs[0][3];
                            v0[2] = v0[2] * cs[1][0] + p0[2] * cs[1][1]; v0[3] = v0[3] * cs[1][2] + p0[3] * cs[1][3];
                            v1[0] = v1[0] * cs[2][0] + p1[0] * cs[2][1]; v1[1] = v1[1] * cs[2][2] + p1[1] * cs[2][3];
                            v1[2] = v1[2] * cs[3][0] + p1[2] * cs[3][1]; v1[3] = v1[3] * cs[3][2] + p1[3] * cs[3][3];
                        }
                        if (isq) { v0 = v0 * C2; v1 = v1 * C2; *(v4u*)(Qd + ((size_t)(b * NH + hb + bj) * T + t) * 128 + within0) = pack8(v0, v1); }
                        else *(v4u*)(Kd + ((size_t)(b * NH + hb + bj) * TK + (lat ? CT + t : rloc)) * 128 + within0) = pack8(v0, v1);
                    }
                }
        } else if (pn == 6 || pn == 7) {
            bf16* dst = pn == 6 ? MQ : MK; const float sc = pn == 6 ? 1.f : 0.125f; const int i0 = 32 * (wc & 1) + 8 * fq;
#pragma unroll
            for (int ai = 0; ai < 2; ++ai)
#pragma unroll
                for (int m = 0; m < 4; ++m) { const int rloc = ai * 128 + wr * 64 + m * 16 + fr, kidx = lat ? CT + tbase + rloc : rloc;
#pragma unroll
                    for (int bj = 0; bj < 2; ++bj) { const int h = 2 * bj + (wc >> 1);
                        *(v4u*)(dst + ((size_t)(b * NH + h) * TK + kidx) * 64 + i0) = pack8(acc[ai][bj][m][0] * sc, acc[ai][bj][m][1] * sc); } }
        } else if (pn < 10) {
            bf16* dst = pn < 6 ? Vd : MV; const int hb = (pn & 1) * 2;
#pragma unroll
            for (int ai = 0; ai < 2; ++ai)
#pragma unroll
                for (int m = 0; m < 4; ++m) { const int rloc = ai * 128 + wr * 64 + m * 16 + fr, kidx = lat ? CT + tbase + rloc : rloc;
#pragma unroll
                    for (int bj = 0; bj < 2; ++bj)
                        *(v4u*)(dst + ((size_t)(b * NH + hb + bj) * TK + kidx) * 128 + within0) = pack8(acc[ai][bj][m][0], acc[ai][bj][m][1]); }
        } else {
#pragma unroll
            for (int ai = 0; ai < 2; ++ai)
#pragma unroll
                for (int m = 0; m < 4; ++m) { const int row = u.pm * 256 + ai * 128 + wr * 64 + m * 16 + fr;
#pragma unroll
                    for (int bj = 0; bj < 2; ++bj) { f32x4 v0 = acc[ai][bj][m][0], v1 = acc[ai][bj][m][1];
#pragma unroll
                        for (int e = 0; e < 4; ++e) { v0[e] = __builtin_amdgcn_rcpf(1.f + __expf(-v0[e])); v1[e] = __builtin_amdgcn_rcpf(1.f + __expf(-v1[e])); }
                        *(v4u*)(MO + (size_t)row * 512 + (pn - 10) * 256 + bj * 128 + within0) = pack8(v0, v1); } }
        }
    }
};
struct EpiOutproj {
    static constexpr bool PERM = true, AFTER_DRAIN = false;
    const float* x; float* out; bf16* A2; const float* mod; const float* n2g; float* rowsq;
    __device__ __forceinline__ void operator()(const f32x4 (&acc)[2][2][4][2], const pg8::Unit& u, int wr, int wc, int fr, int fq) const {
        const int b = u.pm >> 5; const float* modr = mod + (size_t)b * 6 * D; const int col0 = u.pn * 256 + wc * 32 + fq * 8;
        f32x4 g1v[2][2], gs2[2][2];
#pragma unroll
        for (int bj = 0; bj < 2; ++bj)
#pragma unroll
            for (int n = 0; n < 2; ++n) { const int c = col0 + bj * 128 + 4 * n; g1v[bj][n] = *(const f32x4*)(modr + 2 * D + c);
                gs2[bj][n] = *(const f32x4*)(n2g + c) * (*(const f32x4*)(modr + 4 * D + c) + 1.0f); }
#pragma unroll
        for (int ai = 0; ai < 2; ++ai)
#pragma unroll
            for (int m = 0; m < 4; ++m) { const int row = u.pm * 256 + ai * 128 + wr * 64 + m * 16 + fr; float ss = 0.f;
#pragma unroll
                for (int bj = 0; bj < 2; ++bj) { const size_t o = (size_t)row * D + col0 + bj * 128;
                    const f32x4 x0 = *(const f32x4*)(x + o) + g1v[bj][0] * acc[ai][bj][m][0], x1 = *(const f32x4*)(x + o + 4) + g1v[bj][1] * acc[ai][bj][m][1];
                    *(f32x4*)(out + o) = x0; *(f32x4*)(out + o + 4) = x1;
                    ss += (x0[0] * x0[0] + x0[1] * x0[1]) + (x0[2] * x0[2] + x0[3] * x0[3]) + (x1[0] * x1[0] + x1[1] * x1[1]) + (x1[2] * x1[2] + x1[3] * x1[3]);
                    *(v4u*)(A2 + o) = pack8(x0 * gs2[bj][0], x1 * gs2[bj][1]); }
                ss += __shfl_xor(ss, 16); ss += __shfl_xor(ss, 32);
                if (fq == 0) atomicAdd(rowsq + row, ss); }
    }
};
struct EpiFc1 {
    static constexpr bool PERM = true, AFTER_DRAIN = false;
    bf16* Hh; const float* bias1; const float* rowsq;
    __device__ __forceinline__ void operator()(const f32x4 (&acc)[2][2][4][2], const pg8::Unit& u, int wr, int wc, int fr, int fq) const {
        const int b = u.pm >> 5; const int col0 = u.pn * 256 + wc * 32 + fq * 8;
        f32x4 bv[2][2];
#pragma unroll
        for (int bj = 0; bj < 2; ++bj)
#pragma unroll
            for (int n = 0; n < 2; ++n) bv[bj][n] = *(const f32x4*)(bias1 + (size_t)b * FF + col0 + bj * 128 + 4 * n);
#pragma unroll
        for (int ai = 0; ai < 2; ++ai)
#pragma unroll
            for (int m = 0; m < 4; ++m) { const int row = u.pm * 256 + ai * 128 + wr * 64 + m * 16 + fr;
                const float rstd = 1.0f / sqrtf(rowsq[row] * (1.f / D) + EPS);
#pragma unroll
                for (int bj = 0; bj < 2; ++bj) { f32x4 v0 = acc[ai][bj][m][0] * rstd + bv[bj][0], v1 = acc[ai][bj][m][1] * rstd + bv[bj][1];
#pragma unroll
                    for (int e = 0; e < 4; ++e) { const float a0 = fmaxf(v0[e], 0.f), a1 = fmaxf(v1[e], 0.f); v0[e] = a0 * a0; v1[e] = a1 * a1; }
                    *(v4u*)(Hh + (size_t)row * FF + col0 + bj * 128) = pack8(v0, v1); } }
    }
};
struct EpiFc2 {
    static constexpr bool PERM = true, AFTER_DRAIN = false;
    float* out; const float* mod; float* rowsq;
    __device__ __forceinline__ void operator()(const f32x4 (&acc)[2][2][4][2], const pg8::Unit& u, int wr, int wc, int fr, int fq) const {
        const int b = u.pm >> 5; const float* modr = mod + (size_t)b * 6 * D; const int col0 = u.pn * 256 + wc * 32 + fq * 8;
        f32x4 g2v[2][2];
#pragma unroll
        for (int bj = 0; bj < 2; ++bj)
#pragma unroll
            for (int n = 0; n < 2; ++n) g2v[bj][n] = *(const f32x4*)(modr + 5 * D + col0 + bj * 128 + 4 * n);
#pragma unroll
        for (int ai = 0; ai < 2; ++ai)
#pragma unroll
            for (int m = 0; m < 4; ++m) { const int row = u.pm * 256 + ai * 128 + wr * 64 + m * 16 + fr; float ss = 0.f;
#pragma unroll
                for (int bj = 0; bj < 2; ++bj) { const size_t o = (size_t)row * D + col0 + bj * 128;
                    const f32x4 x0 = *(const f32x4*)(out + o) + g2v[bj][0] * acc[ai][bj][m][0], x1 = *(const f32x4*)(out + o + 4) + g2v[bj][1] * acc[ai][bj][m][1];
                    *(f32x4*)(out + o) = x0; *(f32x4*)(out + o + 4) = x1;
                    ss += (x0[0] * x0[0] + x0[1] * x0[1]) + (x0[2] * x0[2] + x0[3] * x0[3]) + (x1[0] * x1[0] + x1[1] * x1[1]) + (x1[2] * x1[2] + x1[3] * x1[3]); }
                ss += __shfl_xor(ss, 16); ss += __shfl_xor(ss, 32);
                if (fq == 0) atomicAdd(rowsq + row, ss); }
    }
};

__device__ __forceinline__ void naive_mlstm(Frame& F) {
    LAS float* ks = (LAS float*)F.lds;
    LAS float* qs = ks + 64 * 64;
    LAS float* vs = qs + 64 * 64;
    LAS float* fg = vs + 64 * 128;
    LAS float* ig = fg + 64;
    const int tid = F.tid, v = tid >> 2, dq = (tid & 3) * 16;
    for (int item = F.vcu; item < 32; item += F.G) {
        const int bh = item >> 1, dir = item & 1;
        float C[16], n[16];
#pragma unroll
        for (int e = 0; e < 16; ++e) { C[e] = 0.f; n[e] = 0.f; }
        float* Hout = (dir ? F.HB : F.HF) + (size_t)bh * T * 128;
        for (int blk = 0; blk < TK / 64; ++blk) {
            int c;
            if (!dir) c = blk; else c = (blk < 4) ? (3 - blk) : (TK / 64 - 1 - (blk - 4));
            const int kidx0 = c * 64; const bool lat = c >= 4;
            const size_t base64 = ((size_t)bh * TK + kidx0) * 64, base128 = ((size_t)bh * TK + kidx0) * 128;
            for (int i = tid; i < 64 * 64; i += 512) { ks[i] = bf2f(F.MK[base64 + i]); qs[i] = bf2f(F.MQ[base64 + i]); }
            for (int i = tid; i < 64 * 128; i += 512) vs[i] = bf2f(F.MV[base128 + i]);
            if (tid < 64) { const float* g = F.gates + ((size_t)bh * TK + kidx0 + tid) * 4 + dir * 2; ig[tid] = __expf(g[0]); fg[tid] = __expf(g[1]); }
            __syncthreads();
            for (int step = 0; step < 64; ++step) {
                const int s = dir ? 63 - step : step;
                const float f = fg[s], iw = ig[s], vv = vs[s * 128 + v] * iw;
                float num = 0.f, den = 0.f;
#pragma unroll
                for (int e = 0; e < 16; ++e) { const float kk = ks[s * 64 + dq + e], qq = qs[s * 64 + dq + e];
                    C[e] = f * C[e] + vv * kk; n[e] = f * n[e] + iw * kk; num += C[e] * qq; den += n[e] * qq; }
                if (lat) {
                    num += __shfl_xor(num, 1); num += __shfl_xor(num, 2); den += __shfl_xor(den, 1); den += __shfl_xor(den, 2);
                    if ((tid & 3) == 0) Hout[(size_t)(kidx0 - CT + s) * 128 + v] = num / fmaxf(fabsf(den), 1.f);
                }
            }
            __syncthreads();
        }
    }
}
__device__ __forceinline__ void naive_mlstm_combine(Frame& F) {
    const int gw = F.vcu * NWAVES + F.wave, NGW = F.G * NWAVES, lane = F.lane;
    for (int rid = gw; rid < NTOK * NH; rid += NGW) {
        const int row = rid >> 2, h = rid & 3, b = row >> 13, t = row & (T - 1);
        const size_t o = ((size_t)(b * NH + h) * T + t) * 128 + 2 * lane;
        const float a0 = F.HF[o] + F.HB[o], a1 = F.HF[o + 1] + F.HB[o + 1];
        const float r = 1.0f / sqrtf(wave_sum(a0 * a0 + a1 * a1) * (1.f / 128.f) + EPS);
        const float* g = F.in[I_MLNG] + h * 128 + 2 * lane;
        const unsigned mo = *(const unsigned*)(F.MO + (size_t)row * 512 + h * 128 + 2 * lane);
        *(unsigned*)(F.MIX + (size_t)row * D + 512 + h * 128 + 2 * lane) = pk2(a0 * r * g[0] * bflo(mo), a1 * r * g[1] * bfhi(mo));
    }
}

__device__ __forceinline__ void naive_attn(Frame& F) {
    LAS float* qs = (LAS float*)F.lds + F.wave * 64;
    const int gw = F.vcu * NWAVES + F.wave, NGW = F.G * NWAVES, lane = F.lane;
    float lam;
    { const float s1 = wave_sum(F.in[I_LQ1][lane] * F.in[I_LK1][lane]), s2 = wave_sum(F.in[I_LQ2][lane] * F.in[I_LK2][lane]); lam = __expf(s1) - __expf(s2) + LAMBDA_INIT; }
    for (int rid = gw; rid < NB * NH * T; rid += NGW) {
        const int bh = rid >> 13, t = rid & (T - 1), b = bh >> 2, h = bh & 3;
        float o0 = 0.f, o1 = 0.f;
        for (int map = 0; map < 2; ++map) {
            qs[lane] = bf2f(F.Qd[((size_t)bh * T + t) * 128 + map * 64 + lane]);
            asm volatile("s_waitcnt lgkmcnt(0)" ::: "memory");
            float m = -1e30f, l = 0.f, a0 = 0.f, a1 = 0.f;
            for (int ch = 0; ch < TK / 64; ++ch) {
                const bf16* kp = F.Kd + ((size_t)bh * TK + ch * 64 + lane) * 128 + map * 64;
                float s = 0.f;
#pragma unroll
                for (int d8 = 0; d8 < 8; ++d8) { const v4u kv = *(const v4u*)(kp + d8 * 8); const f32x4 qa = *(const LAS f32x4*)(qs + d8 * 8), qb = *(const LAS f32x4*)(qs + d8 * 8 + 4);
                    s += bflo(kv.x) * qa.x + bfhi(kv.x) * qa.y + bflo(kv.y) * qa.z + bfhi(kv.y) * qa.w + bflo(kv.z) * qb.x + bfhi(kv.z) * qb.y + bflo(kv.w) * qb.z + bfhi(kv.w) * qb.w; }
                const float mn = fmaxf(m, wave_max(s)), alpha = exp2f(m - mn), p = exp2f(s - mn);
                l = l * alpha + wave_sum(p); a0 *= alpha; a1 *= alpha; m = mn;
                const bf16* vp = F.Vd + ((size_t)bh * TK + ch * 64) * 128 + 2 * lane;
#pragma unroll 8
                for (int kk = 0; kk < 64; ++kk) { const float pk = __shfl(p, kk); const unsigned vv = *(const unsigned*)(vp + (size_t)kk * 128); a0 += pk * bflo(vv); a1 += pk * bfhi(vv); }
            }
            const float il = 1.f / l;
            if (map == 0) { o0 = a0 * il; o1 = a1 * il; } else { o0 -= lam * a0 * il; o1 -= lam * a1 * il; }
        }
        const float r = 1.0f / sqrtf(wave_sum(o0 * o0 + o1 * o1) * (1.f / 128.f) + EPS);
        const float* g = F.in[I_SUBLN] + 2 * lane;
        *(unsigned*)(F.MIX + (size_t)(b * T + t) * D + h * 128 + 2 * lane) = pk2(o0 * r * g[0] * (1.f - LAMBDA_INIT), o1 * r * g[1] * (1.f - LAMBDA_INIT));
    }
}


namespace da {
using bf16x8 = __attribute__((ext_vector_type(8))) short;
using s16x4  = __attribute__((ext_vector_type(4))) short;
using f32x16 = __attribute__((ext_vector_type(16))) float;
using u32x4  = __attribute__((ext_vector_type(4))) unsigned;
constexpr int KVBLK = 64;
constexpr size_t SHM_V = KVBLK * 128 * 2, SHM_K = KVBLK * 128 * 2;
constexpr float THR2 = 8.f * 1.4426950408889634f;
#define KSWZ(row, colB) ((row) * 256 + ((colB) ^ (((row) & 7) << 4)))
#define SBAR() __builtin_amdgcn_sched_barrier(0)
__device__ __forceinline__ int crow(int r, int hi) { return (r & 3) + 8 * (r >> 2) + 4 * hi; }
__device__ __forceinline__ unsigned cvtpk(float lo, float hi) { unsigned r; asm volatile("v_cvt_pk_bf16_f32 %0, %1, %2" : "=v"(r) : "v"(lo), "v"(hi)); return r; }
__device__ __forceinline__ void partialSM(f32x16& p0, f32x16& p1, float& m_reg, float& mn, float& alpha) {
  float pmax = p0[0]; for (int r = 1; r < 16; ++r) pmax = fmaxf(pmax, p0[r]); for (int r = 0; r < 16; ++r) pmax = fmaxf(pmax, p1[r]);
  { auto rr = __builtin_amdgcn_permlane32_swap(__float_as_uint(pmax), __float_as_uint(pmax), false, false);
    pmax = fmaxf(__uint_as_float(rr[0]), __uint_as_float(rr[1])); }
  if (__builtin_expect(__all(pmax - m_reg <= THR2), 1)) { mn = m_reg; alpha = 1.f; }
  else { mn = fmaxf(m_reg, pmax); alpha = __builtin_amdgcn_exp2f(m_reg - mn); m_reg = mn; }
  for (int r = 0; r < 16; ++r) p0[r] = p0[r] - mn; for (int r = 0; r < 16; ++r) p1[r] = p1[r] - mn;
  for (int r = 0; r < 16; ++r) p0[r] = __builtin_amdgcn_exp2f(p0[r]);
}
__device__ __forceinline__ void finishSM(f32x16& p0, f32x16& p1, float alpha, float& l_reg, bf16x8& pa0, bf16x8& pa1, bf16x8& pa2, bf16x8& pa3) {
  for (int r = 0; r < 16; ++r) p1[r] = __builtin_amdgcn_exp2f(p1[r]);
  float ps = 0; for (int r = 0; r < 16; ++r) ps += p0[r]; for (int r = 0; r < 16; ++r) ps += p1[r];
  { auto rr = __builtin_amdgcn_permlane32_swap(__float_as_uint(ps), __float_as_uint(ps), false, false);
    ps = __uint_as_float(rr[0]) + __uint_as_float(rr[1]); }
  l_reg = l_reg * alpha + ps;
#define PK4(P, BASE, OUT) do { unsigned a0 = cvtpk(P[BASE + 0], P[BASE + 1]), a1 = cvtpk(P[BASE + 2], P[BASE + 3]);   \
    unsigned b0 = cvtpk(P[BASE + 4], P[BASE + 5]), b1 = cvtpk(P[BASE + 6], P[BASE + 7]);                              \
    auto r0 = __builtin_amdgcn_permlane32_swap(a0, b0, false, false); auto r1 = __builtin_amdgcn_permlane32_swap(a1, b1, false, false); \
    u32x4 w = {r0[0], r1[0], r0[1], r1[1]}; OUT = *reinterpret_cast<bf16x8*>(&w); } while (0)
  PK4(p0, 0, pa0); PK4(p0, 8, pa1); PK4(p1, 0, pa2); PK4(p1, 8, pa3);
#undef PK4
}
__device__ __forceinline__ void qkt(f32x16& p0, f32x16& p1, const char* Ks, const bf16x8* qr, int r32, int hi, int mapB) {
  p0 = f32x16{}; p1 = f32x16{};
  for (int d0 = 0; d0 < 4; ++d0) { int cb = mapB + (d0 * 16 + hi * 8) * 2;
    bf16x8 b0 = *reinterpret_cast<const bf16x8*>(Ks + KSWZ(r32, cb));
    bf16x8 b1 = *reinterpret_cast<const bf16x8*>(Ks + KSWZ(32 + r32, cb));
    p0 = __builtin_amdgcn_mfma_f32_32x32x16_bf16(b0, qr[d0], p0, 0, 0, 0);
    p1 = __builtin_amdgcn_mfma_f32_32x32x16_bf16(b1, qr[d0], p1, 0, 0, 0); }
}
__device__ __forceinline__ int v_st(int k, int c) { const int kk = (k & ~0xC) | ((k & 4) << 1) | ((k & 8) >> 1); return ((kk >> 3) * 4 + (c >> 5)) * 512 + ((kk & 7) * 32 + (c & 31)) * 2; }
__device__ __forceinline__ int v_rd_base(int lane) { return ((lane & 3) << 3) | (((lane >> 2) & 3) << 6) | (((lane >> 4) & 1) << 5) | (((lane >> 5) & 1) << 8); }
constexpr int v_rd_off(int d0, int ks, int half) { return d0 * 512 + ks * 4096 + half * 2048; }
template <int OFF> __device__ __forceinline__ s16x4 tr_read(int vb) {
  s16x4 r; asm volatile("ds_read_b64_tr_b16 %0, %1 offset:%2" : "=&v"(r) : "v"(vb), "i"(OFF) : "memory"); return r;
}
template <int D0> __device__ __forceinline__ void pv_one(f32x16& od, int vb, bf16x8 pa0, bf16x8 pa1, bf16x8 pa2, bf16x8 pa3) {
  const s16x4 l0 = tr_read<v_rd_off(D0, 0, 0)>(vb), h0 = tr_read<v_rd_off(D0, 0, 1)>(vb), l1 = tr_read<v_rd_off(D0, 1, 0)>(vb), h1 = tr_read<v_rd_off(D0, 1, 1)>(vb);
  const s16x4 l2 = tr_read<v_rd_off(D0, 2, 0)>(vb), h2 = tr_read<v_rd_off(D0, 2, 1)>(vb), l3 = tr_read<v_rd_off(D0, 3, 0)>(vb), h3 = tr_read<v_rd_off(D0, 3, 1)>(vb);
  asm volatile("s_waitcnt lgkmcnt(0)" ::: "memory"); SBAR();
#define PK(L, H) (bf16x8){L[0], L[1], L[2], L[3], H[0], H[1], H[2], H[3]}
  od = __builtin_amdgcn_mfma_f32_32x32x16_bf16(pa0, PK(l0, h0), od, 0, 0, 0);
  od = __builtin_amdgcn_mfma_f32_32x32x16_bf16(pa1, PK(l1, h1), od, 0, 0, 0);
  od = __builtin_amdgcn_mfma_f32_32x32x16_bf16(pa2, PK(l2, h2), od, 0, 0, 0);
  od = __builtin_amdgcn_mfma_f32_32x32x16_bf16(pa3, PK(l3, h3), od, 0, 0, 0);
#undef PK
}
#define PV_RD(D0, S) const s16x4 S##l0 = tr_read<v_rd_off(D0, 0, 0)>(vb), S##h0 = tr_read<v_rd_off(D0, 0, 1)>(vb), S##l1 = tr_read<v_rd_off(D0, 1, 0)>(vb), S##h1 = tr_read<v_rd_off(D0, 1, 1)>(vb), \
    S##l2 = tr_read<v_rd_off(D0, 2, 0)>(vb), S##h2 = tr_read<v_rd_off(D0, 2, 1)>(vb), S##l3 = tr_read<v_rd_off(D0, 3, 0)>(vb), S##h3 = tr_read<v_rd_off(D0, 3, 1)>(vb)
#define PV_PK(L, H) (bf16x8){L[0], L[1], L[2], L[3], H[0], H[1], H[2], H[3]}
#define PV_MM(od, S) do { od = __builtin_amdgcn_mfma_f32_32x32x16_bf16(pa0, PV_PK(S##l0, S##h0), od, 0, 0, 0); od = __builtin_amdgcn_mfma_f32_32x32x16_bf16(pa1, PV_PK(S##l1, S##h1), od, 0, 0, 0); \
    od = __builtin_amdgcn_mfma_f32_32x32x16_bf16(pa2, PV_PK(S##l2, S##h2), od, 0, 0, 0); od = __builtin_amdgcn_mfma_f32_32x32x16_bf16(pa3, PV_PK(S##l3, S##h3), od, 0, 0, 0); } while (0)
__device__ __forceinline__ void pv_d0(f32x16* o, int vb, bf16x8 pa0, bf16x8 pa1, bf16x8 pa2, bf16x8 pa3) {
  PV_RD(0, a); PV_RD(1, b);
  asm volatile("s_waitcnt lgkmcnt(8)" ::: "memory"); SBAR();
  PV_MM(o[0], a);
  SBAR(); PV_RD(2, c);
  asm volatile("s_waitcnt lgkmcnt(8)" ::: "memory"); SBAR();
  PV_MM(o[1], b);
  SBAR(); PV_RD(3, d);
  asm volatile("s_waitcnt lgkmcnt(8)" ::: "memory"); SBAR();
  PV_MM(o[2], c);
  asm volatile("s_waitcnt lgkmcnt(0)" ::: "memory"); SBAR();
  PV_MM(o[3], d);
}
__device__ __forceinline__ void da_unit(const bf16* __restrict__ Qb, const bf16* __restrict__ Kh, const bf16* __restrict__ Vh, bf16* __restrict__ Mx,
                                        const float* __restrict__ subg, float lam, int seq, char* lds) {
  int tid = threadIdx.x; asm volatile("" : "+v"(tid));
  const int wid = tid >> 6, lane = tid & 63, r32 = lane & 31, hi = lane >> 5, map = wid >> 2, wq = wid & 3;
  char* V_lds = lds; char* K_lds = lds + 3 * SHM_V;
  float* ws = (float*)(lds + 3 * SHM_V + 3 * SHM_K) + wid * 64; float* li_l = ws; float* al_l = ws + 32;
  float m_reg = -1e30f, l_reg = 0; f32x16 o[4] = {}; bf16x8 qr[4];
  const bf16* Qw = Qb + (long)(wq * 32 + r32) * 128 + map * 64 + hi * 8;
#pragma unroll
  for (int d0 = 0; d0 < 4; ++d0) qr[d0] = *reinterpret_cast<const bf16x8*>(Qw + d0 * 16);
  const int mapB = map * 128;
  const int sr = tid >> 4, sc = (tid & 15) * 8, vst0 = v_st(sr, sc), vst1 = v_st(32 + sr, sc);
  const int vb0 = (int)(uintptr_t)V_lds + v_rd_base(lane);
  struct { bf16x8 vs0, vs1, ks0, ks1; } sr_;
#define SLOAD(k0) do { sr_.vs0 = *reinterpret_cast<const bf16x8*>(&Vh[(long)((k0) + sr) * 128 + sc]); sr_.vs1 = *reinterpret_cast<const bf16x8*>(&Vh[(long)((k0) + 32 + sr) * 128 + sc]); \
    sr_.ks0 = *reinterpret_cast<const bf16x8*>(&Kh[(long)((k0) + sr) * 128 + sc]); sr_.ks1 = *reinterpret_cast<const bf16x8*>(&Kh[(long)((k0) + 32 + sr) * 128 + sc]); } while (0)
#define SWRITE(so) do { *(bf16x8*)(V_lds + (so) + vst0) = sr_.vs0; *(bf16x8*)(V_lds + (so) + vst1) = sr_.vs1; const int kc = sc * 2;  \
    *(bf16x8*)(K_lds + (so) + KSWZ(sr, kc)) = sr_.ks0; *(bf16x8*)(K_lds + (so) + KSWZ(32 + sr, kc)) = sr_.ks1; } while (0)
#define SWAIT() asm volatile("s_waitcnt vmcnt(0)" ::: "memory")
#define RESC(a) do { if (__any((a) < 1.f)) { if (hi == 0) al_l[r32] = (a); asm volatile("s_waitcnt lgkmcnt(0)" ::: "memory"); \
    for (int d = 0; d < 4; ++d) for (int r = 0; r < 16; ++r) o[d][r] *= al_l[crow(r, hi)]; } } while (0)
#define ROT() do { const int t_ = sprev; sprev = scur; scur = snext; snext = t_; } while (0)
  f32x16 pA0, pA1, pB0, pB1; float mnA, mnB, alA, alB; bf16x8 pa0, pa1, pa2, pa3; const int NT = seq / KVBLK;
  int sprev = 0, scur = (int)SHM_V, snext = 2 * (int)SHM_V;
  SLOAD(0); SWAIT(); SWRITE(0); SLOAD(KVBLK); __syncthreads();
  qkt(pA0, pA1, K_lds, qr, r32, hi, mapB); partialSM(pA0, pA1, m_reg, mnA, alA);
  SWAIT(); SWRITE(scur); SLOAD(2 * KVBLK); __syncthreads();
#define STEP(PC0, PC1, PP0, PP1, alP, mnC, alC, t) do { \
    SBAR(); qkt(PC0, PC1, K_lds + scur, qr, r32, hi, mapB); \
    finishSM(PP0, PP1, alP, l_reg, pa0, pa1, pa2, pa3); SBAR(); \
    pv_d0(o, vb0 + sprev, pa0, pa1, pa2, pa3); partialSM(PC0, PC1, m_reg, mnC, alC); \
    if ((t) + 1 < NT) { SWAIT(); SWRITE(snext); if ((t) + 2 < NT) SLOAD(((t) + 2) * KVBLK); } \
    RESC(alC); __syncthreads(); ROT(); } while (0)
  for (int t = 1; t + 1 < NT; t += 2) {
    STEP(pB0, pB1, pA0, pA1, alA, mnB, alB, t);
    STEP(pA0, pA1, pB0, pB1, alB, mnA, alA, t + 1);
  }
  STEP(pB0, pB1, pA0, pA1, alA, mnB, alB, NT - 1);
  finishSM(pB0, pB1, alB, l_reg, pa0, pa1, pa2, pa3); SBAR();
  pv_d0(o, vb0 + sprev, pa0, pa1, pa2, pa3);
#undef STEP
#undef ROT
  int lane_e = threadIdx.x & 63; asm volatile("" : "+v"(lane_e));
  if (hi == 0) li_l[r32] = l_reg; asm volatile("s_waitcnt lgkmcnt(0)" ::: "memory");
  float rli[16];
#pragma unroll
  for (int r = 0; r < 16; ++r) rli[r] = __builtin_amdgcn_rcpf(li_l[crow(r, hi)]);
  __syncthreads();
  float* X = (float*)lds + (wq * 64 + lane_e) * 64;
  if (map == 1) {
#pragma unroll
    for (int d0 = 0; d0 < 4; ++d0)
#pragma unroll
      for (int r = 0; r < 16; ++r) X[d0 * 16 + r] = o[d0][r] * rli[r] * lam;
  }
  __syncthreads();
  if (map == 0) {
    float ssq[16];
#pragma unroll
    for (int r = 0; r < 16; ++r) ssq[r] = 0.f;
#pragma unroll
    for (int d0 = 0; d0 < 4; ++d0)
#pragma unroll
      for (int r = 0; r < 16; ++r) { o[d0][r] = o[d0][r] * rli[r] - X[d0 * 16 + r]; ssq[r] += o[d0][r] * o[d0][r]; }
#pragma unroll
    for (int r = 0; r < 16; ++r) {
#pragma unroll
      for (int off = 1; off < 32; off <<= 1) ssq[r] += __shfl_xor(ssq[r], off);
      ssq[r] = (1.f - LAMBDA_INIT) / sqrtf(ssq[r] * (1.f / 128.f) + EPS);
    }
    char* st = lds + 65536 + wq * 8704;
#pragma unroll
    for (int d0 = 0; d0 < 4; ++d0) { const float g = subg[d0 * 32 + (lane_e & 31)];
#pragma unroll
      for (int r = 0; r < 16; ++r) *(bf16*)(st + crow(r, lane_e >> 5) * 272 + (d0 * 32 + (lane_e & 31)) * 2) = (bf16)f2bf(o[d0][r] * ssq[r] * g); }
    asm volatile("s_waitcnt lgkmcnt(0)" ::: "memory");
    bf16* Mw = Mx + (long)(wq * 32 + (lane_e >> 4)) * D + (lane_e & 15) * 8;
#pragma unroll
    for (int it = 0; it < 8; ++it) { const u32x4 v = *(const u32x4*)(st + (it * 4 + (lane_e >> 4)) * 272 + (lane_e & 15) * 16); *(u32x4*)(Mw + (long)(it * 4) * D) = v; }
  }
  __syncthreads();
#undef SLOAD
#undef SWRITE
#undef SWAIT
#undef RESC
}
#undef KSWZ
#undef SBAR
}

__device__ __forceinline__ void fast_attn(Frame& F) {
    float lam;
    { const int l = F.lane; const float s1 = wave_sum(F.in[I_LQ1][l] * F.in[I_LK1][l]), s2 = wave_sum(F.in[I_LQ2][l] * F.in[I_LK2][l]); lam = __expf(s1) - __expf(s2) + LAMBDA_INIT; lam = __builtin_bit_cast(float, __builtin_amdgcn_readfirstlane(__builtin_bit_cast(int, lam))); }
    for (int u = F.vcu * 4; u < NB * NH * (T / 128); u += F.G * 4)
        for (int i = 0; i < 4; ++i) {
            const int uu = u + i, bh = uu >> 6, qb = uu & 63, b = bh >> 2, h = bh & 3;
            da::da_unit(F.Qd + ((size_t)bh * T + qb * 128) * 128, F.Kd + (size_t)bh * TK * 128, F.Vd + (size_t)bh * TK * 128,
                        F.MIX + ((size_t)b * T + qb * 128) * D + h * 128, F.in[I_SUBLN], lam, TK, (char*)(F.lds));
        }
}


namespace ml {
using da::bf16x8; using da::s16x4; using da::f32x16; using da::u32x4; using da::crow; using da::cvtpk; using da::v_st; using da::v_rd_base; using da::tr_read; using da::v_rd_off;
constexpr int NCH = TK / 64;
constexpr int CE = 129 * 64;
constexpr float LOG2E = 1.4426950408889634f;
#define KSWZ64(row, colB) ((row) * 128 + ((colB) ^ ((((row) >> 1) & 7) << 4)))
__device__ __forceinline__ float scan_add(float v, int lane) {
#pragma unroll
    for (int o = 1; o < 64; o <<= 1) { const float t = __shfl_up(v, o); if (lane >= o) v += t; }
    return v;
}
__device__ __forceinline__ float scan_max(float v, int lane) {
#pragma unroll
    for (int o = 1; o < 64; o <<= 1) { const float t = __shfl_up(v, o); if (lane >= o) v = fmaxf(v, t); }
    return v;
}
__device__ __forceinline__ int pos_of(int dir, int c) { return dir ? (c < 4 ? 3 - c : 135 - c) : c; }
__device__ __forceinline__ v4u scale8(v4u x, float w) { v4u o; o.x = pk2(bflo(x.x) * w, bfhi(x.x) * w); o.y = pk2(bflo(x.y) * w, bfhi(x.y) * w); o.z = pk2(bflo(x.z) * w, bfhi(x.z) * w); o.w = pk2(bflo(x.w) * w, bfhi(x.w) * w); return o; }
#define ML_PK(L, H) (bf16x8){L[0], L[1], L[2], L[3], H[0], H[1], H[2], H[3]}

__device__ __forceinline__ void phase_a(Frame& F, float* DC, float* SCL) {
    char* lds = (char*)F.lds; const int VI = 0, KW = 16384; float* WL = (float*)(lds + 32768);
    const int tid = F.tid, lane = F.lane, wid = F.wave, r32 = lane & 31, hi = lane >> 5;
    const int dir = wid >> 2, dt = (wid >> 1) & 1, vs = wid & 1;
    const int ldsb = (int)(uintptr_t)lds;
    for (int u = F.vcu; u < NB * NH * NCH; u += F.G) {
        const int bh = u / NCH, c = u % NCH, kidx0 = c * 64;
        if (wid < 2) {
            const int d = wid, s = d ? 63 - lane : lane;
            const float* g4 = F.gates + ((size_t)bh * TK + kidx0 + s) * 4 + d * 2;
            const float li = g4[0], lf = g4[1];
            const float b = scan_add(lf, lane), bl = __shfl(b, 63), g = bl - b + li, m = wave_max(g);
            WL[d * 64 + s] = __expf(g - m);
            if (lane == 0) { float* sp = SCL + ((size_t)(bh * 2 + d) * NCH + pos_of(d, c)) * 2; sp[0] = bl; sp[1] = m; }
        }
        const int krow = tid >> 3, kch = tid & 7, sr = tid >> 4, sc = (tid & 15) * 8;
        const v4u kv = *(const v4u*)(F.MK + ((size_t)bh * TK + kidx0 + krow) * 64 + kch * 8);
        const v4u v0 = *(const v4u*)(F.MV + ((size_t)bh * TK + kidx0 + sr) * 128 + sc), v1 = *(const v4u*)(F.MV + ((size_t)bh * TK + kidx0 + 32 + sr) * 128 + sc);
        __syncthreads();
        *(v4u*)(lds + KW + v_st(krow, kch * 8)) = scale8(kv, WL[krow]);
        *(v4u*)(lds + KW + v_st(krow, 64 + kch * 8)) = scale8(kv, WL[64 + krow]);
        *(v4u*)(lds + VI + v_st(sr, sc)) = v0; *(v4u*)(lds + VI + v_st(32 + sr, sc)) = v1;
        __syncthreads();
        bf16x8 kw[4];
        { const int vb = ldsb + KW + v_rd_base(lane) + (2 * dir + dt) * 512;
          const s16x4 l0 = tr_read<v_rd_off(0, 0, 0)>(vb), h0 = tr_read<v_rd_off(0, 0, 1)>(vb), l1 = tr_read<v_rd_off(0, 1, 0)>(vb), h1 = tr_read<v_rd_off(0, 1, 1)>(vb);
          const s16x4 l2 = tr_read<v_rd_off(0, 2, 0)>(vb), h2 = tr_read<v_rd_off(0, 2, 1)>(vb), l3 = tr_read<v_rd_off(0, 3, 0)>(vb), h3 = tr_read<v_rd_off(0, 3, 1)>(vb);
          asm volatile("s_waitcnt lgkmcnt(0)" ::: "memory"); __builtin_amdgcn_sched_barrier(0);
          kw[0] = ML_PK(l0, h0); kw[1] = ML_PK(l1, h1); kw[2] = ML_PK(l2, h2); kw[3] = ML_PK(l3, h3); }
        float* dcb = DC + ((size_t)(bh * 2 + dir) * NCH + pos_of(dir, c)) * CE + dt * 32 + r32;
#pragma unroll
        for (int t = 0; t < 2; ++t) {
            const int vt = 2 * vs + t; const int vb = ldsb + VI + v_rd_base(lane) + vt * 512;
            const s16x4 l0 = tr_read<v_rd_off(0, 0, 0)>(vb), h0 = tr_read<v_rd_off(0, 0, 1)>(vb), l1 = tr_read<v_rd_off(0, 1, 0)>(vb), h1 = tr_read<v_rd_off(0, 1, 1)>(vb);
            const s16x4 l2 = tr_read<v_rd_off(0, 2, 0)>(vb), h2 = tr_read<v_rd_off(0, 2, 1)>(vb), l3 = tr_read<v_rd_off(0, 3, 0)>(vb), h3 = tr_read<v_rd_off(0, 3, 1)>(vb);
            asm volatile("s_waitcnt lgkmcnt(0)" ::: "memory"); __builtin_amdgcn_sched_barrier(0);
            f32x16 acc = {};
            acc = __builtin_amdgcn_mfma_f32_32x32x16_bf16(ML_PK(l0, h0), kw[0], acc, 0, 0, 0);
            acc = __builtin_amdgcn_mfma_f32_32x32x16_bf16(ML_PK(l1, h1), kw[1], acc, 0, 0, 0);
            acc = __builtin_amdgcn_mfma_f32_32x32x16_bf16(ML_PK(l2, h2), kw[2], acc, 0, 0, 0);
            acc = __builtin_amdgcn_mfma_f32_32x32x16_bf16(ML_PK(l3, h3), kw[3], acc, 0, 0, 0);
#pragma unroll
            for (int r = 0; r < 16; ++r) dcb[(size_t)(vt * 32 + crow(r, hi)) * 64] = acc[r];
        }
        if (vs == 0) {
            const short one = (r32 == 0) ? (short)0x3F80 : (short)0; const bf16x8 ones = {one, one, one, one, one, one, one, one};
            f32x16 acc = {};
#pragma unroll
            for (int ks = 0; ks < 4; ++ks) acc = __builtin_amdgcn_mfma_f32_32x32x16_bf16(ones, kw[ks], acc, 0, 0, 0);
            if (hi == 0) dcb[(size_t)128 * 64] = acc[0];
        }
        __syncthreads();
    }
}

__device__ __forceinline__ void phase_b(Frame& F, const float* DC, const float* SCL, bf16* CIN, float* MINV) {
    const int NPAIR = CE / 2, TOTAL = NB * NH * 2 * NPAIR;
    for (int pr = F.vcu * 512 + F.tid; pr < TOTAL; pr += F.G * 512) {
        const int cd = pr / NPAIR, e = pr % NPAIR;
        const float* dcp = DC + (size_t)cd * NCH * CE + 2 * e; const float* scp = SCL + (size_t)cd * NCH * 2;
        bf16* cop = CIN + (size_t)cd * 128 * CE + 2 * e;
        float M = 0.f, c0 = 0.f, c1 = 0.f;
        for (int p0 = 0; p0 < NCH; p0 += 12) {
            f32x2 dc[12], sl[12];
#pragma unroll
            for (int i = 0; i < 12; ++i) { dc[i] = *(const f32x2*)(dcp + (size_t)(p0 + i) * CE); sl[i] = *(const f32x2*)(scp + (p0 + i) * 2); }
#pragma unroll
            for (int i = 0; i < 12; ++i) { const int pos = p0 + i;
                if (pos >= 4) { *(unsigned*)(cop + (size_t)(pos - 4) * CE) = pk2(c0, c1); if (e == 0) MINV[cd * 128 + pos - 4] = M; }
                const float Mn = fmaxf(sl[i].x + M, sl[i].y), a = __expf(sl[i].x + M - Mn), cc = __expf(sl[i].y - Mn);
                c0 = a * c0 + cc * dc[i].x; c1 = a * c1 + cc * dc[i].y; M = Mn; }
        }
    }
}

__device__ __forceinline__ void phase_c(Frame& F, const bf16* CIN, const float* MINV) {
    char* lds = (char*)F.lds; const int ldsb = (int)(uintptr_t)lds;
    constexpr int KI = 0, VIo = 16384, CI = 49152, NLo = 81920, AAo = 82432, MMo = 82944, WIo = 83456, CFo = 83968, SCWo = 84480, SSQo = 86528, XO = 0, STO = 32768;
    float* NL = (float*)(lds + NLo); float* AA = (float*)(lds + AAo); float* MM = (float*)(lds + MMo); float* WI = (float*)(lds + WIo); float* CF = (float*)(lds + CFo);
    float* SSQ = (float*)(lds + SSQo); float* X = (float*)(lds + XO);
    const int wid = F.wave;
    const int dir = wid >> 2, rb = (wid >> 1) & 1, vh = wid & 1;
    float* SCW = (float*)(lds + SCWo) + wid * 64;
    float* ST = (float*)(lds + STO) + (rb * 2 + vh) * 2048;
    for (int u = F.vcu * 8; u < NB * NH * 128; u += F.G * 8)
      for (int ui = 0; ui < 8; ++ui) {
        int lane = F.lane; asm volatile("" : "+v"(lane));
        const int tid = wid * 64 + lane, r32 = lane & 31, hi = lane >> 5;
        const int uu = u + ui, bh = uu >> 7, cl = uu & 127, b = bh >> 2, h = bh & 3, t0 = cl * 64, kidx0 = CT + t0;
        if (wid < 2) {
            const int d = wid, s = d ? 63 - lane : lane, cpos = d ? 127 - cl : cl;
            const float* g4 = F.gates + ((size_t)bh * TK + kidx0 + s) * 4 + d * 2;
            const float li = g4[0], lf = g4[1];
            const float bq = scan_add(lf, lane), aa = li - bq, pm = scan_max(aa, lane);
            const float M = MINV[(bh * 2 + d) * 128 + cpos], mm = fmaxf(M, pm);
            AA[d * 64 + lane] = aa * LOG2E; MM[d * 64 + lane] = mm * LOG2E; WI[d * 64 + lane] = __expf(M - mm); CF[d * 64 + lane] = __expf(-(bq + mm));
        }
        {
            const int krow = tid >> 3, kch = tid & 7, sr = tid >> 4, sc = (tid & 15) * 8;
            const v4u kv = *(const v4u*)(F.MK + ((size_t)bh * TK + kidx0 + krow) * 64 + kch * 8);
            const v4u v0 = *(const v4u*)(F.MV + ((size_t)bh * TK + kidx0 + sr) * 128 + sc), v1 = *(const v4u*)(F.MV + ((size_t)bh * TK + kidx0 + 32 + sr) * 128 + sc);
            const bf16* cf = CIN + ((size_t)(bh * 2 + 0) * 128 + cl) * CE; const bf16* cb = CIN + ((size_t)(bh * 2 + 1) * 128 + (127 - cl)) * CE;
            const v4u c0 = *(const v4u*)(cf + krow * 64 + kch * 8), c1 = *(const v4u*)(cf + (64 + krow) * 64 + kch * 8);
            const v4u c2 = *(const v4u*)(cb + krow * 64 + kch * 8), c3 = *(const v4u*)(cb + (64 + krow) * 64 + kch * 8);
            if (tid < 128) { const int d = tid >> 6, j = tid & 63; NL[d * 64 + j] = bf2f((d ? cb : cf)[128 * 64 + j]); }
            *(v4u*)(lds + KI + KSWZ64(krow, kch * 16)) = kv; *(v4u*)(lds + KI + 8192 + KSWZ64(63 - krow, kch * 16)) = kv;
            *(v4u*)(lds + VIo + v_st(sr, sc)) = v0; *(v4u*)(lds + VIo + v_st(32 + sr, sc)) = v1;
            *(v4u*)(lds + VIo + 16384 + v_st(63 - sr, sc)) = v0; *(v4u*)(lds + VIo + 16384 + v_st(31 - sr, sc)) = v1;
            *(v4u*)(lds + CI + KSWZ64(krow, kch * 16)) = c0; *(v4u*)(lds + CI + KSWZ64(64 + krow, kch * 16)) = c1;
            *(v4u*)(lds + CI + 16384 + KSWZ64(krow, kch * 16)) = c2; *(v4u*)(lds + CI + 16384 + KSWZ64(64 + krow, kch * 16)) = c3;
        }
        const int prow = rb * 32 + r32, srow = dir ? 63 - prow : prow;
        bf16x8 qr[4];
        { const bf16* qp = F.MQ + ((size_t)bh * TK + kidx0 + srow) * 64 + hi * 8;
#pragma unroll
          for (int d0 = 0; d0 < 4; ++d0) qr[d0] = *reinterpret_cast<const bf16x8*>(qp + d0 * 16); }
        __syncthreads();
        f32x16 p0 = {}, p1 = {};
        { const char* Ks = lds + KI + dir * 8192;
#pragma unroll
          for (int d0 = 0; d0 < 4; ++d0) { const int cbb = (d0 * 16 + hi * 8) * 2;
            const bf16x8 b0 = *reinterpret_cast<const bf16x8*>(Ks + KSWZ64(r32, cbb)), b1 = *reinterpret_cast<const bf16x8*>(Ks + KSWZ64(32 + r32, cbb));
            p0 = __builtin_amdgcn_mfma_f32_32x32x16_bf16(b0, qr[d0], p0, 0, 0, 0); p1 = __builtin_amdgcn_mfma_f32_32x32x16_bf16(b1, qr[d0], p1, 0, 0, 0); } }
        const float mmp = MM[dir * 64 + prow], wip = WI[dir * 64 + prow];
#pragma unroll
        for (int r = 0; r < 16; ++r) { const int k0 = crow(r, hi), k1 = 32 + k0;
            const float e0 = __builtin_amdgcn_exp2f(AA[dir * 64 + k0] - mmp), e1 = __builtin_amdgcn_exp2f(AA[dir * 64 + k1] - mmp);
            p0[r] *= (k0 <= prow) ? e0 : 0.f; p1[r] *= (k1 <= prow) ? e1 : 0.f; }
        float ps = 0.f;
#pragma unroll
        for (int r = 0; r < 16; ++r) ps += p0[r] + p1[r];
        float nq = 0.f;
#pragma unroll
        for (int d0 = 0; d0 < 4; ++d0)
#pragma unroll
            for (int j = 0; j < 8; ++j) nq += bf2f((unsigned short)qr[d0][j]) * NL[dir * 64 + d0 * 16 + hi * 8 + j];
        { auto rr = __builtin_amdgcn_permlane32_swap(__float_as_uint(ps), __float_as_uint(ps), false, false); ps = __uint_as_float(rr[0]) + __uint_as_float(rr[1]); }
        { auto rr = __builtin_amdgcn_permlane32_swap(__float_as_uint(nq), __float_as_uint(nq), false, false); nq = __uint_as_float(rr[0]) + __uint_as_float(rr[1]); }
        const float den = ps + wip * nq, rscale = 1.0f / fmaxf(fabsf(den), CF[dir * 64 + prow]);
        if (hi == 0) SCW[r32] = rscale;
        bf16x8 pa0, pa1, pa2, pa3;
#define PK4(P, BASE, OUT) do { unsigned a0 = cvtpk(P[BASE + 0], P[BASE + 1]), a1 = cvtpk(P[BASE + 2], P[BASE + 3]);   \
    unsigned b0 = cvtpk(P[BASE + 4], P[BASE + 5]), b1 = cvtpk(P[BASE + 6], P[BASE + 7]);                              \
    auto r0 = __builtin_amdgcn_permlane32_swap(a0, b0, false, false); auto r1 = __builtin_amdgcn_permlane32_swap(a1, b1, false, false); \
    u32x4 w = {r0[0], r1[0], r0[1], r1[1]}; OUT = *reinterpret_cast<bf16x8*>(&w); } while (0)
        PK4(p0, 0, pa0); PK4(p0, 8, pa1); PK4(p1, 0, pa2); PK4(p1, 8, pa3);
#undef PK4
        f32x16 o[2] = {};
        { const int vb = ldsb + VIo + dir * 16384 + v_rd_base(lane) + (2 * vh) * 512;
          da::pv_one<0>(o[0], vb, pa0, pa1, pa2, pa3); da::pv_one<1>(o[1], vb, pa0, pa1, pa2, pa3); }
        bf16x8 qs[4];
#pragma unroll
        for (int d0 = 0; d0 < 4; ++d0) { u32x4 w;
            w[0] = cvtpk(bf2f((unsigned short)qr[d0][0]) * wip, bf2f((unsigned short)qr[d0][1]) * wip); w[1] = cvtpk(bf2f((unsigned short)qr[d0][2]) * wip, bf2f((unsigned short)qr[d0][3]) * wip);
            w[2] = cvtpk(bf2f((unsigned short)qr[d0][4]) * wip, bf2f((unsigned short)qr[d0][5]) * wip); w[3] = cvtpk(bf2f((unsigned short)qr[d0][6]) * wip, bf2f((unsigned short)qr[d0][7]) * wip);
            qs[d0] = *reinterpret_cast<bf16x8*>(&w); }
        { const char* Cs = lds + CI + dir * 16384;
#pragma unroll
          for (int t = 0; t < 2; ++t)
#pragma unroll
            for (int ks = 0; ks < 4; ++ks) { const bf16x8 cfr = *reinterpret_cast<const bf16x8*>(Cs + KSWZ64((2 * vh + t) * 32 + r32, (ks * 16 + hi * 8) * 2));
                o[t] = __builtin_amdgcn_mfma_f32_32x32x16_bf16(qs[ks], cfr, o[t], 0, 0, 0); } }
        asm volatile("s_waitcnt lgkmcnt(0)" ::: "memory");
#pragma unroll
        for (int r = 0; r < 16; ++r) { const float sv = SCW[crow(r, hi)]; o[0][r] *= sv; o[1][r] *= sv; }
        __syncthreads();
        if (dir == 1) {
#pragma unroll
            for (int t = 0; t < 2; ++t)
#pragma unroll
                for (int r = 0; r < 16; ++r) X[(63 - (rb * 32 + crow(r, hi))) * 128 + (2 * vh + t) * 32 + r32] = o[t][r];
        }
        __syncthreads();
        float ssq[16];
        if (dir == 0) {
#pragma unroll
            for (int r = 0; r < 16; ++r) { float a = 0.f;
#pragma unroll
                for (int t = 0; t < 2; ++t) { o[t][r] += X[(rb * 32 + crow(r, hi)) * 128 + (2 * vh + t) * 32 + r32]; a += o[t][r] * o[t][r]; }
#pragma unroll
                for (int off = 1; off < 32; off <<= 1) a += __shfl_xor(a, off);
                ssq[r] = a; if (r32 == 0) SSQ[(rb * 2 + vh) * 32 + crow(r, hi)] = a; }
        }
        __syncthreads();
        if (dir == 0) {
            const float* gn = F.in[I_MLNG] + h * 128 + vh * 64;
#pragma unroll
            for (int r = 0; r < 16; ++r) { const float tot = ssq[r] + SSQ[(rb * 2 + (1 - vh)) * 32 + crow(r, hi)]; const float rs = 1.0f / sqrtf(tot * (1.f / 128.f) + EPS);
#pragma unroll
                for (int t = 0; t < 2; ++t) ST[crow(r, hi) * 64 + t * 32 + r32] = o[t][r] * rs * gn[t * 32 + r32]; }
            asm volatile("s_waitcnt lgkmcnt(0)" ::: "memory");
            const size_t row0 = (size_t)b * T + t0 + rb * 32;
#pragma unroll
            for (int it = 0; it < 4; ++it) { const int row = it * 8 + (lane >> 3), ch = lane & 7;
                const f32x4 y0 = *(const f32x4*)(ST + row * 64 + ch * 8), y1 = *(const f32x4*)(ST + row * 64 + ch * 8 + 4);
                const v4u mo = *(const v4u*)(F.MO + (row0 + row) * 512 + h * 128 + vh * 64 + ch * 8);
                v4u ov; ov.x = pk2(y0[0] * bflo(mo.x), y0[1] * bfhi(mo.x)); ov.y = pk2(y0[2] * bflo(mo.y), y0[3] * bfhi(mo.y)); ov.z = pk2(y1[0] * bflo(mo.z), y1[1] * bfhi(mo.z)); ov.w = pk2(y1[2] * bflo(mo.w), y1[3] * bfhi(mo.w));
                *(v4u*)(F.MIX + (row0 + row) * D + 512 + h * 128 + vh * 64 + ch * 8) = ov; }
        }
        __syncthreads();
      }
}
#undef KSWZ64
#undef ML_PK
}

__device__ __forceinline__ void p_final(Frame& F) {
    const int gw = F.vcu * NWAVES + F.wave, NGW = F.G * NWAVES, lane = F.lane;
    for (int row = gw; row < NTOK; row += NGW) {
        const float rstd = 1.0f / sqrtf(F.rowsq2[row] * (1.f / D) + EPS);
#pragma unroll
        for (int j = 0; j < 4; ++j) { const int col = 4 * lane + 256 * j; f32x4* p = (f32x4*)(F.out + (size_t)row * D + col);
            const f32x4 g = *(const f32x4*)(F.in[I_FING] + col); *p = (*p * rstd) * g; }
    }
}


#define XB_TMO      128
#define XB_XCNT(j)  (256  + 64 * (j))
#define XB_XSUB(j)  (1280 + 64 * (j))
#define XB_XGEN(j)  (2304 + 64 * (j))
#define XB_TOP      3328
#define XB_TOPGEN   3392
#define XCD_BAR_WORDS 3456
#define XB_SPIN_CAP (1u << 22)
constexpr int CW_BAR = 4096;
constexpr int MISC_OFF = 131072 + 320;
__device__ __forceinline__ unsigned xb_ld(unsigned* p)              { return __hip_atomic_load(p, __ATOMIC_RELAXED, __HIP_MEMORY_SCOPE_AGENT); }
__device__ __forceinline__ unsigned xb_add(unsigned* p, unsigned v) { return __hip_atomic_fetch_add(p, v, __ATOMIC_RELAXED, __HIP_MEMORY_SCOPE_AGENT); }
__device__ __forceinline__ unsigned xb_xcc_id() { return (unsigned)__builtin_amdgcn_s_getreg((3 << 11) | 20) & 0xFu; }
#define XB_SPIN(cond, bar) do { unsigned _sp = 0; while (cond) { __builtin_amdgcn_s_sleep(1); \
    if ((++_sp & 255u) == 0u) { if (xb_ld(&(bar)[XB_TMO])) break; if (_sp > XB_SPIN_CAP) { atomicAdd(&(bar)[XB_TMO], 1u); break; } } } } while (0)
struct XcdBarrier { unsigned* bar; unsigned x; volatile LAS unsigned* st; };
__device__ __forceinline__ XcdBarrier xcd_barrier_post(unsigned* bar, volatile LAS unsigned* st) {
    XcdBarrier b; b.bar = bar; b.x = xb_xcc_id(); b.st = st;
    if (threadIdx.x == 0) (void)xb_add(&bar[XB_XCNT(b.x)], 1u);
    return b;
}
__device__ __forceinline__ void xcd_barrier_complete(unsigned* bar, unsigned x, unsigned& nloc, unsigned& nx) {
    const unsigned G = gridDim.x * gridDim.y * gridDim.z;
    unsigned sum, cnt, mine, sp = 0u;
    for (;;) {
        sum = 0u; cnt = 0u; mine = 0u;
#pragma unroll
        for (unsigned j = 0; j < 16; ++j) { const unsigned c = xb_ld(&bar[XB_XCNT(j)]); sum += c; cnt += (c > 0u) ? 1u : 0u; mine = (j == x) ? c : mine; }
        if (sum == G) break;
        __builtin_amdgcn_s_sleep(1);
        if ((++sp & 255u) == 0u) { if (xb_ld(&bar[XB_TMO])) break; if (sp > XB_SPIN_CAP) { atomicAdd(&bar[XB_TMO], 1u); break; } }
    }
    nloc = mine > 0u ? mine : 1u; nx = cnt > 0u ? cnt : 1u;
}
__device__ __forceinline__ void xcd_barrier(const XcdBarrier& b) {
    asm volatile("s_waitcnt vmcnt(0)" ::: "memory");
    __syncthreads();
    if (threadIdx.x == 0) {
        unsigned* bar = b.bar;
        __builtin_amdgcn_s_waitcnt(0);
        unsigned nloc = b.st[0], nx = b.st[1];
        if (nloc == 0u) { xcd_barrier_complete(bar, b.x, nloc, nx); b.st[0] = nloc; b.st[1] = nx; }
        const unsigned old = xb_add(&bar[XB_XSUB(b.x)], 1u);
        const unsigned gen = old / nloc;
        if (old + 1u == (gen + 1u) * nloc) {
            __builtin_amdgcn_fence(__ATOMIC_RELEASE, "agent");
            asm volatile("s_waitcnt vmcnt(0)" ::: "memory");
            const unsigned og = xb_add(&bar[XB_TOP], 1u);
            const unsigned tg = og / nx;
            if (og + 1u == (tg + 1u) * nx) xb_add(&bar[XB_TOPGEN], 1u);
            else XB_SPIN(xb_ld(&bar[XB_TOPGEN]) == tg, bar);
            __builtin_amdgcn_fence(__ATOMIC_ACQUIRE, "agent");
            xb_add(&bar[XB_XGEN(b.x)], 1u);
            asm volatile("s_waitcnt vmcnt(0)" ::: "memory");
        } else {
            XB_SPIN(xb_ld(&bar[XB_XGEN(b.x)]) == gen, bar);
            __builtin_amdgcn_fence(__ATOMIC_ACQUIRE, "agent");
            asm volatile("s_waitcnt vmcnt(0)" ::: "memory");
        }
    }
    __syncthreads();
}

constexpr int NPHASE = 10;
__global__ void __launch_bounds__(NWAVES * 64, 2) fwd_kernel(Args args) {
    extern __shared__ __attribute__((aligned(16))) unsigned char lds_raw[];
    Frame F;
    F.lds = (LAS unsigned char*)lds_raw;
    F.tid = threadIdx.x; F.lane = F.tid & 63; F.wave = __builtin_amdgcn_readfirstlane(F.tid >> 6);
    F.G = gridDim.x; { const int bx = blockIdx.x; F.vcu = (F.G % 8 == 0) ? (bx % 8) * (F.G / 8) + bx / 8 : bx; }
#pragma unroll
    for (int i = 0; i < 20; ++i) F.in[i] = args.in[i];
    F.out = args.out; F.ws = args.ws; unsigned char* ws = args.ws;
    F.mod = (float*)(ws + WS_MOD); F.rope = (f32x2*)(ws + WS_ROPE); F.bias1 = (float*)(ws + WS_BIAS1); F.wgt = (float*)(ws + WS_WGT); F.gates = (float*)(ws + WS_G);
    F.rowsq1 = (float*)(ws + WS_ROWSQ1); F.rowsq2 = (float*)(ws + WS_ROWSQ2);
    F.WinT = (bf16*)(ws + WS_WIN); F.WoT = (bf16*)(ws + WS_WO); F.W1T = (bf16*)(ws + WS_W1); F.W2T = (bf16*)(ws + WS_W2);
    F.XM = (bf16*)(ws + WS_XM); F.A2 = (bf16*)(ws + WS_XM);
    F.Qd = (bf16*)(ws + WS_Q); F.Kd = (bf16*)(ws + WS_K); F.Vd = (bf16*)(ws + WS_V); F.MQ = (bf16*)(ws + WS_MQ); F.MK = (bf16*)(ws + WS_MK); F.MV = (bf16*)(ws + WS_MV); F.MO = (bf16*)(ws + WS_MO);
    F.HF = (float*)(ws + WS_DC); F.HB = (float*)(ws + WS_DC + 64 * MiB);
#if FAST_MLSTM
    F.MIX = (bf16*)(ws + WS_DC);
#else
    F.MIX = (bf16*)(ws + WS_CIN);
#endif
    F.Hh = (bf16*)(ws + WS_H);
    const int lo = args.ph_lo, hi = args.ph_hi;
    for (int u = F.tid; u < (LDS_BYTES - 131072) / 4; u += NWAVES * 64) ((LAS unsigned*)(F.lds + 131072))[u] = 0u;
    __syncthreads();
    XcdBarrier bar = xcd_barrier_post((unsigned*)(ws + WS_CTL) + CW_BAR + args.li * XCD_BAR_WORDS, (volatile LAS unsigned*)(F.lds + MISC_OFF));
#define IN(k) (refresh_ids(F), (lo <= (k) && (k) < hi))
#define SEAM(k) do { if (IN(k) && IN((k) + 1)) xcd_barrier(bar); } while (0)
    if (IN(0)) { p0_prologue(F); if (DOUBLE_MASK & 1) { __syncthreads(); p0_prologue(F); } }
    SEAM(0);
    if (IN(1)) { p1_rows(F); if (DOUBLE_MASK & 2) { __syncthreads(); p1_rows(F); } }
    SEAM(1);
#if FAST_GEMM & 1
    if (IN(2)) { pg8::Gemm g{F.XM, F.WinT, MROWS, INP, D}; pg8::StaticOrder S; S.init(MROWS, INP, F.G, (int)blockIdx.x);
        EpiInproj E{F.Qd, F.Kd, F.Vd, F.MQ, F.MK, F.MV, F.MO, F.rope}; pg8::gemm_phase<EpiInproj, pg8::StaticOrder, true, true>(F.lds, g, S, E);
        if (DOUBLE_MASK & 4) { __syncthreads(); pg8::gemm_phase<EpiInproj, pg8::StaticOrder, true, true>(F.lds, g, S, E); } }
#else
    if (IN(2)) naive_gemm(F, F.XM, D, MROWS, F.in[I_WIN], INC, INP, D, NaiveInprojEpi{});
#endif
    SEAM(2);
#if FAST_MLSTM
    if (IN(3)) { ml::phase_a(F, (float*)(ws + WS_DC), (float*)(ws + WS_SCL)); if (DOUBLE_MASK & 8) { __syncthreads(); ml::phase_a(F, (float*)(ws + WS_DC), (float*)(ws + WS_SCL)); } }
    SEAM(3);
    if (IN(4)) { ml::phase_b(F, (const float*)(ws + WS_DC), (const float*)(ws + WS_SCL), (bf16*)(ws + WS_CIN), (float*)(ws + WS_MIN)); if (DOUBLE_MASK & 16) ml::phase_b(F, (const float*)(ws + WS_DC), (const float*)(ws + WS_SCL), (bf16*)(ws + WS_CIN), (float*)(ws + WS_MIN)); }
    SEAM(4);
    if (IN(5)) { fast_attn(F); if (DOUBLE_MASK & 32) fast_attn(F); refresh_ids(F); ml::phase_c(F, (const bf16*)(ws + WS_CIN), (const float*)(ws + WS_MIN)); if (DOUBLE_MASK & 64) { refresh_ids(F); ml::phase_c(F, (const bf16*)(ws + WS_CIN), (const float*)(ws + WS_MIN)); } }
#else
    if (IN(3)) naive_mlstm(F);
    SEAM(3);
    SEAM(4);
    if (IN(5)) { fast_attn(F); refresh_ids(F); naive_mlstm_combine(F); }
#endif
    SEAM(5);
#if FAST_GEMM & 2
    if (IN(6)) { pg8::Gemm g{F.MIX, F.WoT, NTOK, D, D}; pg8::StaticOrder S; S.init(NTOK, D, F.G, (int)blockIdx.x);
        EpiOutproj E{F.in[I_X], F.out, F.A2, F.mod, F.in[I_N2G], F.rowsq1}; pg8::gemm_phase<EpiOutproj, pg8::StaticOrder, true, true>(F.lds, g, S, E); }
#else
    if (IN(6)) naive_gemm(F, F.MIX, D, NTOK, F.in[I_WOUT], D, D, D, NaiveOutprojEpi{});
#endif
    SEAM(6);
#if FAST_GEMM & 4
    if (IN(7)) { pg8::Gemm g{F.A2, F.W1T, NTOK, FF, D}; pg8::StaticOrder S; S.init(NTOK, FF, F.G, (int)blockIdx.x);
        EpiFc1 E{F.Hh, F.bias1, F.rowsq1}; pg8::gemm_phase<EpiFc1, pg8::StaticOrder, true, true>(F.lds, g, S, E);
        if (DOUBLE_MASK & 128) { __syncthreads(); pg8::gemm_phase<EpiFc1, pg8::StaticOrder, true, true>(F.lds, g, S, E); } }
#else
    if (IN(7)) naive_gemm(F, F.A2, D, NTOK, F.in[I_WFC1], FF, FF, D, NaiveFc1Epi{});
#endif
    SEAM(7);
#if FAST_GEMM & 8
    if (IN(8)) { pg8::Gemm g{F.Hh, F.W2T, NTOK, D, FF}; pg8::StaticOrder S; S.init(NTOK, D, F.G, (int)blockIdx.x);
        EpiFc2 E{F.out, F.mod, F.rowsq2}; pg8::gemm_phase<EpiFc2, pg8::StaticOrder, true, true>(F.lds, g, S, E); }
#else
    if (IN(8)) naive_gemm(F, F.Hh, FF, NTOK, F.in[I_WFC2], D, D, FF, NaiveFc2Epi{});
#endif
    SEAM(8);
    if (IN(9)) p_final(F);
#undef IN
#undef SEAM
}

extern "C" void kernel_launch(void* const* d_in, const int* in_sizes, int n_in, void* d_out, int out_size, void* d_ws, size_t ws_size, hipStream_t stream) {
    static int grid = 0;
    if (grid == 0) {
        if (n_in != 20 || in_sizes[0] != NTOK * D || out_size != NTOK * D || ws_size < WS_END) { fprintf(stderr, "kernel_launch: unexpected shapes n_in %d in0 %d out %d ws %zu\n", n_in, n_in > 0 ? in_sizes[0] : -1, out_size, ws_size); grid = -1; return; }
        int dev = 0, cus = 0, per_cu = 0;
        if (hipGetDevice(&dev) != hipSuccess || hipDeviceGetAttribute(&cus, hipDeviceAttributeMultiprocessorCount, dev) != hipSuccess) { grid = -1; return; }
        if (hipFuncSetAttribute((const void*)fwd_kernel, hipFuncAttributeMaxDynamicSharedMemorySize, LDS_BYTES) != hipSuccess) { fprintf(stderr, "kernel_launch: hipFuncSetAttribute failed\n"); grid = -1; return; }
        if (hipOccupancyMaxActiveBlocksPerMultiprocessor(&per_cu, (const void*)fwd_kernel, NWAVES * 64, LDS_BYTES) != hipSuccess || per_cu < 1) { fprintf(stderr, "kernel_launch: occupancy query says %d\n", per_cu); per_cu = 1; }
        (void)hipGetLastError();
        grid = cus;
    }
    if (grid < 0) return;
    (void)hipMemsetAsync((char*)d_ws + WS_CTL, 0, CTL_ZERO_BYTES, stream);
    Args a{};
    for (int i = 0; i < 20; ++i) a.in[i] = (const float*)d_in[i];
    a.out = (float*)d_out; a.ws = (unsigned char*)d_ws;
    a.ph_lo = 0; a.ph_hi = NPHASE; a.li = 0;
    hipLaunchKernelGGL(fwd_kernel, dim3(grid), dim3(NWAVES * 64), LDS_BYTES, stream, a);
}
```

```cpp
#include <hip/hip_runtime.h>
#include <cstdio>
#include <cstdint>

constexpr int NB = 4, T = 8192, CT = 256, TK = T + CT, D = 1024, FF = 4096, NH = 4;
constexpr int NTOK = NB * T, NCTX = NB * CT, MROWS = NTOK + NCTX;
constexpr int INC = 3088, INP = 3072;
constexpr float EPS = 1e-6f;
constexpr float LAMBDA_INIT = 0.2f;
constexpr float C2 = 0.125f * 1.4426950408889634f;

constexpr size_t MiB = 1u << 20;
constexpr size_t WS_CTL = 0, CTL_ZERO_BYTES = 1 * MiB;
constexpr size_t WS_ROWSQ1 = 256 * 1024, WS_ROWSQ2 = 384 * 1024;
constexpr size_t WS_KMAX = 128 * 1024;
constexpr size_t WS_MOD = 1 * MiB;
constexpr size_t WS_ROPE = WS_MOD + 128 * 1024;
constexpr size_t WS_BIAS1 = WS_ROPE + 32 * 1024;
constexpr size_t WS_WGT = WS_BIAS1 + 64 * 1024;
constexpr size_t WS_SCL = WS_WGT + 64 * 1024;
constexpr size_t WS_MIN = WS_SCL + 64 * 1024;
constexpr size_t WS_WIN = 2 * MiB, WS_WO = 9 * MiB, WS_W1 = 11 * MiB, WS_W2 = 19 * MiB;
constexpr size_t WS_G = 27 * MiB;
constexpr size_t WS_XM = 32 * MiB;
constexpr size_t WS_Q = 98 * MiB, WS_K = 130 * MiB, WS_V = 163 * MiB, WS_MQ = 196 * MiB, WS_MK = 213 * MiB, WS_MV = 230 * MiB, WS_MO = 263 * MiB;
constexpr size_t WS_DC = 296 * MiB;
constexpr size_t WS_CIN = 430 * MiB;
constexpr size_t WS_MIX = 296 * MiB + 0;
constexpr size_t WS_H = 98 * MiB;
constexpr size_t WS_END = 512 * MiB;

typedef unsigned short bf16;
typedef unsigned v4u __attribute__((ext_vector_type(4)));
typedef unsigned v2u __attribute__((ext_vector_type(2)));
typedef float f32x4 __attribute__((ext_vector_type(4)));
typedef float f32x2 __attribute__((ext_vector_type(2)));
#define LAS __attribute__((address_space(3)))

__device__ __forceinline__ unsigned f2bf(float f) { unsigned u = __builtin_bit_cast(unsigned, f); return (u + 0x7fffu + ((u >> 16) & 1u)) >> 16; }
__device__ __forceinline__ unsigned pk2(float lo, float hi) { return f2bf(lo) | (f2bf(hi) << 16); }
__device__ __forceinline__ float bf2f(unsigned short b) { return __builtin_bit_cast(float, (unsigned)b << 16); }
__device__ __forceinline__ float bflo(unsigned w) { return __builtin_bit_cast(float, w << 16); }
__device__ __forceinline__ float bfhi(unsigned w) { return __builtin_bit_cast(float, w & 0xffff0000u); }
__device__ __forceinline__ float wave_sum(float v) {
#pragma unroll
    for (int o = 1; o < 64; o <<= 1) v += __shfl_xor(v, o);
    return v;
}
__device__ __forceinline__ float wave_max(float v) {
#pragma unroll
    for (int o = 1; o < 64; o <<= 1) v = fmaxf(v, __shfl_xor(v, o));
    return v;
}

#ifndef DOUBLE_MASK
#define DOUBLE_MASK 0
#endif
#ifndef FAST_MLSTM
#define FAST_MLSTM 1
#endif
#ifndef FAST_ATTN
#define FAST_ATTN 1
#endif
#ifndef FAST_GEMM
#define FAST_GEMM 15
#endif
__device__ __forceinline__ int lane_id() { return (int)__builtin_amdgcn_mbcnt_hi(~0u, __builtin_amdgcn_mbcnt_lo(~0u, 0u)); }
constexpr int NWAVES = 8;
constexpr int LDS_BYTES = 147456;

struct Args {
    const float* in[20]; float* out; unsigned char* ws; int ph_lo, ph_hi, li, pad;
};
enum { I_X = 0, I_C, I_CTX, I_CCTX, I_WADA, I_BADA, I_N1G, I_N2G, I_WIN, I_BGATE, I_LQ1, I_LK1, I_LQ2, I_LK2, I_SUBLN, I_MLNG, I_WOUT, I_WFC1, I_WFC2, I_FING };

struct Frame {
    LAS unsigned char* lds;
    int tid, lane, wave, vcu, G;
    const float* in[20]; float* out; unsigned char* ws;
    float* mod; f32x2* rope; float* bias1; float* wgt; float* gates; float* rowsq1; float* rowsq2;
    bf16 *WinT, *WoT, *W1T, *W2T, *XM, *Qd, *Kd, *Vd, *MQ, *MK, *MV, *MO, *MIX, *A2, *Hh;
    float *HF, *HB;
};

__device__ __forceinline__ void refresh_ids(Frame& F) { int l = (int)__builtin_amdgcn_mbcnt_hi(~0u, __builtin_amdgcn_mbcnt_lo(~0u, 0u)); asm volatile("" : "+v"(l)); F.lane = l; F.tid = F.wave * 64 + l; }

__device__ __forceinline__ void gemv_item(Frame& F, const LAS float* a, int R, const float* W, int ldw, int col0, const float* bias, float* out, int ldo, LAS float* red) {
    const int w = F.wave, lane = F.lane, c = lane & 31, kp = lane >> 5;
    float acc[5] = {0.f, 0.f, 0.f, 0.f, 0.f};
    const float* wp = W + (size_t)(128 * w + kp) * ldw + col0 + c;
#pragma unroll 8
    for (int kk = 0; kk < 64; ++kk) {
        const float wv = wp[(size_t)(2 * kk) * ldw];
        const int k = 128 * w + 2 * kk + kp;
#pragma unroll
        for (int r = 0; r < 5; ++r) if (r < R) acc[r] += a[r * 1024 + k] * wv;
    }
#pragma unroll
    for (int r = 0; r < 5; ++r) acc[r] += __shfl_xor(acc[r], 32);
    if (lane < 32) {
#pragma unroll
        for (int r = 0; r < 5; ++r) red[(w * 5 + r) * 32 + lane] = acc[r];
    }
    __syncthreads();
    if (F.tid < R * 32) {
        const int r = F.tid >> 5, cc = F.tid & 31; float s = 0.f;
#pragma unroll
        for (int ww = 0; ww < 8; ++ww) s += red[(ww * 5 + r) * 32 + cc];
        out[(size_t)r * ldo + col0 + cc] = s + (bias ? bias[col0 + cc] : 0.f);
    }
    __syncthreads();
}

__device__ __forceinline__ void p0_transpose_item(const float* W, int K, int ldw, int nblk, bf16* WT, LAS float* scr, int item, int lane) {
    const int kb = item / nblk, nb = item % nblk, k0 = 64 * kb, n0 = 32 * nb;
#pragma unroll 8
    for (int i = 0; i < 32; ++i) { const int kk = 2 * i + (lane >> 5); scr[kk * 33 + (lane & 31)] = W[(size_t)(k0 + kk) * ldw + n0 + (lane & 31)]; }
    asm volatile("s_waitcnt lgkmcnt(0)" ::: "memory");
    const int c = lane & 7;
#pragma unroll
    for (int j = 0; j < 4; ++j) { const int n = (lane >> 3) + 8 * j; const LAS float* s = scr + (8 * c) * 33 + n;
        v4u o; o.x = pk2(s[0 * 33], s[1 * 33]); o.y = pk2(s[2 * 33], s[3 * 33]); o.z = pk2(s[4 * 33], s[5 * 33]); o.w = pk2(s[6 * 33], s[7 * 33]);
        *(v4u*)(WT + (size_t)(n0 + n) * K + k0 + 8 * c) = o; }
    asm volatile("s_waitcnt lgkmcnt(0)" ::: "memory");
}

__device__ __forceinline__ void p0_prologue(Frame& F) {
    LAS float* sa = (LAS float*)F.lds;
    LAS float* red = sa + 5 * 1024;
    for (int i = F.tid; i < 5 * 1024; i += 512) { const int r = i >> 10, k = i & 1023; const float c = r < 4 ? F.in[I_C][r * 1024 + k] : F.in[I_CCTX][k]; sa[i] = c / (1.f + __expf(-c)); }
    __syncthreads();
    for (int item = F.vcu; item < 192; item += F.G) gemv_item(F, sa, 5, F.in[I_WADA], 6 * D, item * 32, F.in[I_BADA], F.mod, 6 * D, red);
    LAS float* scr = (LAS float*)(F.lds + 32768 + F.wave * 8448);
    const int gw = F.vcu * NWAVES + F.wave, NGW = F.G * NWAVES;
    constexpr int I_IN = (D / 64) * (INP / 32), I_O = (D / 64) * (D / 32), I_1 = (D / 64) * (FF / 32), I_2 = (FF / 64) * (D / 32);
    for (int it = gw; it < I_IN + I_O + I_1 + I_2; it += NGW) {
        int r = it;
        if (r < I_IN) { p0_transpose_item(F.in[I_WIN], D, INC, INP / 32, F.WinT, scr, r, F.lane); continue; } r -= I_IN;
        if (r < I_O) { p0_transpose_item(F.in[I_WOUT], D, D, D / 32, F.WoT, scr, r, F.lane); continue; } r -= I_O;
        if (r < I_1) { p0_transpose_item(F.in[I_WFC1], D, FF, FF / 32, F.W1T, scr, r, F.lane); continue; } r -= I_1;
        p0_transpose_item(F.in[I_WFC2], FF, D, D / 32, F.W2T, scr, r, F.lane);
    }
    const int gt = F.vcu * 512 + F.tid, NGT = F.G * 512;
    for (int idx = gt; idx < 192 * 16; idx += NGT) {
        const int p = idx >> 4, j = idx & 15; const int pos = p < 128 ? p : p - 128;
        double inv = 1.0; for (int q = 0; q < j; ++q) inv *= 0.5623413251903491;
        const float ang = (float)pos * (float)inv;
        double a = (double)ang; const double TWO_PI = 6.283185307179586476925;
        const double n = __builtin_rint(a / TWO_PI); a -= n * TWO_PI;
        const double a2 = a * a; double sn = 0.0, cs = 0.0, ts = a, tc = 1.0;
        for (int q = 0; q < 14; ++q) { sn += ts; cs += tc; tc = -tc * a2 / (double)((2 * q + 1) * (2 * q + 2)); ts = -ts * a2 / (double)((2 * q + 2) * (2 * q + 3)); }
        F.rope[idx] = (f32x2){(float)cs, (float)sn};
    }
    for (int idx = gt; idx < 16 * 1024; idx += NGT) { const int g = idx >> 10, k = idx & 1023; F.wgt[idx] = F.in[I_WIN][(size_t)k * INC + INP + g]; }
}

__device__ __forceinline__ float log_sigmoid(float x) { return fminf(x, 0.f) - log1pf(__expf(-fabsf(x))); }
__device__ __forceinline__ void p1_rows(Frame& F) {
    LAS float* wg = (LAS float*)F.lds;
    LAS float* sa = (LAS float*)(F.lds + 65536);
    LAS float* red = (LAS float*)(F.lds + 65536 + 16384);
    for (int i = F.tid; i < 16 * 1024; i += 512) wg[i] = F.wgt[i];
    for (int i = F.tid; i < 4 * 1024; i += 512) sa[i] = F.mod[(i >> 10) * 6 * D + 3 * D + (i & 1023)];
    __syncthreads();
    for (int item = F.vcu; item < 128; item += F.G) gemv_item(F, sa, 4, F.in[I_WFC1], FF, item * 32, nullptr, F.bias1, FF, red);
    const int gw = F.vcu * NWAVES + F.wave, NGW = F.G * NWAVES, lane = F.lane;
    const float* g1n = F.in[I_N1G];
    f32x4 vn[4];
    if (gw < MROWS) { const float* src = gw < NTOK ? F.in[I_X] + (size_t)gw * D : F.in[I_CTX] + (size_t)(gw - NTOK) * D;
#pragma unroll
        for (int j = 0; j < 4; ++j) vn[j] = *(const f32x4*)(src + 4 * lane + 256 * j); }
    for (int row = gw; row < MROWS; row += NGW) {
        const bool lat = row < NTOK; const int b5 = lat ? (row >> 13) : 4;
        const float* modr = F.mod + (size_t)b5 * 6 * D;
        f32x4 v[4]; float ss = 0.f;
#pragma unroll
        for (int j = 0; j < 4; ++j) { v[j] = vn[j]; ss += (v[j].x * v[j].x + v[j].y * v[j].y) + (v[j].z * v[j].z + v[j].w * v[j].w); }
        { const int nrow = row + NGW;
          if (nrow < MROWS) { const float* src = nrow < NTOK ? F.in[I_X] + (size_t)nrow * D : F.in[I_CTX] + (size_t)(nrow - NTOK) * D;
#pragma unroll
            for (int j = 0; j < 4; ++j) vn[j] = *(const f32x4*)(src + 4 * lane + 256 * j); } }
        const float rstd = 1.0f / sqrtf(wave_sum(ss) * (1.f / D) + EPS);
        float acc[16]; f32x4 xm[4];
#pragma unroll
        for (int j = 0; j < 4; ++j) {
            const int col = 4 * lane + 256 * j;
            const f32x4 gg = *(const f32x4*)(g1n + col), sc = *(const f32x4*)(modr + D + col), sh = *(const f32x4*)(modr + col);
            xm[j] = (v[j] * rstd) * gg * (sc + 1.0f) + sh;
            v2u o; o.x = pk2(xm[j].x, xm[j].y); o.y = pk2(xm[j].z, xm[j].w);
            *(v2u*)(F.XM + (size_t)row * D + col) = o;
        }
#pragma unroll
        for (int g = 0; g < 16; ++g) {
            float a = 0.f;
#pragma unroll
            for (int j = 0; j < 4; ++j) { const f32x4 w = *(const LAS f32x4*)(wg + g * 1024 + 4 * lane + 256 * j); a += (xm[j].x * w.x + xm[j].y * w.y) + (xm[j].z * w.z + xm[j].w * w.w); }
            acc[g] = a;
            asm volatile("" ::: "memory");
        }
#pragma unroll
        for (int i = 0; i < 8; ++i) { const bool hi = lane & 32; const float mine = hi ? acc[i + 8] : acc[i], send = hi ? acc[i] : acc[i + 8]; acc[i] = mine + __shfl_xor(send, 32); }
#pragma unroll
        for (int i = 0; i < 4; ++i) { const bool hi = lane & 16; const float mine = hi ? acc[i + 4] : acc[i], send = hi ? acc[i] : acc[i + 4]; acc[i] = mine + __shfl_xor(send, 16); }
#pragma unroll
        for (int i = 0; i < 2; ++i) { const bool hi = lane & 8; const float mine = hi ? acc[i + 2] : acc[i], send = hi ? acc[i] : acc[i + 2]; acc[i] = mine + __shfl_xor(send, 8); }
        { const bool hi = lane & 4; const float mine = hi ? acc[1] : acc[0], send = hi ? acc[0] : acc[1]; acc[0] = mine + __shfl_xor(send, 4); }
        acc[0] += __shfl_xor(acc[0], 2); acc[0] += __shfl_xor(acc[0], 1);
        if ((lane & 3) == 0) {
            const int g = ((lane >> 5) & 1) * 8 + ((lane >> 4) & 1) * 4 + ((lane >> 3) & 1) * 2 + ((lane >> 2) & 1);
            const float val = acc[0] + F.in[I_BGATE][g]; const int type = g >> 2, h = g & 3;
            const float o = (type & 1) ? log_sigmoid(val) : val;
            const int b = lat ? (row >> 13) : ((row - NTOK) >> 8), kidx = lat ? (CT + (row & (T - 1))) : ((row - NTOK) & (CT - 1));
            F.gates[((size_t)(b * NH + h) * TK + kidx) * 4 + type] = o;
        }
    }
}

template <class Epi>
__device__ __forceinline__ void naive_gemm(Frame& F, const bf16* A, int lda, int M, const float* W, int ldw, int N, int K, const Epi& E) {
    LAS float* As = (LAS float*)F.lds;
    LAS float* Ws = As + 16 * 132;
    LAS float* Ct = (LAS float*)(F.lds + 32768);
    const int tid = F.tid, ty = tid >> 4, tx = tid & 15;
    const int tn_n = N / 128, ntiles = (M / 128) * tn_n;
    for (int tile = F.vcu; tile < ntiles; tile += F.G) {
        const int tm = tile / tn_n, tn = tile % tn_n;
        float acc[4][8];
#pragma unroll
        for (int i = 0; i < 4; ++i)
#pragma unroll
            for (int j = 0; j < 8; ++j) acc[i][j] = 0.f;
        const int ar = tid >> 2, ak = (tid & 3) * 4, wk = tid >> 5, wn = (tid & 31) * 4;
        const bf16* ap = A + (size_t)(tm * 128 + ar) * lda + ak;
        const float* wp = W + (size_t)wk * ldw + tn * 128 + wn;
        for (int k0 = 0; k0 < K; k0 += 16) {
            const v2u av = *(const v2u*)(ap + k0);
            const f32x4 wv = *(const f32x4*)(wp + (size_t)k0 * ldw);
            As[(ak + 0) * 132 + ar] = bflo(av.x); As[(ak + 1) * 132 + ar] = bfhi(av.x); As[(ak + 2) * 132 + ar] = bflo(av.y); As[(ak + 3) * 132 + ar] = bfhi(av.y);
            *(LAS f32x4*)(Ws + wk * 128 + wn) = wv;
            __syncthreads();
#pragma unroll
            for (int kk = 0; kk < 16; ++kk) {
                const f32x4 a = *(const LAS f32x4*)(As + kk * 132 + ty * 4);
                const f32x4 w0 = *(const LAS f32x4*)(Ws + kk * 128 + tx * 8), w1 = *(const LAS f32x4*)(Ws + kk * 128 + tx * 8 + 4);
                const float aa[4] = {a.x, a.y, a.z, a.w}; const float ww[8] = {w0.x, w0.y, w0.z, w0.w, w1.x, w1.y, w1.z, w1.w};
#pragma unroll
                for (int i = 0; i < 4; ++i)
#pragma unroll
                    for (int j = 0; j < 8; ++j) acc[i][j] += aa[i] * ww[j];
            }
            __syncthreads();
        }
#pragma unroll
        for (int i = 0; i < 4; ++i)
#pragma unroll
            for (int j = 0; j < 8; ++j) Ct[(ty * 4 + i) * 129 + tx * 8 + j] = acc[i][j];
        __syncthreads();
        E.tile(F, Ct, tm * 128, tn * 128);
        __syncthreads();
    }
}

__device__ __forceinline__ void row_decode(int row, bool& lat, int& b, int& t, int& kidx) {
    lat = row < NTOK;
    if (lat) { b = row >> 13; t = row & (T - 1); kidx = CT + t; } else { const int j = row - NTOK; b = j >> 8; t = -1; kidx = j & (CT - 1); }
}

struct NaiveInprojEpi {
    __device__ __forceinline__ void tile(Frame& F, const LAS float* Ct, int row0, int col0) const {
        for (int idx = F.tid; idx < 128 * 128; idx += 512) {
            const int r = idx >> 7, c = idx & 127, row = row0 + r, col = col0 + c;
            bool lat; int b, t, kidx; row_decode(row, lat, b, t, kidx);
            float val = Ct[r * 129 + c];
            if (col < 1024) {
                const bool isq = col < 512; const int cc = col & 511, h = cc >> 7, within = cc & 127, i = within & 63;
                if (isq && !lat) continue;
                if (lat) {
                    const bool lowhalf = (i & 31) < 16; const float partner = Ct[r * 129 + (lowhalf ? c + 16 : c - 16)];
                    const int pos = (i < 32) ? (t >> 6) : (128 + (t & 63)); const f32x2 cs = F.rope[pos * 16 + (i & 15)];
                    val = val * cs.x + (lowhalf ? -partner : partner) * cs.y;
                }
                if (isq) F.Qd[((size_t)(b * NH + h) * T + t) * 128 + within] = (bf16)f2bf(val * C2);
                else F.Kd[((size_t)(b * NH + h) * TK + kidx) * 128 + within] = (bf16)f2bf(val);
            } else if (col < 1536) { const int cc = col - 1024, h = cc >> 7, within = cc & 127; F.Vd[((size_t)(b * NH + h) * TK + kidx) * 128 + within] = (bf16)f2bf(val);
            } else if (col < 1792) { const int cc = col - 1536, h = cc >> 6, i = cc & 63; F.MQ[((size_t)(b * NH + h) * TK + kidx) * 64 + i] = (bf16)f2bf(val);
            } else if (col < 2048) { const int cc = col - 1792, h = cc >> 6, i = cc & 63; F.MK[((size_t)(b * NH + h) * TK + kidx) * 64 + i] = (bf16)f2bf(val * 0.125f);
            } else if (col < 2560) { const int cc = col - 2048, h = cc >> 7, within = cc & 127; F.MV[((size_t)(b * NH + h) * TK + kidx) * 128 + within] = (bf16)f2bf(val);
            } else { if (!lat) continue; F.MO[(size_t)row * 512 + (col - 2560)] = (bf16)f2bf(1.f / (1.f + __expf(-val))); }
        }
    }
};
struct NaiveOutprojEpi {
    __device__ __forceinline__ void tile(Frame& F, const LAS float* Ct, int row0, int col0) const {
        for (int rr = 0; rr < 16; ++rr) {
            const int r = F.wave * 16 + rr, row = row0 + r, b = row >> 13; const float* modr = F.mod + (size_t)b * 6 * D;
            float ss = 0.f;
#pragma unroll
            for (int e = 0; e < 2; ++e) { const int c = F.lane + 64 * e, col = col0 + c;
                const float x1 = F.in[I_X][(size_t)row * D + col] + modr[2 * D + col] * Ct[r * 129 + c];
                F.out[(size_t)row * D + col] = x1; ss += x1 * x1;
                F.A2[(size_t)row * D + col] = (bf16)f2bf(x1 * F.in[I_N2G][col] * (1.f + modr[4 * D + col])); }
            ss = wave_sum(ss); if (F.lane == 0) atomicAdd(F.rowsq1 + row, ss);
        }
    }
};
struct NaiveFc1Epi {
    __device__ __forceinline__ void tile(Frame& F, const LAS float* Ct, int row0, int col0) const {
        for (int idx = F.tid; idx < 128 * 128; idx += 512) {
            const int r = idx >> 7, c = idx & 127, row = row0 + r, col = col0 + c, b = row >> 13;
            const float rstd = 1.0f / sqrtf(F.rowsq1[row] * (1.f / D) + EPS);
            float v = rstd * Ct[r * 129 + c] + F.bias1[b * FF + col]; v = fmaxf(v, 0.f);
            F.Hh[(size_t)row * FF + col] = (bf16)f2bf(v * v);
        }
    }
};
struct NaiveFc2Epi {
    __device__ __forceinline__ void tile(Frame& F, const LAS float* Ct, int row0, int col0) const {
        for (int rr = 0; rr < 16; ++rr) {
            const int r = F.wave * 16 + rr, row = row0 + r, b = row >> 13; const float* modr = F.mod + (size_t)b * 6 * D;
            float ss = 0.f;
#pragma unroll
            for (int e = 0; e < 2; ++e) { const int c = F.lane + 64 * e, col = col0 + c;
                const float x2 = F.out[(size_t)row * D + col] + modr[5 * D + col] * Ct[r * 129 + c];
                F.out[(size_t)row * D + col] = x2; ss += x2 * x2; }
            ss = wave_sum(ss); if (F.lane == 0) atomicAdd(F.rowsq2 + row, ss);
        }
    }
};


namespace pg8 {
#define PG8_LAS __attribute__((address_space(3)))
typedef unsigned short bf16_t;
typedef short bf16x8 __attribute__((ext_vector_type(8)));
typedef float f32x4 __attribute__((ext_vector_type(4)));
typedef unsigned u32x4 __attribute__((ext_vector_type(4)));
constexpr int BM = 256, BK = 64, HALF = 128, HTB = HALF * BK * 2  , STAGE_BYTES = 8 * HTB, NXCD = 8, WGM = 8;

__host__ __device__ __forceinline__ int lds_byte(int r, int c) { const int st = (r >> 4) * 2 + (c >> 5), rr = r & 15, cc = c & 31, ob = rr * 64 + cc * 2; return st * 1024 + (ob ^ (((ob >> 9) & 1) << 5)); }
__host__ __device__ __forceinline__ void stage_rc(int b, int& R, int& C) { const int st = b / 1024, sb = b % 1024, swz = sb ^ (((sb >> 9) & 1) << 5); R = (st >> 1) * 16 + swz / 64; C = (st & 1) * 32 + (swz % 64) / 2; }
__host__ __device__ __forceinline__ int perm32(int rho) { const int n = rho >> 4, i = rho & 15; return 8 * (i >> 2) + 4 * n + (i & 3); }

struct Unit { int pm, pn; };
struct Gemm { const bf16_t* A; const bf16_t* Bt; int M, N, K; };

struct StaticOrder {
    int nM, nN, nwg, G, c;
    __host__ __device__ void init(int M, int N, int G_, int c_) { nM = M / BM; nN = N / BM; nwg = nM * nN; G = G_; c = c_; }
    __host__ __device__ bool next(int i, Unit& u) const {
        const long L = (long)i * G + c; if (L >= nwg) return false;
        int wgid = (int)L; { const int q = nwg / NXCD, r = nwg % NXCD, xcd = wgid % NXCD, off = wgid / NXCD; wgid = (xcd < r ? xcd * (q + 1) : r * (q + 1) + (xcd - r) * q) + off; }
        const int nig = WGM * nN, gid = wgid / nig, fm = gid * WGM, gsz = (nM - fm) < WGM ? (nM - fm) : WGM;
        u.pm = fm + ((wgid % nig) % gsz); u.pn = (wgid % nig) / gsz; return true;
    }
    __device__ __forceinline__ void a_ready(const Unit&) const {}
    __device__ __forceinline__ void done(const Unit&) const {}
};

__device__ __forceinline__ unsigned cvt_pk_bf16(float lo, float hi) { unsigned r; asm volatile("v_cvt_pk_bf16_f32 %0, %1, %2" : "=v"(r) : "v"(lo), "v"(hi)); return r; }
template <class Epi, class Sched, bool ALIGN_EPI = false, bool SP2 = false>
__device__ __forceinline__ void gemm_phase(PG8_LAS unsigned char* lds, const Gemm g, const Sched& S, const Epi& E, const int tid) {
    const int wid = __builtin_amdgcn_readfirstlane(tid >> 6), lane = tid & 63, wr = wid >> 2, wc = wid & 3, fr = lane & 15, fq = lane >> 4;
    const int K = g.K, nt = K / BK;
    unsigned voffA[2], voffB[2];
#pragma unroll
    for (int i = 0; i < 2; ++i) { int R, C; stage_rc(tid * 16 + i * 8192, R, C); const int Rb = Epi::PERM ? ((R & ~31) + perm32(R & 31)) : R;
        voffA[i] = (unsigned)(R * K + C) * 2u; voffB[i] = (unsigned)(Rb * K + C) * 2u; }
    const size_t kstep = (size_t)(BK * 2);
    const size_t hstep = (size_t)HALF * K * 2;
    const size_t tstep = 2 * hstep;
    const unsigned ldsw = (unsigned)wid * 1024u;
    const int aoff = lds_byte(wr * 64 + fr, fq * 8), boff = lds_byte(wc * 32 + fr, fq * 8);
#define PG8_SA(b, h) (((b) * 2 + (h)) * HTB)
#define PG8_SB(b, h) ((4 + (b) * 2 + (h)) * HTB)
#define PG8_STAGE(bufoff, gbase, voff) do { _Pragma("unroll") for (int _i = 0; _i < 2; ++_i) \
        __builtin_amdgcn_global_load_lds((const unsigned*)((const char*)(gbase) + (voff)[_i]), (PG8_LAS unsigned*)(lds + (bufoff) + ldsw + _i * 8192), 16, 0, 0); } while (0)
#define PG8_LDA(dst, b, h) do { _Pragma("unroll") for (int m = 0; m < 4; ++m) _Pragma("unroll") for (int k = 0; k < 2; ++k) dst[m][k] = *(const PG8_LAS bf16x8*)(lds + PG8_SA(b, h) + aoff + m * 2048 + k * 1024); } while (0)
#define PG8_LDB(dst, b, h) do { _Pragma("unroll") for (int n = 0; n < 2; ++n) _Pragma("unroll") for (int k = 0; k < 2; ++k) dst[n][k] = *(const PG8_LAS bf16x8*)(lds + PG8_SB(b, h) + boff + n * 2048 + k * 1024); } while (0)
#define PG8_MMA(ai, bj, At, Bt) do { __builtin_amdgcn_s_setprio(1); _Pragma("unroll") for (int m = 0; m < 4; ++m) _Pragma("unroll") for (int n = 0; n < 2; ++n) _Pragma("unroll") for (int k = 0; k < 2; ++k) \
        acc[ai][bj][m][n] = __builtin_amdgcn_mfma_f32_16x16x32_bf16(Bt[n][k], At[m][k], acc[ai][bj][m][n], 0, 0, 0); __builtin_amdgcn_s_setprio(0); } while (0)
#define PG8_WAIT_V(n) asm volatile("s_waitcnt vmcnt(" #n ")" ::: "memory")
#define PG8_WAIT_L(n) asm volatile("s_waitcnt lgkmcnt(" #n ")" ::: "memory")
#define PG8_BAR __builtin_amdgcn_s_barrier()
#define PG8_SCHED __builtin_amdgcn_sched_barrier(0)
    Unit cur, nxt; int ui = 0;
    if (!S.next(0, cur)) return;
    f32x4 acc[2][2][4][2];
#pragma unroll
    for (int a = 0; a < 2; ++a)
#pragma unroll
        for (int b = 0; b < 2; ++b)
#pragma unroll
            for (int m = 0; m < 4; ++m)
#pragma unroll
                for (int n = 0; n < 2; ++n) acc[a][b][m][n] = (f32x4){0.f, 0.f, 0.f, 0.f};
    bf16x8 At[4][2], B0[2][2], B1[2][2];
    const char* cA = (const char*)g.A + (size_t)cur.pm * tstep; const char* cB = (const char*)g.Bt + (size_t)cur.pn * tstep;
    S.a_ready(cur);
    if constexpr (SP2) {
        PG8_STAGE(PG8_SB(0, 0), cB, voffB); PG8_STAGE(PG8_SB(0, 1), cB + hstep, voffB); PG8_STAGE(PG8_SA(0, 0), cA, voffA); PG8_STAGE(PG8_SA(0, 1), cA + hstep, voffA);
        if (wr == 1) PG8_BAR;
        PG8_WAIT_V(2); PG8_BAR;
        PG8_STAGE(PG8_SB(1, 0), cB + kstep, voffB); PG8_STAGE(PG8_SA(1, 0), cA + kstep, voffA); PG8_STAGE(PG8_SB(1, 1), cB + hstep + kstep, voffB);
        PG8_WAIT_V(6); PG8_BAR;
    } else {
        PG8_STAGE(PG8_SB(0, 0), cB, voffB); PG8_STAGE(PG8_SA(0, 0), cA, voffA); PG8_STAGE(PG8_SB(0, 1), cB + hstep, voffB); PG8_STAGE(PG8_SA(0, 1), cA + hstep, voffA);
        if (wr == 1) PG8_BAR;
        PG8_WAIT_V(4); PG8_BAR;
        PG8_STAGE(PG8_SB(1, 0), cB + kstep, voffB); PG8_STAGE(PG8_SA(1, 0), cA + kstep, voffA); PG8_STAGE(PG8_SB(1, 1), cB + hstep + kstep, voffB);
        PG8_WAIT_V(6); PG8_BAR;
    }
    for (;;) {
        const bool has_next = S.next(ui + 1, nxt);
        const char* nA = has_next ? (const char*)g.A + (size_t)nxt.pm * tstep : cA; const char* nB = has_next ? (const char*)g.Bt + (size_t)nxt.pn * tstep : cB;
        for (int t = 0; t < nt; t += 2) {
            const bool last = (t == nt - 2);
            const char* a1 = cA + (size_t)(t + 1) * kstep;
            const char* a2 = last ? nA : cA + (size_t)(t + 2) * kstep; const char* b2 = last ? nB : cB + (size_t)(t + 2) * kstep;
            const char* a3 = a2 + kstep; const char* b3 = b2 + kstep;
            if (last && has_next) S.a_ready(nxt);
            if constexpr (SP2) {
            PG8_LDB(B0, 0, 0); PG8_LDB(B1, 0, 1); PG8_SCHED; PG8_LDA(At, 0, 0); PG8_STAGE(PG8_SA(1, 1), a1 + hstep, voffA);
            PG8_WAIT_V(8); PG8_WAIT_L(0); PG8_BAR; PG8_MMA(0, 0, At, B0); PG8_MMA(0, 1, At, B1); PG8_BAR; PG8_SCHED;
            PG8_LDA(At, 0, 1); PG8_STAGE(PG8_SB(0, 0), b2, voffB); PG8_STAGE(PG8_SB(0, 1), b2 + hstep, voffB); PG8_STAGE(PG8_SA(0, 0), a2, voffA);
            PG8_WAIT_V(8); PG8_WAIT_L(0); PG8_BAR; PG8_MMA(1, 0, At, B0); PG8_MMA(1, 1, At, B1); PG8_BAR; PG8_SCHED;
            PG8_LDB(B0, 1, 0); PG8_LDB(B1, 1, 1); PG8_SCHED; PG8_LDA(At, 1, 0); PG8_STAGE(PG8_SA(0, 1), a2 + hstep, voffA);
            PG8_WAIT_V(8); PG8_WAIT_L(0); PG8_BAR; PG8_MMA(0, 0, At, B0); PG8_MMA(0, 1, At, B1); PG8_BAR; PG8_SCHED;
            PG8_LDA(At, 1, 1); PG8_STAGE(PG8_SB(1, 0), b3, voffB); PG8_STAGE(PG8_SB(1, 1), b3 + hstep, voffB); PG8_STAGE(PG8_SA(1, 0), a3, voffA);
            PG8_WAIT_V(8); PG8_WAIT_L(0); PG8_BAR; PG8_MMA(1, 0, At, B0); PG8_MMA(1, 1, At, B1); PG8_BAR; PG8_SCHED;
            } else {
            PG8_LDB(B0, 0, 0); PG8_SCHED; PG8_LDA(At, 0, 0); PG8_STAGE(PG8_SA(1, 1), a1 + hstep, voffA);
            PG8_WAIT_L(8); PG8_BAR; PG8_WAIT_L(0); PG8_MMA(0, 0, At, B0); PG8_BAR; PG8_SCHED;
            PG8_LDB(B1, 0, 1); PG8_STAGE(PG8_SB(0, 0), b2, voffB);
            PG8_BAR; PG8_WAIT_L(0); PG8_MMA(0, 1, At, B1); PG8_BAR;
            PG8_LDA(At, 0, 1); PG8_STAGE(PG8_SA(0, 0), a2, voffA);
            PG8_BAR; PG8_WAIT_L(0); PG8_MMA(1, 0, At, B0); PG8_BAR; PG8_SCHED;
            PG8_STAGE(PG8_SB(0, 1), b2 + hstep, voffB);
            PG8_WAIT_V(6); PG8_BAR; PG8_MMA(1, 1, At, B1); PG8_BAR;
            PG8_LDB(B0, 1, 0); PG8_SCHED; PG8_LDA(At, 1, 0); PG8_STAGE(PG8_SA(0, 1), a2 + hstep, voffA);
            PG8_WAIT_L(8); PG8_BAR; PG8_WAIT_L(0); PG8_MMA(0, 0, At, B0); PG8_BAR; PG8_SCHED;
            PG8_LDB(B1, 1, 1); PG8_STAGE(PG8_SB(1, 0), b3, voffB);
            PG8_BAR; PG8_WAIT_L(0); PG8_MMA(0, 1, At, B1); PG8_BAR;
            PG8_LDA(At, 1, 1); PG8_STAGE(PG8_SA(1, 0), a3, voffA);
            PG8_BAR; PG8_WAIT_L(0); PG8_MMA(1, 0, At, B0); PG8_BAR; PG8_SCHED;
            PG8_STAGE(PG8_SB(1, 1), b3 + hstep, voffB);
            PG8_WAIT_V(6); PG8_BAR; PG8_MMA(1, 1, At, B1); PG8_BAR;
            }
        }
        if constexpr (ALIGN_EPI) { if (wr == 0) PG8_BAR; }
        if constexpr (!Epi::AFTER_DRAIN) { E(acc, cur, wr, wc, fr, fq); S.done(cur); }
        if (!has_next) break;
#pragma unroll
        for (int a = 0; a < 2; ++a)
#pragma unroll
            for (int b = 0; b < 2; ++b)
#pragma unroll
                for (int m = 0; m < 4; ++m)
#pragma unroll
                    for (int n = 0; n < 2; ++n) acc[a][b][m][n] = (f32x4){0.f, 0.f, 0.f, 0.f};
        cur = nxt; cA = nA; cB = nB; ++ui;
        if constexpr (ALIGN_EPI) { if (wr == 1) PG8_BAR; }
    }
    PG8_WAIT_V(0);
    if constexpr (!ALIGN_EPI) { if (wr == 0) PG8_BAR; }
    PG8_BAR;
    if constexpr (Epi::AFTER_DRAIN) { E.fused(acc, cur, wr, wc, fr, fq, lds, wid, lane); S.done(cur); }
#undef PG8_SA
#undef PG8_SB
#undef PG8_STAGE
#undef PG8_LDA
#undef PG8_LDB
#undef PG8_MMA
#undef PG8_WAIT_V
#undef PG8_WAIT_L
#undef PG8_BAR
#undef PG8_SCHED
}
}

__device__ __forceinline__ v4u pack8(const f32x4& a, const f32x4& b) { v4u w; w.x = pg8::cvt_pk_bf16(a[0], a[1]); w.y = pg8::cvt_pk_bf16(a[2], a[3]); w.z = pg8::cvt_pk_bf16(b[0], b[1]); w.w = pg8::cvt_pk_bf16(b[2], b[3]); return w; }
struct EpiInproj {
    static constexpr bool PERM = true, AFTER_DRAIN = false;
    bf16 *Qd, *Kd, *Vd, *MQ, *MK, *MV, *MO; const f32x2* rope;
    __device__ __forceinline__ void operator()(const f32x4 (&acc)[2][2][4][2], const pg8::Unit& u, int wr, int wc, int fr, int fq) const {
        const int pn = u.pn; const bool lat = u.pm < 128;
        if (!lat && (pn < 2 || pn >= 10)) return;
        const int b = lat ? (u.pm >> 5) : (u.pm - 128);
        const int tbase = lat ? ((u.pm & 31) * 256) : 0;
        const int within0 = wc * 32 + fq * 8;
        if (pn < 4) {
            const bool isq = pn < 2; const int hb = (pn & 1) * 2; const bool rowaxis = (wc & 1) == 0, low = fq < 2; const int j0 = (fq & 1) * 8;
#pragma unroll
            for (int ai = 0; ai < 2; ++ai)
#pragma unroll
                for (int m = 0; m < 4; ++m) {
                    const int rloc = ai * 128 + wr * 64 + m * 16 + fr, t = tbase + rloc;
                    f32x4 cs[4];
                    if (lat) { const int pos = rowaxis ? (t >> 6) : (128 + (t & 63)); const f32x4* rp = (const f32x4*)(rope + pos * 16 + j0);
#pragma unroll
                        for (int q = 0; q < 4; ++q) cs[q] = rp[q]; }
#pragma unroll
                    for (int bj = 0; bj < 2; ++bj) {
                        f32x4 v0 = acc[ai][bj][m][0], v1 = acc[ai][bj][m][1];
                        if (lat) {
                            f32x4 p0, p1;
#pragma unroll
                            for (int e = 0; e < 4; ++e) { p0[e] = __shfl_xor(v0[e], 32); p1[e] = __shfl_xor(v1[e], 32); }
                            if (low) { p0 = -p0; p1 = -p1; }
                            v0[0] = v0[0] * cs[0][0] + p0[0] * cs[0][1]; v0[1] = v0[1] * cs[0][2] + p0[1] * cs[0][3];
                            v0[2] = v0[2] * cs[1][0] + p0[2] * cs[1][1]; v0[3] = v0[3] * cs[1][2] + p0[3] * cs[1][3];
                            v1[0] = v1[0] * cs[2][0] + p1[0] * cs[2][1]; v1[1] = v1[1] * cs[2][2] + p1[1] * cs[2][3];
                            v1[2] = v1[2] * cs[3][0] + p1[2] * cs[3][1]; v1[3] = v1[3] * cs[3][2] + p1[3] * cs[3][3];
                        }
                        if (isq) { v0 = v0 * C2; v1 = v1 * C2; *(v4u*)(Qd + ((size_t)(b * NH + hb + bj) * T + t) * 128 + within0) = pack8(v0, v1); }
                        else *(v4u*)(Kd + ((size_t)(b * NH + hb + bj) * TK + (lat ? CT + t : rloc)) * 128 + within0) = pack8(v0, v1);
                    }
                }
        } else if (pn == 6 || pn == 7) {
            bf16* dst = pn == 6 ? MQ : MK; const float sc = pn == 6 ? 1.f : 0.125f; const int i0 = 32 * (wc & 1) + 8 * fq;
#pragma unroll
            for (int ai = 0; ai < 2; ++ai)
#pragma unroll
                for (int m = 0; m < 4; ++m) { const int rloc = ai * 128 + wr * 64 + m * 16 + fr, kidx = lat ? CT + tbase + rloc : rloc;
#pragma unroll
                    for (int bj = 0; bj < 2; ++bj) { const int h = 2 * bj + (wc >> 1);
                        *(v4u*)(dst + ((size_t)(b * NH + h) * TK + kidx) * 64 + i0) = pack8(acc[ai][bj][m][0] * sc, acc[ai][bj][m][1] * sc); } }
        } else if (pn < 10) {
            bf16* dst = pn < 6 ? Vd : MV; const int hb = (pn & 1) * 2;
#pragma unroll
            for (int ai = 0; ai < 2; ++ai)
#pragma unroll
                for (int m = 0; m < 4; ++m) { const int rloc = ai * 128 + wr * 64 + m * 16 + fr, kidx = lat ? CT + tbase + rloc : rloc;
#pragma unroll
                    for (int bj = 0; bj < 2; ++bj)
                        *(v4u*)(dst + ((size_t)(b * NH + hb + bj) * TK + kidx) * 128 + within0) = pack8(acc[ai][bj][m][0], acc[ai][bj][m][1]); }
        } else {
#pragma unroll
            for (int ai = 0; ai < 2; ++ai)
#pragma unroll
                for (int m = 0; m < 4; ++m) { const int row = u.pm * 256 + ai * 128 + wr * 64 + m * 16 + fr;
#pragma unroll
                    for (int bj = 0; bj < 2; ++bj) { f32x4 v0 = acc[ai][bj][m][0], v1 = acc[ai][bj][m][1];
#pragma unroll
                        for (int e = 0; e < 4; ++e) { v0[e] = __builtin_amdgcn_rcpf(1.f + __expf(-v0[e])); v1[e] = __builtin_amdgcn_rcpf(1.f + __expf(-v1[e])); }
                        *(v4u*)(MO + (size_t)row * 512 + (pn - 10) * 256 + bj * 128 + within0) = pack8(v0, v1); } }
        }
    }
};
struct EpiOutproj {
    static constexpr bool PERM = true, AFTER_DRAIN = false;
    const float* x; float* out; bf16* A2; const float* mod; const float* n2g; float* rowsq;
    __device__ __forceinline__ void operator()(const f32x4 (&acc)[2][2][4][2], const pg8::Unit& u, int wr, int wc, int fr, int fq) const {
        const int b = u.pm >> 5; const float* modr = mod + (size_t)b * 6 * D; const int col0 = u.pn * 256 + wc * 32 + fq * 8;
        f32x4 g1v[2][2], gs2[2][2];
#pragma unroll
        for (int bj = 0; bj < 2; ++bj)
#pragma unroll
            for (int n = 0; n < 2; ++n) { const int c = col0 + bj * 128 + 4 * n; g1v[bj][n] = *(const f32x4*)(modr + 2 * D + c);
                gs2[bj][n] = *(const f32x4*)(n2g + c) * (*(const f32x4*)(modr + 4 * D + c) + 1.0f); }
#pragma unroll
        for (int ai = 0; ai < 2; ++ai)
#pragma unroll
            for (int m = 0; m < 4; ++m) { const int row = u.pm * 256 + ai * 128 + wr * 64 + m * 16 + fr; float ss = 0.f;
#pragma unroll
                for (int bj = 0; bj < 2; ++bj) { const size_t o = (size_t)row * D + col0 + bj * 128;
                    const f32x4 x0 = *(const f32x4*)(x + o) + g1v[bj][0] * acc[ai][bj][m][0], x1 = *(const f32x4*)(x + o + 4) + g1v[bj][1] * acc[ai][bj][m][1];
                    *(f32x4*)(out + o) = x0; *(f32x4*)(out + o + 4) = x1;
                    ss += (x0[0] * x0[0] + x0[1] * x0[1]) + (x0[2] * x0[2] + x0[3] * x0[3]) + (x1[0] * x1[0] + x1[1] * x1[1]) + (x1[2] * x1[2] + x1[3] * x1[3]);
                    *(v4u*)(A2 + o) = pack8(x0 * gs2[bj][0], x1 * gs2[bj][1]); }
                ss += __shfl_xor(ss, 16); ss += __shfl_xor(ss, 32);
                if (fq == 0) atomicAdd(rowsq + row, ss); }
    }
};
struct EpiFc1 {
    static constexpr bool PERM = true, AFTER_DRAIN = false;
    bf16* Hh; const float* bias1; const float* rowsq;
    __device__ __forceinline__ void operator()(const f32x4 (&acc)[2][2][4][2], const pg8::Unit& u, int wr, int wc, int fr, int fq) const {
        const int b = u.pm >> 5; const int col0 = u.pn * 256 + wc * 32 + fq * 8;
        f32x4 bv[2][2];
#pragma unroll
        for (int bj = 0; bj < 2; ++bj)
#pragma unroll
            for (int n = 0; n < 2; ++n) bv[bj][n] = *(const f32x4*)(bias1 + (size_t)b * FF + col0 + bj * 128 + 4 * n);
#pragma unroll
        for (int ai = 0; ai < 2; ++ai)
#pragma unroll
            for (int m = 0; m < 4; ++m) { const int row = u.pm * 256 + ai * 128 + wr * 64 + m * 16 + fr;
                const float rstd = 1.0f / sqrtf(rowsq[row] * (1.f / D) + EPS);
#pragma unroll
                for (int bj = 0; bj < 2; ++bj) { f32x4 v0 = acc[ai][bj][m][0] * rstd + bv[bj][0], v1 = acc[ai][bj][m][1] * rstd + bv[bj][1];
#pragma unroll
                    for (int e = 0; e < 4; ++e) { const float a0 = fmaxf(v0[e], 0.f), a1 = fmaxf(v1[e], 0.f); v0[e] = a0 * a0; v1[e] = a1 * a1; }
                    *(v4u*)(Hh + (size_t)row * FF + col0 + bj * 128) = pack8(v0, v1); } }
    }
};
struct EpiFc2 {
    static constexpr bool PERM = true, AFTER_DRAIN = false;
    float* out; const float* mod; float* rowsq;
    __device__ __forceinline__ void operator()(const f32x4 (&acc)[2][2][4][2], const pg8::Unit& u, int wr, int wc, int fr, int fq) const {
        const int b = u.pm >> 5; const float* modr = mod + (size_t)b * 6 * D; const int col0 = u.pn * 256 + wc * 32 + fq * 8;
        f32x4 g2v[2][2];
#pragma unroll
        for (int bj = 0; bj < 2; ++bj)
#pragma unroll
            for (int n = 0; n < 2; ++n) g2v[bj][n] = *(const f32x4*)(modr + 5 * D + col0 + bj * 128 + 4 * n);
#pragma unroll
        for (int ai = 0; ai < 2; ++ai)
#pragma unroll
            for (int m = 0; m < 4; ++m) { const int row = u.pm * 256 + ai * 128 + wr * 64 + m * 16 + fr; float ss = 0.f;
#pragma unroll
                for (int bj = 0; bj < 2; ++bj) { const size_t o = (size_t)row * D + col0 + bj * 128;
                    const f32x4 x0 = *(const f32x4*)(out + o) + g2v[bj][0] * acc[ai][bj][m][0], x1 = *(const f32x4*)(out + o + 4) + g2v[bj][1] * acc[ai][bj][m][1];
                    *(f32x4*)(out + o) = x0; *(f32x4*)(out + o + 4) = x1;
                    ss += (x0[0] * x0[0] + x0[1] * x0[1]) + (x0[2] * x0[2] + x0[3] * x0[3]) + (x1[0] * x1[0] + x1[1] * x1[1]) + (x1[2] * x1[2] + x1[3] * x1[3]); }
                ss += __shfl_xor(ss, 16); ss += __shfl_xor(ss, 32);
                if (fq == 0) atomicAdd(rowsq + row, ss); }
    }
};

__device__ __forceinline__ void naive_mlstm(Frame& F) {
    LAS float* ks = (LAS float*)F.lds;
    LAS float* qs = ks + 64 * 64;
    LAS float* vs = qs + 64 * 64;
    LAS float* fg = vs + 64 * 128;
    LAS float* ig = fg + 64;
    const int tid = F.tid, v = tid >> 2, dq = (tid & 3) * 16;
    for (int item = F.vcu; item < 32; item += F.G) {
        const int bh = item >> 1, dir = item & 1;
        float C[16], n[16];
#pragma unroll
        for (int e = 0; e < 16; ++e) { C[e] = 0.f; n[e] = 0.f; }
        float* Hout = (dir ? F.HB : F.HF) + (size_t)bh * T * 128;
        for (int blk = 0; blk < TK / 64; ++blk) {
            int c;
            if (!dir) c = blk; else c = (blk < 4) ? (3 - blk) : (TK / 64 - 1 - (blk - 4));
            const int kidx0 = c * 64; const bool lat = c >= 4;
            const size_t base64 = ((size_t)bh * TK + kidx0) * 64, base128 = ((size_t)bh * TK + kidx0) * 128;
            for (int i = tid; i < 64 * 64; i += 512) { ks[i] = bf2f(F.MK[base64 + i]); qs[i] = bf2f(F.MQ[base64 + i]); }
            for (int i = tid; i < 64 * 128; i += 512) vs[i] = bf2f(F.MV[base128 + i]);
            if (tid < 64) { const float* g = F.gates + ((size_t)bh * TK + kidx0 + tid) * 4 + dir * 2; ig[tid] = __expf(g[0]); fg[tid] = __expf(g[1]); }
            __syncthreads();
            for (int step = 0; step < 64; ++step) {
                const int s = dir ? 63 - step : step;
                const float f = fg[s], iw = ig[s], vv = vs[s * 128 + v] * iw;
                float num = 0.f, den = 0.f;
#pragma unroll
                for (int e = 0; e < 16; ++e) { const float kk = ks[s * 64 + dq + e], qq = qs[s * 64 + dq + e];
                    C[e] = f * C[e] + vv * kk; n[e] = f * n[e] + iw * kk; num += C[e] * qq; den += n[e] * qq; }
                if (lat) {
                    num += __shfl_xor(num, 1); num += __shfl_xor(num, 2); den += __shfl_xor(den, 1); den += __shfl_xor(den, 2);
                    if ((tid & 3) == 0) Hout[(size_t)(kidx0 - CT + s) * 128 + v] = num / fmaxf(fabsf(den), 1.f);
                }
            }
            __syncthreads();
        }
    }
}
__device__ __forceinline__ void naive_mlstm_combine(Frame& F) {
    const int gw = F.vcu * NWAVES + F.wave, NGW = F.G * NWAVES, lane = F.lane;
    for (int rid = gw; rid < NTOK * NH; rid += NGW) {
        const int row = rid >> 2, h = rid & 3, b = row >> 13, t = row & (T - 1);
        const size_t o = ((size_t)(b * NH + h) * T + t) * 128 + 2 * lane;
        const float a0 = F.HF[o] + F.HB[o], a1 = F.HF[o + 1] + F.HB[o + 1];
        const float r = 1.0f / sqrtf(wave_sum(a0 * a0 + a1 * a1) * (1.f / 128.f) + EPS);
        const float* g = F.in[I_MLNG] + h * 128 + 2 * lane;
        const unsigned mo = *(const unsigned*)(F.MO + (size_t)row * 512 + h * 128 + 2 * lane);
        *(unsigned*)(F.MIX + (size_t)row * D + 512 + h * 128 + 2 * lane) = pk2(a0 * r * g[0] * bflo(mo), a1 * r * g[1] * bfhi(mo));
    }
}

__device__ __forceinline__ void naive_attn(Frame& F) {
    LAS float* qs = (LAS float*)F.lds + F.wave * 64;
    const int gw = F.vcu * NWAVES + F.wave, NGW = F.G * NWAVES, lane = F.lane;
    float lam;
    { const float s1 = wave_sum(F.in[I_LQ1][lane] * F.in[I_LK1][lane]), s2 = wave_sum(F.in[I_LQ2][lane] * F.in[I_LK2][lane]); lam = __expf(s1) - __expf(s2) + LAMBDA_INIT; }
    for (int rid = gw; rid < NB * NH * T; rid += NGW) {
        const int bh = rid >> 13, t = rid & (T - 1), b = bh >> 2, h = bh & 3;
        float o0 = 0.f, o1 = 0.f;
        for (int map = 0; map < 2; ++map) {
            qs[lane] = bf2f(F.Qd[((size_t)bh * T + t) * 128 + map * 64 + lane]);
            asm volatile("s_waitcnt lgkmcnt(0)" ::: "memory");
            float m = -1e30f, l = 0.f, a0 = 0.f, a1 = 0.f;
            for (int ch = 0; ch < TK / 64; ++ch) {
                const bf16* kp = F.Kd + ((size_t)bh * TK + ch * 64 + lane) * 128 + map * 64;
                float s = 0.f;
#pragma unroll
                for (int d8 = 0; d8 < 8; ++d8) { const v4u kv = *(const v4u*)(kp + d8 * 8); const f32x4 qa = *(const LAS f32x4*)(qs + d8 * 8), qb = *(const LAS f32x4*)(qs + d8 * 8 + 4);
                    s += bflo(kv.x) * qa.x + bfhi(kv.x) * qa.y + bflo(kv.y) * qa.z + bfhi(kv.y) * qa.w + bflo(kv.z) * qb.x + bfhi(kv.z) * qb.y + bflo(kv.w) * qb.z + bfhi(kv.w) * qb.w; }
                const float mn = fmaxf(m, wave_max(s)), alpha = exp2f(m - mn), p = exp2f(s - mn);
                l = l * alpha + wave_sum(p); a0 *= alpha; a1 *= alpha; m = mn;
                const bf16* vp = F.Vd + ((size_t)bh * TK + ch * 64) * 128 + 2 * lane;
#pragma unroll 8
                for (int kk = 0; kk < 64; ++kk) { const float pk = __shfl(p, kk); const unsigned vv = *(const unsigned*)(vp + (size_t)kk * 128); a0 += pk * bflo(vv); a1 += pk * bfhi(vv); }
            }
            const float il = 1.f / l;
            if (map == 0) { o0 = a0 * il; o1 = a1 * il; } else { o0 -= lam * a0 * il; o1 -= lam * a1 * il; }
        }
        const float r = 1.0f / sqrtf(wave_sum(o0 * o0 + o1 * o1) * (1.f / 128.f) + EPS);
        const float* g = F.in[I_SUBLN] + 2 * lane;
        *(unsigned*)(F.MIX + (size_t)(b * T + t) * D + h * 128 + 2 * lane) = pk2(o0 * r * g[0] * (1.f - LAMBDA_INIT), o1 * r * g[1] * (1.f - LAMBDA_INIT));
    }
}


namespace da {
using bf16x8 = __attribute__((ext_vector_type(8))) short;
using s16x4  = __attribute__((ext_vector_type(4))) short;
using f32x16 = __attribute__((ext_vector_type(16))) float;
using u32x4  = __attribute__((ext_vector_type(4))) unsigned;
constexpr int KVBLK = 64;
constexpr size_t SHM_V = KVBLK * 128 * 2, SHM_K = KVBLK * 128 * 2;
constexpr float THR2 = 8.f * 1.4426950408889634f;
#define KSWZ(row, colB) ((row) * 256 + ((colB) ^ (((row) & 7) << 4)))
#define SBAR() __builtin_amdgcn_sched_barrier(0)
__device__ __forceinline__ int crow(int r, int hi) { return (r & 3) + 8 * (r >> 2) + 4 * hi; }
__device__ __forceinline__ unsigned cvtpk(float lo, float hi) { unsigned r; asm volatile("v_cvt_pk_bf16_f32 %0, %1, %2" : "=v"(r) : "v"(lo), "v"(hi)); return r; }
__device__ __forceinline__ void partialSM(f32x16& p0, f32x16& p1, float& m_reg, float& mn, float& alpha) {
  float pmax = p0[0]; for (int r = 1; r < 16; ++r) pmax = fmaxf(pmax, p0[r]); for (int r = 0; r < 16; ++r) pmax = fmaxf(pmax, p1[r]);
  { auto rr = __builtin_amdgcn_permlane32_swap(__float_as_uint(pmax), __float_as_uint(pmax), false, false);
    pmax = fmaxf(__uint_as_float(rr[0]), __uint_as_float(rr[1])); }
  if (__builtin_expect(__all(pmax - m_reg <= THR2), 1)) { mn = m_reg; alpha = 1.f; }
  else { mn = fmaxf(m_reg, pmax); alpha = __builtin_amdgcn_exp2f(m_reg - mn); m_reg = mn; }
  for (int r = 0; r < 16; ++r) p0[r] = p0[r] - mn; for (int r = 0; r < 16; ++r) p1[r] = p1[r] - mn;
  for (int r = 0; r < 16; ++r) p0[r] = __builtin_amdgcn_exp2f(p0[r]);
}
__device__ __forceinline__ void finishSM(f32x16& p0, f32x16& p1, float alpha, float& l_reg, bf16x8& pa0, bf16x8& pa1, bf16x8& pa2, bf16x8& pa3) {
  for (int r = 0; r < 16; ++r) p1[r] = __builtin_amdgcn_exp2f(p1[r]);
  float ps = 0; for (int r = 0; r < 16; ++r) ps += p0[r]; for (int r = 0; r < 16; ++r) ps += p1[r];
  { auto rr = __builtin_amdgcn_permlane32_swap(__float_as_uint(ps), __float_as_uint(ps), false, false);
    ps = __uint_as_float(rr[0]) + __uint_as_float(rr[1]); }
  l_reg = l_reg * alpha + ps;
#define PK4(P, BASE, OUT) do { unsigned a0 = cvtpk(P[BASE + 0], P[BASE + 1]), a1 = cvtpk(P[BASE + 2], P[BASE + 3]);   \
    unsigned b0 = cvtpk(P[BASE + 4], P[BASE + 5]), b1 = cvtpk(P[BASE + 6], P[BASE + 7]);                              \
    auto r0 = __builtin_amdgcn_permlane32_swap(a0, b0, false, false); auto r1 = __builtin_amdgcn_permlane32_swap(a1, b1, false, false); \
    u32x4 w = {r0[0], r1[0], r0[1], r1[1]}; OUT = *reinterpret_cast<bf16x8*>(&w); } while (0)
  PK4(p0, 0, pa0); PK4(p0, 8, pa1); PK4(p1, 0, pa2); PK4(p1, 8, pa3);
#undef PK4
}
constexpr float FAST_BOUND = 60.f;
__device__ __forceinline__ void partialSM_fast(f32x16& p0) { for (int r = 0; r < 16; ++r) p0[r] = __builtin_amdgcn_exp2f(p0[r]); }
__device__ __forceinline__ void finishSM_fast(f32x16& p0, f32x16& p1, float& l_reg, bf16x8& pa0, bf16x8& pa1, bf16x8& pa2, bf16x8& pa3) {
  for (int r = 0; r < 16; ++r) p1[r] = __builtin_amdgcn_exp2f(p1[r]);
  float ps0 = 0, ps1 = 0, ps2 = 0, ps3 = 0;
  for (int r = 0; r < 16; r += 4) { ps0 += p0[r]; ps1 += p0[r + 1]; ps2 += p0[r + 2]; ps3 += p0[r + 3]; }
  for (int r = 0; r < 16; r += 4) { ps0 += p1[r]; ps1 += p1[r + 1]; ps2 += p1[r + 2]; ps3 += p1[r + 3]; }
  float ps = (ps0 + ps1) + (ps2 + ps3);
  { auto rr = __builtin_amdgcn_permlane32_swap(__float_as_uint(ps), __float_as_uint(ps), false, false);
    ps = __uint_as_float(rr[0]) + __uint_as_float(rr[1]); }
  l_reg += ps;
#define PK4(P, BASE, OUT) do { unsigned a0 = cvtpk(P[BASE + 0], P[BASE + 1]), a1 = cvtpk(P[BASE + 2], P[BASE + 3]);   \
    unsigned b0 = cvtpk(P[BASE + 4], P[BASE + 5]), b1 = cvtpk(P[BASE + 6], P[BASE + 7]);                              \
    auto r0 = __builtin_amdgcn_permlane32_swap(a0, b0, false, false); auto r1 = __builtin_amdgcn_permlane32_swap(a1, b1, false, false); \
    u32x4 w = {r0[0], r1[0], r0[1], r1[1]}; OUT = *reinterpret_cast<bf16x8*>(&w); } while (0)
  PK4(p0, 0, pa0); PK4(p0, 8, pa1); PK4(p1, 0, pa2); PK4(p1, 8, pa3);
#undef PK4
}
__device__ __forceinline__ void qkt(f32x16& p0, f32x16& p1, const char* Ks, const bf16x8* qr, int r32, int hi, int mapB) {
  p0 = f32x16{}; p1 = f32x16{};
  for (int d0 = 0; d0 < 4; ++d0) { int cb = mapB + (d0 * 16 + hi * 8) * 2;
    bf16x8 b0 = *reinterpret_cast<const bf16x8*>(Ks + KSWZ(r32, cb));
    bf16x8 b1 = *reinterpret_cast<const bf16x8*>(Ks + KSWZ(32 + r32, cb));
    p0 = __builtin_amdgcn_mfma_f32_32x32x16_bf16(b0, qr[d0], p0, 0, 0, 0);
    p1 = __builtin_amdgcn_mfma_f32_32x32x16_bf16(b1, qr[d0], p1, 0, 0, 0); }
}
__device__ __forceinline__ int v_st(int k, int c) { const int kk = (k & ~0xC) | ((k & 4) << 1) | ((k & 8) >> 1); return ((kk >> 3) * 4 + (c >> 5)) * 512 + ((kk & 7) * 32 + (c & 31)) * 2; }
__device__ __forceinline__ int v_rd_base(int lane) { return ((lane & 3) << 3) | (((lane >> 2) & 3) << 6) | (((lane >> 4) & 1) << 5) | (((lane >> 5) & 1) << 8); }
constexpr int v_rd_off(int d0, int ks, int half) { return d0 * 512 + ks * 4096 + half * 2048; }
template <int OFF> __device__ __forceinline__ s16x4 tr_read(int vb) {
  s16x4 r; asm volatile("ds_read_b64_tr_b16 %0, %1 offset:%2" : "=&v"(r) : "v"(vb), "i"(OFF) : "memory"); return r;
}
template <int D0> __device__ __forceinline__ void pv_one(f32x16& od, int vb, bf16x8 pa0, bf16x8 pa1, bf16x8 pa2, bf16x8 pa3) {
  const s16x4 l0 = tr_read<v_rd_off(D0, 0, 0)>(vb), h0 = tr_read<v_rd_off(D0, 0, 1)>(vb), l1 = tr_read<v_rd_off(D0, 1, 0)>(vb), h1 = tr_read<v_rd_off(D0, 1, 1)>(vb);
  const s16x4 l2 = tr_read<v_rd_off(D0, 2, 0)>(vb), h2 = tr_read<v_rd_off(D0, 2, 1)>(vb), l3 = tr_read<v_rd_off(D0, 3, 0)>(vb), h3 = tr_read<v_rd_off(D0, 3, 1)>(vb);
  asm volatile("s_waitcnt lgkmcnt(0)" ::: "memory"); SBAR();
#define PK(L, H) (bf16x8){L[0], L[1], L[2], L[3], H[0], H[1], H[2], H[3]}
  od = __builtin_amdgcn_mfma_f32_32x32x16_bf16(pa0, PK(l0, h0), od, 0, 0, 0);
  od = __builtin_amdgcn_mfma_f32_32x32x16_bf16(pa1, PK(l1, h1), od, 0, 0, 0);
  od = __builtin_amdgcn_mfma_f32_32x32x16_bf16(pa2, PK(l2, h2), od, 0, 0, 0);
  od = __builtin_amdgcn_mfma_f32_32x32x16_bf16(pa3, PK(l3, h3), od, 0, 0, 0);
#undef PK
}
__device__ __forceinline__ void pv_d0(f32x16* o, int vb, bf16x8 pa0, bf16x8 pa1, bf16x8 pa2, bf16x8 pa3) {
  pv_one<0>(o[0], vb, pa0, pa1, pa2, pa3); pv_one<1>(o[1], vb, pa0, pa1, pa2, pa3); pv_one<2>(o[2], vb, pa0, pa1, pa2, pa3); pv_one<3>(o[3], vb, pa0, pa1, pa2, pa3);
}
__device__ __forceinline__ void da_unit(const bf16* __restrict__ Qb, const bf16* __restrict__ Kh, const bf16* __restrict__ Vh, bf16* __restrict__ Mx,
                                        const float* __restrict__ subg, float lam, int seq, char* lds, const unsigned* kmax2, int wave_s) {
  int tid = wave_s * 64 + lane_id(); asm volatile("" : "+v"(tid));
  const int wid = tid >> 6, lane = tid & 63, r32 = lane & 31, hi = lane >> 5, map = wid >> 2, wq = wid & 3;
  char* V_lds = lds; char* K_lds = lds + 3 * SHM_V;
  float* ws = (float*)(lds + 3 * SHM_V + 3 * SHM_K) + wid * 64; float* li_l = ws; float* al_l = ws + 32;
  float m_reg = -1e30f, l_reg = 0; f32x16 o[4] = {}; bf16x8 qr[4];
  const bf16* Qw = Qb + (long)(wq * 32 + r32) * 128 + map * 64 + hi * 8;
#pragma unroll
  for (int d0 = 0; d0 < 4; ++d0) qr[d0] = *reinterpret_cast<const bf16x8*>(Qw + d0 * 16);
  const int mapB = map * 128;
  const int sr = tid >> 4, sc = (tid & 15) * 8, vst0 = v_st(sr, sc), vst1 = v_st(32 + sr, sc);
  const int vb0 = (int)(uintptr_t)V_lds + v_rd_base(lane);
  struct { bf16x8 vs0, vs1, ks0, ks1; } sr_;
#define SLOAD(k0) do { sr_.vs0 = *reinterpret_cast<const bf16x8*>(&Vh[(long)((k0) + sr) * 128 + sc]); sr_.vs1 = *reinterpret_cast<const bf16x8*>(&Vh[(long)((k0) + 32 + sr) * 128 + sc]); \
    sr_.ks0 = *reinterpret_cast<const bf16x8*>(&Kh[(long)((k0) + sr) * 128 + sc]); sr_.ks1 = *reinterpret_cast<const bf16x8*>(&Kh[(long)((k0) + 32 + sr) * 128 + sc]); } while (0)
#define SWRITE(so) do { *(bf16x8*)(V_lds + (so) + vst0) = sr_.vs0; *(bf16x8*)(V_lds + (so) + vst1) = sr_.vs1; const int kc = sc * 2;  \
    *(bf16x8*)(K_lds + (so) + KSWZ(sr, kc)) = sr_.ks0; *(bf16x8*)(K_lds + (so) + KSWZ(32 + sr, kc)) = sr_.ks1; } while (0)
#define SWAIT() asm volatile("s_waitcnt vmcnt(0)" ::: "memory")
#define RESC(a) do { if (__any((a) < 1.f)) { if (hi == 0) al_l[r32] = (a); asm volatile("s_waitcnt lgkmcnt(0)" ::: "memory"); \
    for (int d = 0; d < 4; ++d) for (int r = 0; r < 16; ++r) o[d][r] *= al_l[crow(r, hi)]; } } while (0)
#define ROT() do { const int t_ = sprev; sprev = scur; scur = snext; snext = t_; } while (0)
  f32x16 pA0, pA1, pB0, pB1; float mnA, mnB, alA, alB; bf16x8 pa0, pa1, pa2, pa3; const int NT = seq / KVBLK;
  int sprev = 0, scur = (int)SHM_V, snext = 2 * (int)SHM_V;
  bool fast;
  { float q2 = 0.f;
#pragma unroll
    for (int d0 = 0; d0 < 4; ++d0)
#pragma unroll
      for (int j = 0; j < 8; ++j) { const float qv = bf2f((unsigned short)qr[d0][j]); q2 += qv * qv; }
    { auto rr = __builtin_amdgcn_permlane32_swap(__float_as_uint(q2), __float_as_uint(q2), false, false); q2 = __uint_as_float(rr[0]) + __uint_as_float(rr[1]); }
    const float k2 = __uint_as_float(kmax2[map]);
    fast = __all(q2 * k2 < FAST_BOUND * FAST_BOUND); }
#define STEP(PC0, PC1, PP0, PP1, alP, mnC, alC, t) do { \
    SBAR(); qkt(PC0, PC1, K_lds + scur, qr, r32, hi, mapB); \
    finishSM(PP0, PP1, alP, l_reg, pa0, pa1, pa2, pa3); SBAR(); \
    pv_d0(o, vb0 + sprev, pa0, pa1, pa2, pa3); partialSM(PC0, PC1, m_reg, mnC, alC); \
    if ((t) + 1 < NT) { SWAIT(); SWRITE(snext); if ((t) + 2 < NT) SLOAD(((t) + 2) * KVBLK); } \
    RESC(alC); __syncthreads(); ROT(); } while (0)
#define STEPF(PC0, PC1, PP0, PP1, t) do { \
    SBAR(); qkt(PC0, PC1, K_lds + scur, qr, r32, hi, mapB); \
    finishSM_fast(PP0, PP1, l_reg, pa0, pa1, pa2, pa3); SBAR(); \
    pv_d0(o, vb0 + sprev, pa0, pa1, pa2, pa3); partialSM_fast(PC0); \
    if ((t) + 1 < NT) { SWAIT(); SWRITE(snext); if ((t) + 2 < NT) SLOAD(((t) + 2) * KVBLK); } \
    __syncthreads(); ROT(); } while (0)
  if (fast) {
    SLOAD(0); SWAIT(); SWRITE(0); SLOAD(KVBLK); __syncthreads();
    qkt(pA0, pA1, K_lds, qr, r32, hi, mapB); partialSM_fast(pA0);
    SWAIT(); SWRITE(scur); SLOAD(2 * KVBLK); __syncthreads();
    for (int t = 1; t + 1 < NT; t += 2) { STEPF(pB0, pB1, pA0, pA1, t); STEPF(pA0, pA1, pB0, pB1, t + 1); }
    STEPF(pB0, pB1, pA0, pA1, NT - 1);
    finishSM_fast(pB0, pB1, l_reg, pa0, pa1, pa2, pa3); SBAR();
    pv_d0(o, vb0 + sprev, pa0, pa1, pa2, pa3);
  } else {
    SLOAD(0); SWAIT(); SWRITE(0); SLOAD(KVBLK); __syncthreads();
    qkt(pA0, pA1, K_lds, qr, r32, hi, mapB); partialSM(pA0, pA1, m_reg, mnA, alA);
    SWAIT(); SWRITE(scur); SLOAD(2 * KVBLK); __syncthreads();
    for (int t = 1; t + 1 < NT; t += 2) {
      STEP(pB0, pB1, pA0, pA1, alA, mnB, alB, t);
      STEP(pA0, pA1, pB0, pB1, alB, mnA, alA, t + 1);
    }
    STEP(pB0, pB1, pA0, pA1, alA, mnB, alB, NT - 1);
    finishSM(pB0, pB1, alB, l_reg, pa0, pa1, pa2, pa3); SBAR();
    pv_d0(o, vb0 + sprev, pa0, pa1, pa2, pa3);
  }
#undef STEP
#undef STEPF
#undef ROT
  int lane_e = lane_id(); asm volatile("" : "+v"(lane_e));
  if (hi == 0) li_l[r32] = l_reg; asm volatile("s_waitcnt lgkmcnt(0)" ::: "memory");
  float rli[16];
#pragma unroll
  for (int r = 0; r < 16; ++r) rli[r] = __builtin_amdgcn_rcpf(li_l[crow(r, hi)]);
  __syncthreads();
  float* X = (float*)lds + (wq * 64 + lane_e) * 64;
  if (map == 1) {
#pragma unroll
    for (int d0 = 0; d0 < 4; ++d0)
#pragma unroll
      for (int r = 0; r < 16; ++r) X[d0 * 16 + r] = o[d0][r] * rli[r] * lam;
  }
  __syncthreads();
  if (map == 0) {
    float ssq[16];
#pragma unroll
    for (int r = 0; r < 16; ++r) ssq[r] = 0.f;
#pragma unroll
    for (int d0 = 0; d0 < 4; ++d0)
#pragma unroll
      for (int r = 0; r < 16; ++r) { o[d0][r] = o[d0][r] * rli[r] - X[d0 * 16 + r]; ssq[r] += o[d0][r] * o[d0][r]; }
#pragma unroll
    for (int r = 0; r < 16; ++r) {
#pragma unroll
      for (int off = 1; off < 32; off <<= 1) ssq[r] += __shfl_xor(ssq[r], off);
      ssq[r] = (1.f - LAMBDA_INIT) / sqrtf(ssq[r] * (1.f / 128.f) + EPS);
    }
    char* st = lds + 65536 + wq * 8704;
#pragma unroll
    for (int d0 = 0; d0 < 4; ++d0) { const float g = subg[d0 * 32 + (lane_e & 31)];
#pragma unroll
      for (int r = 0; r < 16; ++r) *(bf16*)(st + crow(r, lane_e >> 5) * 272 + (d0 * 32 + (lane_e & 31)) * 2) = (bf16)f2bf(o[d0][r] * ssq[r] * g); }
    asm volatile("s_waitcnt lgkmcnt(0)" ::: "memory");
    bf16* Mw = Mx + (long)(wq * 32 + (lane_e >> 4)) * D + (lane_e & 15) * 8;
#pragma unroll
    for (int it = 0; it < 8; ++it) { const u32x4 v = *(const u32x4*)(st + (it * 4 + (lane_e >> 4)) * 272 + (lane_e & 15) * 16); *(u32x4*)(Mw + (long)(it * 4) * D) = v; }
  }
  __syncthreads();
#undef SLOAD
#undef SWRITE
#undef SWAIT
#undef RESC
}
#undef KSWZ
#undef SBAR
}

__device__ __forceinline__ void knorm_pass(Frame& F) {
    const int gw = F.vcu * NWAVES + F.wave, NGW = F.G * NWAVES, lane = F.lane;
    unsigned* KM = (unsigned*)(F.ws + WS_KMAX);
    for (int it = gw; it < NB * NH * (TK / 64); it += NGW) {
        const int bh = it / (TK / 64), kb = it % (TK / 64);
        const v4u* kp = (const v4u*)(F.Kd + ((size_t)bh * TK + kb * 64 + lane) * 128);
        float s0 = 0.f, s1 = 0.f;
#pragma unroll
        for (int c = 0; c < 16; ++c) { const v4u w = kp[c]; const float a = bflo(w.x), b = bfhi(w.x), cc = bflo(w.y), d = bfhi(w.y), e = bflo(w.z), f = bfhi(w.z), g = bflo(w.w), h = bfhi(w.w);
            const float q = (a * a + b * b) + (cc * cc + d * d) + (e * e + f * f) + (g * g + h * h); if (c < 8) s0 += q; else s1 += q; }
        s0 = wave_max(s0); s1 = wave_max(s1);
        if (lane == 0) { atomicMax(KM + bh * 2, __float_as_uint(s0)); atomicMax(KM + bh * 2 + 1, __float_as_uint(s1)); }
    }
}

__device__ __forceinline__ void fast_attn(Frame& F) {
    float lam;
    { const int l = F.lane; const float s1 = wave_sum(F.in[I_LQ1][l] * F.in[I_LK1][l]), s2 = wave_sum(F.in[I_LQ2][l] * F.in[I_LK2][l]); lam = __expf(s1) - __expf(s2) + LAMBDA_INIT; lam = __builtin_bit_cast(float, __builtin_amdgcn_readfirstlane(__builtin_bit_cast(int, lam))); }
    for (int u = F.vcu * 4; u < NB * NH * (T / 128); u += F.G * 4)
        for (int i = 0; i < 4; ++i) {
            const int uu = u + i, bh = uu >> 6, qb = uu & 63, b = bh >> 2, h = bh & 3;
            da::da_unit(F.Qd + ((size_t)bh * T + qb * 128) * 128, F.Kd + (size_t)bh * TK * 128, F.Vd + (size_t)bh * TK * 128,
                        F.MIX + ((size_t)b * T + qb * 128) * D + h * 128, F.in[I_SUBLN], lam, TK, (char*)(F.lds), (const unsigned*)(F.ws + WS_KMAX) + bh * 2, F.wave);
        }
}


namespace ml {
using da::bf16x8; using da::s16x4; using da::f32x16; using da::u32x4; using da::crow; using da::cvtpk; using da::v_st; using da::v_rd_base; using da::tr_read; using da::v_rd_off;
constexpr int NCH = TK / 64;
constexpr int CE = 129 * 64;
constexpr float LOG2E = 1.4426950408889634f;
#define KSWZ64(row, colB) ((row) * 128 + ((colB) ^ ((((row) >> 1) & 7) << 4)))
__device__ __forceinline__ float scan_add(float v, int lane) {
#pragma unroll
    for (int o = 1; o < 64; o <<= 1) { const float t = __shfl_up(v, o); if (lane >= o) v += t; }
    return v;
}
__device__ __forceinline__ float scan_max(float v, int lane) {
#pragma unroll
    for (int o = 1; o < 64; o <<= 1) { const float t = __shfl_up(v, o); if (lane >= o) v = fmaxf(v, t); }
    return v;
}
__device__ __forceinline__ int pos_of(int dir, int c) { return dir ? (c < 4 ? 3 - c : 135 - c) : c; }
__device__ __forceinline__ v4u scale8(v4u x, float w) { v4u o; o.x = pk2(bflo(x.x) * w, bfhi(x.x) * w); o.y = pk2(bflo(x.y) * w, bfhi(x.y) * w); o.z = pk2(bflo(x.z) * w, bfhi(x.z) * w); o.w = pk2(bflo(x.w) * w, bfhi(x.w) * w); return o; }
#define ML_PK(L, H) (bf16x8){L[0], L[1], L[2], L[3], H[0], H[1], H[2], H[3]}

__device__ __forceinline__ void phase_a(Frame& F, float* DC, float* SCL) {
    char* lds = (char*)F.lds; const int VI = 0, KW = 16384; float* WL = (float*)(lds + 32768);
    const int tid = F.tid, lane = F.lane, wid = F.wave, r32 = lane & 31, hi = lane >> 5;
    const int dir = wid >> 2, dt = (wid >> 1) & 1, vs = wid & 1;
    const int ldsb = (int)(uintptr_t)lds;
    const int krow = tid >> 3, kch = tid & 7, sr = tid >> 4, sc = (tid & 15) * 8;
    v4u kv, v0, v1; float gli = 0.f, glf = 0.f;
#define A_LOAD(uu) do { const int bh_ = (uu) / NCH, k0_ = ((uu) % NCH) * 64; \
        kv = *(const v4u*)(F.MK + ((size_t)bh_ * TK + k0_ + krow) * 64 + kch * 8); \
        v0 = *(const v4u*)(F.MV + ((size_t)bh_ * TK + k0_ + sr) * 128 + sc); v1 = *(const v4u*)(F.MV + ((size_t)bh_ * TK + k0_ + 32 + sr) * 128 + sc); \
        if (wid < 2) { const float* g4_ = F.gates + ((size_t)bh_ * TK + k0_ + (wid ? 63 - lane : lane)) * 4 + wid * 2; gli = g4_[0]; glf = g4_[1]; } } while (0)
    if (F.vcu < NB * NH * NCH) A_LOAD(F.vcu);
    for (int u = F.vcu; u < NB * NH * NCH; u += F.G) {
        const int bh = u / NCH, c = u % NCH;
        if (wid < 2) {
            const int d = wid, s = d ? 63 - lane : lane;
            const float li = gli, lf = glf;
            const float b = scan_add(lf, lane), bl = __shfl(b, 63), g = bl - b + li, m = wave_max(g);
            WL[d * 64 + s] = __expf(g - m);
            if (lane == 0) { float* sp = SCL + ((size_t)(bh * 2 + d) * NCH + pos_of(d, c)) * 2; sp[0] = bl; sp[1] = m; }
        }
        __syncthreads();
        *(v4u*)(lds + KW + v_st(krow, kch * 8)) = scale8(kv, WL[krow]);
        *(v4u*)(lds + KW + v_st(krow, 64 + kch * 8)) = scale8(kv, WL[64 + krow]);
        *(v4u*)(lds + VI + v_st(sr, sc)) = v0; *(v4u*)(lds + VI + v_st(32 + sr, sc)) = v1;
        if (u + F.G < NB * NH * NCH) A_LOAD(u + F.G);
        __syncthreads();
        bf16x8 kw[4];
        { const int vb = ldsb + KW + v_rd_base(lane) + (2 * dir + dt) * 512;
          const s16x4 l0 = tr_read<v_rd_off(0, 0, 0)>(vb), h0 = tr_read<v_rd_off(0, 0, 1)>(vb), l1 = tr_read<v_rd_off(0, 1, 0)>(vb), h1 = tr_read<v_rd_off(0, 1, 1)>(vb);
          const s16x4 l2 = tr_read<v_rd_off(0, 2, 0)>(vb), h2 = tr_read<v_rd_off(0, 2, 1)>(vb), l3 = tr_read<v_rd_off(0, 3, 0)>(vb), h3 = tr_read<v_rd_off(0, 3, 1)>(vb);
          asm volatile("s_waitcnt lgkmcnt(0)" ::: "memory"); __builtin_amdgcn_sched_barrier(0);
          kw[0] = ML_PK(l0, h0); kw[1] = ML_PK(l1, h1); kw[2] = ML_PK(l2, h2); kw[3] = ML_PK(l3, h3); }
        float* dcb = DC + ((size_t)(bh * 2 + dir) * NCH + pos_of(dir, c)) * CE + dt * 32 + r32;
#pragma unroll
        for (int t = 0; t < 2; ++t) {
            const int vt = 2 * vs + t; const int vb = ldsb + VI + v_rd_base(lane) + vt * 512;
            const s16x4 l0 = tr_read<v_rd_off(0, 0, 0)>(vb), h0 = tr_read<v_rd_off(0, 0, 1)>(vb), l1 = tr_read<v_rd_off(0, 1, 0)>(vb), h1 = tr_read<v_rd_off(0, 1, 1)>(vb);
            const s16x4 l2 = tr_read<v_rd_off(0, 2, 0)>(vb), h2 = tr_read<v_rd_off(0, 2, 1)>(vb), l3 = tr_read<v_rd_off(0, 3, 0)>(vb), h3 = tr_read<v_rd_off(0, 3, 1)>(vb);
            asm volatile("s_waitcnt lgkmcnt(0)" ::: "memory"); __builtin_amdgcn_sched_barrier(0);
            f32x16 acc = {};
            acc = __builtin_amdgcn_mfma_f32_32x32x16_bf16(ML_PK(l0, h0), kw[0], acc, 0, 0, 0);
            acc = __builtin_amdgcn_mfma_f32_32x32x16_bf16(ML_PK(l1, h1), kw[1], acc, 0, 0, 0);
            acc = __builtin_amdgcn_mfma_f32_32x32x16_bf16(ML_PK(l2, h2), kw[2], acc, 0, 0, 0);
            acc = __builtin_amdgcn_mfma_f32_32x32x16_bf16(ML_PK(l3, h3), kw[3], acc, 0, 0, 0);
#pragma unroll
            for (int r = 0; r < 16; ++r) dcb[(size_t)(vt * 32 + crow(r, hi)) * 64] = acc[r];
        }
        if (vs == 0) {
            const short one = (r32 == 0) ? (short)0x3F80 : (short)0; const bf16x8 ones = {one, one, one, one, one, one, one, one};
            f32x16 acc = {};
#pragma unroll
            for (int ks = 0; ks < 4; ++ks) acc = __builtin_amdgcn_mfma_f32_32x32x16_bf16(ones, kw[ks], acc, 0, 0, 0);
            if (hi == 0) dcb[(size_t)128 * 64] = acc[0];
        }
        __syncthreads();
    }
#undef A_LOAD
}

__device__ __forceinline__ void phase_b(Frame& F, const float* DC, const float* SCL, bf16* CIN, float* MINV) {
    const int NPAIR = CE / 2, TOTAL = NB * NH * 2 * NPAIR;
    for (int pr = F.vcu * 512 + F.tid; pr < TOTAL; pr += F.G * 512) {
        const int cd = pr / NPAIR, e = pr % NPAIR;
        const float* dcp = DC + (size_t)cd * NCH * CE + 2 * e; const float* scp = SCL + (size_t)cd * NCH * 2;
        bf16* cop = CIN + (size_t)cd * 128 * CE + 2 * e;
        float M = 0.f, c0 = 0.f, c1 = 0.f;
        for (int p0 = 0; p0 < NCH; p0 += 12) {
            f32x2 dc[12], sl[12];
#pragma unroll
            for (int i = 0; i < 12; ++i) { dc[i] = *(const f32x2*)(dcp + (size_t)(p0 + i) * CE); sl[i] = *(const f32x2*)(scp + (p0 + i) * 2); }
#pragma unroll
            for (int i = 0; i < 12; ++i) { const int pos = p0 + i;
                if (pos >= 4) { *(unsigned*)(cop + (size_t)(pos - 4) * CE) = pk2(c0, c1); if (e == 0) MINV[cd * 128 + pos - 4] = M; }
                const float Mn = fmaxf(sl[i].x + M, sl[i].y), a = __expf(sl[i].x + M - Mn), cc = __expf(sl[i].y - Mn);
                c0 = a * c0 + cc * dc[i].x; c1 = a * c1 + cc * dc[i].y; M = Mn; }
        }
    }
}

__device__ __forceinline__ void phase_c(Frame& F, const bf16* CIN, const float* MINV) {
    char* lds = (char*)F.lds; const int ldsb = (int)(uintptr_t)lds;
    constexpr int KI = 0, VIo = 16384, CI = 49152, NLo = 81920, AAo = 82432, MMo = 82944, WIo = 83456, CFo = 83968, SCWo = 84480, SSQo = 86528, XO = 0, STO = 32768;
    float* NL = (float*)(lds + NLo); float* AA = (float*)(lds + AAo); float* MM = (float*)(lds + MMo); float* WI = (float*)(lds + WIo); float* CF = (float*)(lds + CFo);
    float* SSQ = (float*)(lds + SSQo); float* X = (float*)(lds + XO);
    const int wid = F.wave;
    const int dir = wid >> 2, rb = (wid >> 1) & 1, vh = wid & 1;
    float* SCW = (float*)(lds + SCWo) + wid * 64;
    float* ST = (float*)(lds + STO) + (rb * 2 + vh) * 2048;
    v4u kv, v0, v1, c0, c1, c2, c3; float gli = 0.f, glf = 0.f, gM = 0.f, nval = 0.f; bf16x8 qr[4];
#define C_LOAD_STAGE(uu_, tid_, lane_) do { const int bh_ = (uu_) >> 7, cl_ = (uu_) & 127, k0_ = CT + cl_ * 64; const int kr_ = (tid_) >> 3, kc_ = (tid_) & 7, sr_ = (tid_) >> 4, sc_ = ((tid_) & 15) * 8; \
        kv = *(const v4u*)(F.MK + ((size_t)bh_ * TK + k0_ + kr_) * 64 + kc_ * 8); \
        v0 = *(const v4u*)(F.MV + ((size_t)bh_ * TK + k0_ + sr_) * 128 + sc_); v1 = *(const v4u*)(F.MV + ((size_t)bh_ * TK + k0_ + 32 + sr_) * 128 + sc_); \
        const bf16* cf_ = CIN + ((size_t)(bh_ * 2 + 0) * 128 + cl_) * CE; const bf16* cb_ = CIN + ((size_t)(bh_ * 2 + 1) * 128 + (127 - cl_)) * CE; \
        c0 = *(const v4u*)(cf_ + kr_ * 64 + kc_ * 8); c1 = *(const v4u*)(cf_ + (64 + kr_) * 64 + kc_ * 8); c2 = *(const v4u*)(cb_ + kr_ * 64 + kc_ * 8); c3 = *(const v4u*)(cb_ + (64 + kr_) * 64 + kc_ * 8); \
        if ((tid_) < 128) nval = bf2f(((tid_) >> 6 ? cb_ : cf_)[128 * 64 + ((tid_) & 63)]); \
        if (wid < 2) { const int s_ = wid ? 63 - (lane_) : (lane_); const float* g4_ = F.gates + ((size_t)bh_ * TK + k0_ + s_) * 4 + wid * 2; gli = g4_[0]; glf = g4_[1]; gM = MINV[(bh_ * 2 + wid) * 128 + (wid ? 127 - cl_ : cl_)]; } } while (0)
#define C_LOAD_Q(uu_, lane_) do { const int bh_ = (uu_) >> 7, k0_ = CT + ((uu_) & 127) * 64; const int pr_ = rb * 32 + ((lane_) & 31), sw_ = dir ? 63 - pr_ : pr_; \
        const bf16* qp_ = F.MQ + ((size_t)bh_ * TK + k0_ + sw_) * 64 + ((lane_) >> 5) * 8; \
        _Pragma("unroll") for (int d0 = 0; d0 < 4; ++d0) qr[d0] = *reinterpret_cast<const bf16x8*>(qp_ + d0 * 16); } while (0)
    { const int l0_ = F.lane, t0_ = wid * 64 + l0_; C_LOAD_STAGE(F.vcu * 8, t0_, l0_); C_LOAD_Q(F.vcu * 8, l0_); }
    for (int u = F.vcu * 8; u < NB * NH * 128; u += F.G * 8)
      for (int ui = 0; ui < 8; ++ui) {
        int lane = F.lane; asm volatile("" : "+v"(lane));
        const int tid = wid * 64 + lane, r32 = lane & 31, hi = lane >> 5;
        const int uu = u + ui, bh = uu >> 7, cl = uu & 127, b = bh >> 2, h = bh & 3, t0 = cl * 64;
        const int unext = (ui < 7) ? uu + 1 : u + F.G * 8; const bool has_next = unext < NB * NH * 128;
        if (wid < 2) {
            const int d = wid;
            const float li = gli, lf = glf;
            const float bq = scan_add(lf, lane), aa = li - bq, pm = scan_max(aa, lane);
            const float M = gM, mm = fmaxf(M, pm);
            AA[d * 64 + lane] = aa * LOG2E; MM[d * 64 + lane] = mm * LOG2E; WI[d * 64 + lane] = __expf(M - mm); CF[d * 64 + lane] = __expf(-(bq + mm));
        }
        {
            const int krow = tid >> 3, kch = tid & 7, sr = tid >> 4, sc = (tid & 15) * 8;
            if (tid < 128) NL[(tid >> 6) * 64 + (tid & 63)] = nval;
            *(v4u*)(lds + KI + KSWZ64(krow, kch * 16)) = kv; *(v4u*)(lds + KI + 8192 + KSWZ64(63 - krow, kch * 16)) = kv;
            *(v4u*)(lds + VIo + v_st(sr, sc)) = v0; *(v4u*)(lds + VIo + v_st(32 + sr, sc)) = v1;
            *(v4u*)(lds + VIo + 16384 + v_st(63 - sr, sc)) = v0; *(v4u*)(lds + VIo + 16384 + v_st(31 - sr, sc)) = v1;
            *(v4u*)(lds + CI + KSWZ64(krow, kch * 16)) = c0; *(v4u*)(lds + CI + KSWZ64(64 + krow, kch * 16)) = c1;
            *(v4u*)(lds + CI + 16384 + KSWZ64(krow, kch * 16)) = c2; *(v4u*)(lds + CI + 16384 + KSWZ64(64 + krow, kch * 16)) = c3;
            if (has_next) C_LOAD_STAGE(unext, tid, lane);
        }
        const int prow = rb * 32 + r32;
        __syncthreads();
        f32x16 p0 = {}, p1 = {};
        { const char* Ks = lds + KI + dir * 8192;
#pragma unroll
          for (int d0 = 0; d0 < 4; ++d0) { const int cbb = (d0 * 16 + hi * 8) * 2;
            const bf16x8 b0 = *reinterpret_cast<const bf16x8*>(Ks + KSWZ64(r32, cbb)), b1 = *reinterpret_cast<const bf16x8*>(Ks + KSWZ64(32 + r32, cbb));
            p0 = __builtin_amdgcn_mfma_f32_32x32x16_bf16(b0, qr[d0], p0, 0, 0, 0); p1 = __builtin_amdgcn_mfma_f32_32x32x16_bf16(b1, qr[d0], p1, 0, 0, 0); } }
        const float mmp = MM[dir * 64 + prow], wip = WI[dir * 64 + prow];
#pragma unroll
        for (int r = 0; r < 16; ++r) { const int k0 = crow(r, hi), k1 = 32 + k0;
            const float e0 = __builtin_amdgcn_exp2f(AA[dir * 64 + k0] - mmp), e1 = __builtin_amdgcn_exp2f(AA[dir * 64 + k1] - mmp);
            p0[r] *= (k0 <= prow) ? e0 : 0.f; p1[r] *= (k1 <= prow) ? e1 : 0.f; }
        float ps = 0.f;
#pragma unroll
        for (int r = 0; r < 16; ++r) ps += p0[r] + p1[r];
        float nq = 0.f;
#pragma unroll
        for (int d0 = 0; d0 < 4; ++d0)
#pragma unroll
            for (int j = 0; j < 8; ++j) nq += bf2f((unsigned short)qr[d0][j]) * NL[dir * 64 + d0 * 16 + hi * 8 + j];
        { auto rr = __builtin_amdgcn_permlane32_swap(__float_as_uint(ps), __float_as_uint(ps), false, false); ps = __uint_as_float(rr[0]) + __uint_as_float(rr[1]); }
        { auto rr = __builtin_amdgcn_permlane32_swap(__float_as_uint(nq), __float_as_uint(nq), false, false); nq = __uint_as_float(rr[0]) + __uint_as_float(rr[1]); }
        const float den = ps + wip * nq, rscale = 1.0f / fmaxf(fabsf(den), CF[dir * 64 + prow]);
        if (hi == 0) SCW[r32] = rscale;
        bf16x8 pa0, pa1, pa2, pa3;
#define PK4(P, BASE, OUT) do { unsigned a0 = cvtpk(P[BASE + 0], P[BASE + 1]), a1 = cvtpk(P[BASE + 2], P[BASE + 3]);   \
    unsigned b0 = cvtpk(P[BASE + 4], P[BASE + 5]), b1 = cvtpk(P[BASE + 6], P[BASE + 7]);                              \
    auto r0 = __builtin_amdgcn_permlane32_swap(a0, b0, false, false); auto r1 = __builtin_amdgcn_permlane32_swap(a1, b1, false, false); \
    u32x4 w = {r0[0], r1[0], r0[1], r1[1]}; OUT = *reinterpret_cast<bf16x8*>(&w); } while (0)
        PK4(p0, 0, pa0); PK4(p0, 8, pa1); PK4(p1, 0, pa2); PK4(p1, 8, pa3);
#undef PK4
        f32x16 o[2] = {};
        { const int vb = ldsb + VIo + dir * 16384 + v_rd_base(lane) + (2 * vh) * 512;
          da::pv_one<0>(o[0], vb, pa0, pa1, pa2, pa3); da::pv_one<1>(o[1], vb, pa0, pa1, pa2, pa3); }
        bf16x8 qs[4];
#pragma unroll
        for (int d0 = 0; d0 < 4; ++d0) { u32x4 w;
            w[0] = cvtpk(bf2f((unsigned short)qr[d0][0]) * wip, bf2f((unsigned short)qr[d0][1]) * wip); w[1] = cvtpk(bf2f((unsigned short)qr[d0][2]) * wip, bf2f((unsigned short)qr[d0][3]) * wip);
            w[2] = cvtpk(bf2f((unsigned short)qr[d0][4]) * wip, bf2f((unsigned short)qr[d0][5]) * wip); w[3] = cvtpk(bf2f((unsigned short)qr[d0][6]) * wip, bf2f((unsigned short)qr[d0][7]) * wip);
            qs[d0] = *reinterpret_cast<bf16x8*>(&w); }
        if (has_next) C_LOAD_Q(unext, lane);
        { const char* Cs = lds + CI + dir * 16384;
#pragma unroll
          for (int t = 0; t < 2; ++t)
#pragma unroll
            for (int ks = 0; ks < 4; ++ks) { const bf16x8 cfr = *reinterpret_cast<const bf16x8*>(Cs + KSWZ64((2 * vh + t) * 32 + r32, (ks * 16 + hi * 8) * 2));
                o[t] = __builtin_amdgcn_mfma_f32_32x32x16_bf16(qs[ks], cfr, o[t], 0, 0, 0); } }
        asm volatile("s_waitcnt lgkmcnt(0)" ::: "memory");
#pragma unroll
        for (int r = 0; r < 16; ++r) { const float sv = SCW[crow(r, hi)]; o[0][r] *= sv; o[1][r] *= sv; }
        __syncthreads();
        if (dir == 1) {
#pragma unroll
            for (int t = 0; t < 2; ++t)
#pragma unroll
                for (int r = 0; r < 16; ++r) X[(63 - (rb * 32 + crow(r, hi))) * 128 + (2 * vh + t) * 32 + r32] = o[t][r];
        }
        __syncthreads();
        float ssq[16];
        if (dir == 0) {
#pragma unroll
            for (int r = 0; r < 16; ++r) { float a = 0.f;
#pragma unroll
                for (int t = 0; t < 2; ++t) { o[t][r] += X[(rb * 32 + crow(r, hi)) * 128 + (2 * vh + t) * 32 + r32]; a += o[t][r] * o[t][r]; }
#pragma unroll
                for (int off = 1; off < 32; off <<= 1) a += __shfl_xor(a, off);
                ssq[r] = a; if (r32 == 0) SSQ[(rb * 2 + vh) * 32 + crow(r, hi)] = a; }
        }
        __syncthreads();
        if (dir == 0) {
            const float* gn = F.in[I_MLNG] + h * 128 + vh * 64;
#pragma unroll
            for (int r = 0; r < 16; ++r) { const float tot = ssq[r] + SSQ[(rb * 2 + (1 - vh)) * 32 + crow(r, hi)]; const float rs = 1.0f / sqrtf(tot * (1.f / 128.f) + EPS);
#pragma unroll
                for (int t = 0; t < 2; ++t) ST[crow(r, hi) * 64 + t * 32 + r32] = o[t][r] * rs * gn[t * 32 + r32]; }
            asm volatile("s_waitcnt lgkmcnt(0)" ::: "memory");
            const size_t row0 = (size_t)b * T + t0 + rb * 32;
#pragma unroll
            for (int it = 0; it < 4; ++it) { const int row = it * 8 + (lane >> 3), ch = lane & 7;
                const f32x4 y0 = *(const f32x4*)(ST + row * 64 + ch * 8), y1 = *(const f32x4*)(ST + row * 64 + ch * 8 + 4);
                const v4u mo = *(const v4u*)(F.MO + (row0 + row) * 512 + h * 128 + vh * 64 + ch * 8);
                v4u ov; ov.x = pk2(y0[0] * bflo(mo.x), y0[1] * bfhi(mo.x)); ov.y = pk2(y0[2] * bflo(mo.y), y0[3] * bfhi(mo.y)); ov.z = pk2(y1[0] * bflo(mo.z), y1[1] * bfhi(mo.z)); ov.w = pk2(y1[2] * bflo(mo.w), y1[3] * bfhi(mo.w));
                *(v4u*)(F.MIX + (row0 + row) * D + 512 + h * 128 + vh * 64 + ch * 8) = ov; }
        }
        __syncthreads();
      }
#undef C_LOAD_STAGE
#undef C_LOAD_Q
}
#undef KSWZ64
#undef ML_PK
}

__device__ __forceinline__ void p_final(Frame& F) {
    const int gw = F.vcu * NWAVES + F.wave, NGW = F.G * NWAVES, lane = F.lane;
    f32x4 g[4];
#pragma unroll
    for (int j = 0; j < 4; ++j) g[j] = *(const f32x4*)(F.in[I_FING] + 4 * lane + 256 * j);
    for (int row = gw; row < NTOK; row += 4 * NGW) {
        f32x4 v[4][4]; float rs[4];
#pragma unroll
        for (int q = 0; q < 4; ++q) { const int r = row + q * NGW; if (r < NTOK) { rs[q] = F.rowsq2[r];
#pragma unroll
            for (int j = 0; j < 4; ++j) v[q][j] = *(const f32x4*)(F.out + (size_t)r * D + 4 * lane + 256 * j); } }
#pragma unroll
        for (int q = 0; q < 4; ++q) { const int r = row + q * NGW; if (r < NTOK) { const float rstd = 1.0f / sqrtf(rs[q] * (1.f / D) + EPS);
#pragma unroll
            for (int j = 0; j < 4; ++j) *(f32x4*)(F.out + (size_t)r * D + 4 * lane + 256 * j) = (v[q][j] * rstd) * g[j]; } }
    }
}

#define XB_TMO      128
#define XB_XCNT(j)  (256  + 64 * (j))
#define XB_XSUB(j)  (1280 + 64 * (j))
#define XB_XGEN(j)  (2304 + 64 * (j))
#define XB_TOP      3328
#define XB_TOPGEN   3392
#define XCD_BAR_WORDS 3456
#define XB_SPIN_CAP (1u << 22)
constexpr int CW_BAR = 4096;
constexpr int MISC_OFF = 131072 + 320;
__device__ __forceinline__ unsigned xb_ld(unsigned* p)              { return __hip_atomic_load(p, __ATOMIC_RELAXED, __HIP_MEMORY_SCOPE_AGENT); }
__device__ __forceinline__ unsigned xb_add(unsigned* p, unsigned v) { return __hip_atomic_fetch_add(p, v, __ATOMIC_RELAXED, __HIP_MEMORY_SCOPE_AGENT); }
__device__ __forceinline__ unsigned xb_xcc_id() { return (unsigned)__builtin_amdgcn_s_getreg((3 << 11) | 20) & 0xFu; }
#define XB_SPIN(cond, bar) do { unsigned _sp = 0; while (cond) { __builtin_amdgcn_s_sleep(1); \
    if ((++_sp & 255u) == 0u) { if (xb_ld(&(bar)[XB_TMO])) break; if (_sp > XB_SPIN_CAP) { atomicAdd(&(bar)[XB_TMO], 1u); break; } } } } while (0)
struct XcdBarrier { unsigned* bar; unsigned x; volatile LAS unsigned* st; };
__device__ __forceinline__ XcdBarrier xcd_barrier_post(unsigned* bar, volatile LAS unsigned* st, int tid) {
    XcdBarrier b; b.bar = bar; b.x = xb_xcc_id(); b.st = st;
    if (tid == 0) (void)xb_add(&bar[XB_XCNT(b.x)], 1u);
    return b;
}
__device__ __forceinline__ void xcd_barrier_complete(unsigned* bar, unsigned x, unsigned& nloc, unsigned& nx) {
    const unsigned G = gridDim.x * gridDim.y * gridDim.z;
    unsigned sum, cnt, mine, sp = 0u;
    for (;;) {
        sum = 0u; cnt = 0u; mine = 0u;
#pragma unroll
        for (unsigned j = 0; j < 16; ++j) { const unsigned c = xb_ld(&bar[XB_XCNT(j)]); sum += c; cnt += (c > 0u) ? 1u : 0u; mine = (j == x) ? c : mine; }
        if (sum == G) break;
        __builtin_amdgcn_s_sleep(1);
        if ((++sp & 255u) == 0u) { if (xb_ld(&bar[XB_TMO])) break; if (sp > XB_SPIN_CAP) { atomicAdd(&bar[XB_TMO], 1u); break; } }
    }
    nloc = mine > 0u ? mine : 1u; nx = cnt > 0u ? cnt : 1u;
}
__device__ __forceinline__ void xcd_barrier(const XcdBarrier& b, int tid) {
    asm volatile("s_waitcnt vmcnt(0)" ::: "memory");
    __syncthreads();
    if (tid == 0) {
        unsigned* bar = b.bar;
        __builtin_amdgcn_s_waitcnt(0);
        unsigned nloc = b.st[0], nx = b.st[1];
        if (nloc == 0u) { xcd_barrier_complete(bar, b.x, nloc, nx); b.st[0] = nloc; b.st[1] = nx; }
        const unsigned old = xb_add(&bar[XB_XSUB(b.x)], 1u);
        const unsigned gen = old / nloc;
        if (old + 1u == (gen + 1u) * nloc) {
            __builtin_amdgcn_fence(__ATOMIC_RELEASE, "agent");
            asm volatile("s_waitcnt vmcnt(0)" ::: "memory");
            const unsigned og = xb_add(&bar[XB_TOP], 1u);
            const unsigned tg = og / nx;
            if (og + 1u == (tg + 1u) * nx) xb_add(&bar[XB_TOPGEN], 1u);
            else XB_SPIN(xb_ld(&bar[XB_TOPGEN]) == tg, bar);
            __builtin_amdgcn_fence(__ATOMIC_ACQUIRE, "agent");
            xb_add(&bar[XB_XGEN(b.x)], 1u);
            asm volatile("s_waitcnt vmcnt(0)" ::: "memory");
        } else {
            XB_SPIN(xb_ld(&bar[XB_XGEN(b.x)]) == gen, bar);
            __builtin_amdgcn_fence(__ATOMIC_ACQUIRE, "agent");
            asm volatile("s_waitcnt vmcnt(0)" ::: "memory");
        }
    }
    __syncthreads();
}

constexpr int NPHASE = 10;
__global__ void __launch_bounds__(NWAVES * 64, 2) fwd_kernel(Args args) {
    extern __shared__ __attribute__((aligned(16))) unsigned char lds_raw[];
    Frame F;
    F.lds = (LAS unsigned char*)lds_raw;
    F.tid = threadIdx.x; F.lane = F.tid & 63; F.wave = __builtin_amdgcn_readfirstlane(F.tid >> 6);
    F.G = gridDim.x; { const int bx = blockIdx.x; F.vcu = (F.G % 8 == 0) ? (bx % 8) * (F.G / 8) + bx / 8 : bx; }
#pragma unroll
    for (int i = 0; i < 20; ++i) F.in[i] = args.in[i];
    F.out = args.out; F.ws = args.ws; unsigned char* ws = args.ws;
    F.mod = (float*)(ws + WS_MOD); F.rope = (f32x2*)(ws + WS_ROPE); F.bias1 = (float*)(ws + WS_BIAS1); F.wgt = (float*)(ws + WS_WGT); F.gates = (float*)(ws + WS_G);
    F.rowsq1 = (float*)(ws + WS_ROWSQ1); F.rowsq2 = (float*)(ws + WS_ROWSQ2);
    F.WinT = (bf16*)(ws + WS_WIN); F.WoT = (bf16*)(ws + WS_WO); F.W1T = (bf16*)(ws + WS_W1); F.W2T = (bf16*)(ws + WS_W2);
    F.XM = (bf16*)(ws + WS_XM); F.A2 = (bf16*)(ws + WS_XM);
    F.Qd = (bf16*)(ws + WS_Q); F.Kd = (bf16*)(ws + WS_K); F.Vd = (bf16*)(ws + WS_V); F.MQ = (bf16*)(ws + WS_MQ); F.MK = (bf16*)(ws + WS_MK); F.MV = (bf16*)(ws + WS_MV); F.MO = (bf16*)(ws + WS_MO);
    F.HF = (float*)(ws + WS_DC); F.HB = (float*)(ws + WS_DC + 64 * MiB);
#if FAST_MLSTM
    F.MIX = (bf16*)(ws + WS_DC);
#else
    F.MIX = (bf16*)(ws + WS_CIN);
#endif
    F.Hh = (bf16*)(ws + WS_H);
    const int lo = args.ph_lo, hi = args.ph_hi;
    for (int u = F.tid; u < (LDS_BYTES - 131072) / 4; u += NWAVES * 64) ((LAS unsigned*)(F.lds + 131072))[u] = 0u;
    __syncthreads();
    XcdBarrier bar = xcd_barrier_post((unsigned*)(ws + WS_CTL) + CW_BAR + args.li * XCD_BAR_WORDS, (volatile LAS unsigned*)(F.lds + MISC_OFF), F.tid);
#define IN(k) (refresh_ids(F), (lo <= (k) && (k) < hi))
#define SEAM(k) do { if (IN(k) && IN((k) + 1)) xcd_barrier(bar, F.tid); } while (0)
    if (IN(0)) { p0_prologue(F); if (DOUBLE_MASK & 1) { __syncthreads(); p0_prologue(F); } }
    SEAM(0);
    if (IN(1)) { p1_rows(F); if (DOUBLE_MASK & 2) { __syncthreads(); p1_rows(F); } }
    SEAM(1);
#if FAST_GEMM & 1
    if (IN(2)) { pg8::Gemm g{F.XM, F.WinT, MROWS, INP, D}; pg8::StaticOrder S; S.init(MROWS, INP, F.G, (int)blockIdx.x);
        EpiInproj E{F.Qd, F.Kd, F.Vd, F.MQ, F.MK, F.MV, F.MO, F.rope}; pg8::gemm_phase<EpiInproj, pg8::StaticOrder, true, true>(F.lds, g, S, E, F.tid);
        if (DOUBLE_MASK & 4) { __syncthreads(); pg8::gemm_phase<EpiInproj, pg8::StaticOrder, true, true>(F.lds, g, S, E, F.tid); } }
#else
    if (IN(2)) naive_gemm(F, F.XM, D, MROWS, F.in[I_WIN], INC, INP, D, NaiveInprojEpi{});
#endif
    SEAM(2);
#if FAST_MLSTM
    if (IN(3)) { knorm_pass(F); refresh_ids(F); ml::phase_a(F, (float*)(ws + WS_DC), (float*)(ws + WS_SCL)); if (DOUBLE_MASK & 8) { __syncthreads(); ml::phase_a(F, (float*)(ws + WS_DC), (float*)(ws + WS_SCL)); } }
    SEAM(3);
    if (IN(4)) { ml::phase_b(F, (const float*)(ws + WS_DC), (const float*)(ws + WS_SCL), (bf16*)(ws + WS_CIN), (float*)(ws + WS_MIN)); if (DOUBLE_MASK & 16) ml::phase_b(F, (const float*)(ws + WS_DC), (const float*)(ws + WS_SCL), (bf16*)(ws + WS_CIN), (float*)(ws + WS_MIN)); }
    SEAM(4);
    if (IN(5)) { fast_attn(F); if (DOUBLE_MASK & 32) fast_attn(F); refresh_ids(F); ml::phase_c(F, (const bf16*)(ws + WS_CIN), (const float*)(ws + WS_MIN)); if (DOUBLE_MASK & 64) { refresh_ids(F); ml::phase_c(F, (const bf16*)(ws + WS_CIN), (const float*)(ws + WS_MIN)); } }
#else
    if (IN(3)) naive_mlstm(F);
    SEAM(3);
    SEAM(4);
    if (IN(5)) { fast_attn(F); refresh_ids(F); naive_mlstm_combine(F); }
#endif
    SEAM(5);
#if FAST_GEMM & 2
    if (IN(6)) { pg8::Gemm g{F.MIX, F.WoT, NTOK, D, D}; pg8::StaticOrder S; S.init(NTOK, D, F.G, (int)blockIdx.x);
        EpiOutproj E{F.in[I_X], F.out, F.A2, F.mod, F.in[I_N2G], F.rowsq1}; pg8::gemm_phase<EpiOutproj, pg8::StaticOrder, true, true>(F.lds, g, S, E, F.tid); }
#else
    if (IN(6)) naive_gemm(F, F.MIX, D, NTOK, F.in[I_WOUT], D, D, D, NaiveOutprojEpi{});
#endif
    SEAM(6);
#if FAST_GEMM & 4
    if (IN(7)) { pg8::Gemm g{F.A2, F.W1T, NTOK, FF, D}; pg8::StaticOrder S; S.init(NTOK, FF, F.G, (int)blockIdx.x);
        EpiFc1 E{F.Hh, F.bias1, F.rowsq1}; pg8::gemm_phase<EpiFc1, pg8::StaticOrder, true, true>(F.lds, g, S, E, F.tid);
        if (DOUBLE_MASK & 128) { __syncthreads(); pg8::gemm_phase<EpiFc1, pg8::StaticOrder, true, true>(F.lds, g, S, E, F.tid); } }
#else
    if (IN(7)) naive_gemm(F, F.A2, D, NTOK, F.in[I_WFC1], FF, FF, D, NaiveFc1Epi{});
#endif
    SEAM(7);
#if FAST_GEMM & 8
    if (IN(8)) { pg8::Gemm g{F.Hh, F.W2T, NTOK, D, FF}; pg8::StaticOrder S; S.init(NTOK, D, F.G, (int)blockIdx.x);
        EpiFc2 E{F.out, F.mod, F.rowsq2}; pg8::gemm_phase<EpiFc2, pg8::StaticOrder, true, true>(F.lds, g, S, E, F.tid); }
#else
    if (IN(8)) naive_gemm(F, F.Hh, FF, NTOK, F.in[I_WFC2], D, D, FF, NaiveFc2Epi{});
#endif
    SEAM(8);
    if (IN(9)) p_final(F);
#undef IN
#undef SEAM
}

extern "C" void kernel_launch(void* const* d_in, const int* in_sizes, int n_in, void* d_out, int out_size, void* d_ws, size_t ws_size, hipStream_t stream) {
    static int grid = 0;
    if (grid == 0) {
        if (n_in != 20 || in_sizes[0] != NTOK * D || out_size != NTOK * D || ws_size < WS_END) { fprintf(stderr, "kernel_launch: unexpected shapes n_in %d in0 %d out %d ws %zu\n", n_in, n_in > 0 ? in_sizes[0] : -1, out_size, ws_size); grid = -1; return; }
        int dev = 0, cus = 0, per_cu = 0;
        if (hipGetDevice(&dev) != hipSuccess || hipDeviceGetAttribute(&cus, hipDeviceAttributeMultiprocessorCount, dev) != hipSuccess) { grid = -1; return; }
        if (hipFuncSetAttribute((const void*)fwd_kernel, hipFuncAttributeMaxDynamicSharedMemorySize, LDS_BYTES) != hipSuccess) { fprintf(stderr, "kernel_launch: hipFuncSetAttribute failed\n"); grid = -1; return; }
        if (hipOccupancyMaxActiveBlocksPerMultiprocessor(&per_cu, (const void*)fwd_kernel, NWAVES * 64, LDS_BYTES) != hipSuccess || per_cu < 1) { fprintf(stderr, "kernel_launch: occupancy query says %d\n", per_cu); per_cu = 1; }
        (void)hipGetLastError();
        grid = cus;
    }
    if (grid < 0) return;
    (void)hipMemsetAsync((char*)d_ws + WS_CTL, 0, CTL_ZERO_BYTES, stream);
    Args a{};
    for (int i = 0; i < 20; ++i) a.in[i] = (const float*)d_in[i];
    a.out = (float*)d_out; a.ws = (unsigned char*)d_ws;
    a.ph_lo = 0; a.ph_hi = NPHASE; a.li = 0;
    hipLaunchKernelGGL(fwd_kernel, dim3(grid), dim3(NWAVES * 64), LDS_BYTES, stream, a);
}
```

```cpp
#include <hip/hip_runtime.h>
#include <cstdio>
#include <cstdint>

constexpr int NB = 4, T = 8192, CT = 256, TK = T + CT, D = 1024, FF = 4096, NH = 4;
constexpr int NTOK = NB * T, NCTX = NB * CT, MROWS = NTOK + NCTX;
constexpr int INC = 3088, INP = 3072;
constexpr float EPS = 1e-6f;
constexpr float LAMBDA_INIT = 0.2f;
constexpr float C2 = 0.125f * 1.4426950408889634f;

constexpr size_t MiB = 1u << 20;
constexpr size_t WS_CTL = 0, CTL_ZERO_BYTES = 1 * MiB;
constexpr size_t WS_ROWSQ1 = 256 * 1024, WS_ROWSQ2 = 384 * 1024;
constexpr size_t WS_KMAX = 128 * 1024;
constexpr size_t WS_MOD = 1 * MiB;
constexpr size_t WS_ROPE = WS_MOD + 128 * 1024;
constexpr size_t WS_BIAS1 = WS_ROPE + 32 * 1024;
constexpr size_t WS_WGT = WS_BIAS1 + 64 * 1024;
constexpr size_t WS_SCL = WS_WGT + 64 * 1024;
constexpr size_t WS_MIN = WS_SCL + 64 * 1024;
constexpr size_t WS_WIN = 2 * MiB, WS_WO = 9 * MiB, WS_W1 = 11 * MiB, WS_W2 = 19 * MiB;
constexpr size_t WS_G = 27 * MiB;
constexpr size_t WS_XM = 32 * MiB;
constexpr size_t WS_Q = 98 * MiB, WS_K = 130 * MiB, WS_V = 163 * MiB, WS_MQ = 196 * MiB, WS_MK = 213 * MiB, WS_MV = 230 * MiB, WS_MO = 263 * MiB;
constexpr size_t WS_DC = 296 * MiB;
constexpr size_t WS_CIN = 430 * MiB;
constexpr size_t WS_MIX = 296 * MiB + 0;
constexpr size_t WS_H = 98 * MiB;
constexpr size_t WS_END = 512 * MiB;

typedef unsigned short bf16;
typedef unsigned v4u __attribute__((ext_vector_type(4)));
typedef unsigned v2u __attribute__((ext_vector_type(2)));
typedef float f32x4 __attribute__((ext_vector_type(4)));
typedef float f32x2 __attribute__((ext_vector_type(2)));
#define LAS __attribute__((address_space(3)))

__device__ __forceinline__ unsigned f2bf(float f) { unsigned u = __builtin_bit_cast(unsigned, f); return (u + 0x7fffu + ((u >> 16) & 1u)) >> 16; }
__device__ __forceinline__ unsigned pk2(float lo, float hi) { return f2bf(lo) | (f2bf(hi) << 16); }
__device__ __forceinline__ float bf2f(unsigned short b) { return __builtin_bit_cast(float, (unsigned)b << 16); }
__device__ __forceinline__ float bflo(unsigned w) { return __builtin_bit_cast(float, w << 16); }
__device__ __forceinline__ float bfhi(unsigned w) { return __builtin_bit_cast(float, w & 0xffff0000u); }
__device__ __forceinline__ float wave_sum(float v) {
#pragma unroll
    for (int o = 1; o < 64; o <<= 1) v += __shfl_xor(v, o);
    return v;
}
__device__ __forceinline__ float wave_max(float v) {
#pragma unroll
    for (int o = 1; o < 64; o <<= 1) v = fmaxf(v, __shfl_xor(v, o));
    return v;
}

#ifndef DOUBLE_MASK
#define DOUBLE_MASK 0
#endif
#ifndef FAST_MLSTM
#define FAST_MLSTM 1
#endif
#ifndef FAST_ATTN
#define FAST_ATTN 1
#endif
#ifndef FAST_GEMM
#define FAST_GEMM 15
#endif
__device__ __forceinline__ int lane_id() { return (int)__builtin_amdgcn_mbcnt_hi(~0u, __builtin_amdgcn_mbcnt_lo(~0u, 0u)); }
constexpr int NWAVES = 8;
constexpr int LDS_BYTES = 147456;

struct Args {
    const float* in[20]; float* out; unsigned char* ws; int ph_lo, ph_hi, li, pad;
};
enum { I_X = 0, I_C, I_CTX, I_CCTX, I_WADA, I_BADA, I_N1G, I_N2G, I_WIN, I_BGATE, I_LQ1, I_LK1, I_LQ2, I_LK2, I_SUBLN, I_MLNG, I_WOUT, I_WFC1, I_WFC2, I_FING };

struct Frame {
    LAS unsigned char* lds;
    int tid, lane, wave, vcu, G;
    const float* in[20]; float* out; unsigned char* ws;
    float* mod; f32x2* rope; float* bias1; float* wgt; float* gates; float* rowsq1; float* rowsq2;
    bf16 *WinT, *WoT, *W1T, *W2T, *XM, *Qd, *Kd, *Vd, *MQ, *MK, *MV, *MO, *MIX, *A2, *Hh;
    float *HF, *HB;
};

__device__ __forceinline__ void refresh_ids(Frame& F) { int l = (int)__builtin_amdgcn_mbcnt_hi(~0u, __builtin_amdgcn_mbcnt_lo(~0u, 0u)); asm volatile("" : "+v"(l)); F.lane = l; F.tid = F.wave * 64 + l; }

__device__ __forceinline__ void gemv_item(Frame& F, const LAS float* a, int R, const float* W, int ldw, int col0, const float* bias, float* out, int ldo, LAS float* red) {
    const int w = F.wave, lane = F.lane, c = lane & 31, kp = lane >> 5;
    float acc[5] = {0.f, 0.f, 0.f, 0.f, 0.f};
    const float* wp = W + (size_t)(128 * w + kp) * ldw + col0 + c;
#pragma unroll 8
    for (int kk = 0; kk < 64; ++kk) {
        const float wv = wp[(size_t)(2 * kk) * ldw];
        const int k = 128 * w + 2 * kk + kp;
#pragma unroll
        for (int r = 0; r < 5; ++r) if (r < R) acc[r] += a[r * 1024 + k] * wv;
    }
#pragma unroll
    for (int r = 0; r < 5; ++r) acc[r] += __shfl_xor(acc[r], 32);
    if (lane < 32) {
#pragma unroll
        for (int r = 0; r < 5; ++r) red[(w * 5 + r) * 32 + lane] = acc[r];
    }
    __syncthreads();
    if (F.tid < R * 32) {
        const int r = F.tid >> 5, cc = F.tid & 31; float s = 0.f;
#pragma unroll
        for (int ww = 0; ww < 8; ++ww) s += red[(ww * 5 + r) * 32 + cc];
        out[(size_t)r * ldo + col0 + cc] = s + (bias ? bias[col0 + cc] : 0.f);
    }
    __syncthreads();
}

__device__ __forceinline__ void p0_transpose_item(const float* W, int K, int ldw, int nblk, bf16* WT, LAS float* scr, int item, int lane) {
    const int kb = item / nblk, nb = item % nblk, k0 = 64 * kb, n0 = 32 * nb;
#pragma unroll 8
    for (int i = 0; i < 32; ++i) { const int kk = 2 * i + (lane >> 5); scr[kk * 33 + (lane & 31)] = W[(size_t)(k0 + kk) * ldw + n0 + (lane & 31)]; }
    asm volatile("s_waitcnt lgkmcnt(0)" ::: "memory");
    const int c = lane & 7;
#pragma unroll
    for (int j = 0; j < 4; ++j) { const int n = (lane >> 3) + 8 * j; const LAS float* s = scr + (8 * c) * 33 + n;
        v4u o; o.x = pk2(s[0 * 33], s[1 * 33]); o.y = pk2(s[2 * 33], s[3 * 33]); o.z = pk2(s[4 * 33], s[5 * 33]); o.w = pk2(s[6 * 33], s[7 * 33]);
        *(v4u*)(WT + (size_t)(n0 + n) * K + k0 + 8 * c) = o; }
    asm volatile("s_waitcnt lgkmcnt(0)" ::: "memory");
}

__device__ __forceinline__ void p0_prologue(Frame& F) {
    LAS float* sa = (LAS float*)F.lds;
    LAS float* red = sa + 5 * 1024;
    for (int i = F.tid; i < 5 * 1024; i += 512) { const int r = i >> 10, k = i & 1023; const float c = r < 4 ? F.in[I_C][r * 1024 + k] : F.in[I_CCTX][k]; sa[i] = c / (1.f + __expf(-c)); }
    __syncthreads();
    for (int item = F.vcu; item < 192; item += F.G) gemv_item(F, sa, 5, F.in[I_WADA], 6 * D, item * 32, F.in[I_BADA], F.mod, 6 * D, red);
    LAS float* scr = (LAS float*)(F.lds + 32768 + F.wave * 8448);
    const int gw = F.vcu * NWAVES + F.wave, NGW = F.G * NWAVES;
    constexpr int I_IN = (D / 64) * (INP / 32), I_O = (D / 64) * (D / 32), I_1 = (D / 64) * (FF / 32), I_2 = (FF / 64) * (D / 32);
    for (int it = gw; it < I_IN + I_O + I_1 + I_2; it += NGW) {
        int r = it;
        if (r < I_IN) { p0_transpose_item(F.in[I_WIN], D, INC, INP / 32, F.WinT, scr, r, F.lane); continue; } r -= I_IN;
        if (r < I_O) { p0_transpose_item(F.in[I_WOUT], D, D, D / 32, F.WoT, scr, r, F.lane); continue; } r -= I_O;
        if (r < I_1) { p0_transpose_item(F.in[I_WFC1], D, FF, FF / 32, F.W1T, scr, r, F.lane); continue; } r -= I_1;
        p0_transpose_item(F.in[I_WFC2], FF, D, D / 32, F.W2T, scr, r, F.lane);
    }
    const int gt = F.vcu * 512 + F.tid, NGT = F.G * 512;
    for (int idx = gt; idx < 192 * 16; idx += NGT) {
        const int p = idx >> 4, j = idx & 15; const int pos = p < 128 ? p : p - 128;
        double inv = 1.0; for (int q = 0; q < j; ++q) inv *= 0.5623413251903491;
        const float ang = (float)pos * (float)inv;
        double a = (double)ang; const double TWO_PI = 6.283185307179586476925;
        const double n = __builtin_rint(a / TWO_PI); a -= n * TWO_PI;
        const double a2 = a * a; double sn = 0.0, cs = 0.0, ts = a, tc = 1.0;
        for (int q = 0; q < 14; ++q) { sn += ts; cs += tc; tc = -tc * a2 / (double)((2 * q + 1) * (2 * q + 2)); ts = -ts * a2 / (double)((2 * q + 2) * (2 * q + 3)); }
        F.rope[idx] = (f32x2){(float)cs, (float)sn};
    }
    for (int idx = gt; idx < 16 * 1024; idx += NGT) { const int g = idx >> 10, k = idx & 1023; F.wgt[idx] = F.in[I_WIN][(size_t)k * INC + INP + g]; }
}

__device__ __forceinline__ float log_sigmoid(float x) { return fminf(x, 0.f) - log1pf(__expf(-fabsf(x))); }
__device__ __forceinline__ void p1_rows(Frame& F) {
    LAS float* wg = (LAS float*)F.lds;
    LAS float* sa = (LAS float*)(F.lds + 65536);
    LAS float* red = (LAS float*)(F.lds + 65536 + 16384);
    for (int i = F.tid; i < 16 * 1024; i += 512) wg[i] = F.wgt[i];
    for (int i = F.tid; i < 4 * 1024; i += 512) sa[i] = F.mod[(i >> 10) * 6 * D + 3 * D + (i & 1023)];
    __syncthreads();
    for (int item = F.vcu; item < 128; item += F.G) gemv_item(F, sa, 4, F.in[I_WFC1], FF, item * 32, nullptr, F.bias1, FF, red);
    const int gw = F.vcu * NWAVES + F.wave, NGW = F.G * NWAVES, lane = F.lane;
    const float* g1n = F.in[I_N1G];
    f32x4 vn[4];
    if (gw < MROWS) { const float* src = gw < NTOK ? F.in[I_X] + (size_t)gw * D : F.in[I_CTX] + (size_t)(gw - NTOK) * D;
#pragma unroll
        for (int j = 0; j < 4; ++j) vn[j] = *(const f32x4*)(src + 4 * lane + 256 * j); }
    for (int row = gw; row < MROWS; row += NGW) {
        const bool lat = row < NTOK; const int b5 = lat ? (row >> 13) : 4;
        const float* modr = F.mod + (size_t)b5 * 6 * D;
        f32x4 v[4]; float ss = 0.f;
#pragma unroll
        for (int j = 0; j < 4; ++j) { v[j] = vn[j]; ss += (v[j].x * v[j].x + v[j].y * v[j].y) + (v[j].z * v[j].z + v[j].w * v[j].w); }
        { const int nrow = row + NGW;
          if (nrow < MROWS) { const float* src = nrow < NTOK ? F.in[I_X] + (size_t)nrow * D : F.in[I_CTX] + (size_t)(nrow - NTOK) * D;
#pragma unroll
            for (int j = 0; j < 4; ++j) vn[j] = *(const f32x4*)(src + 4 * lane + 256 * j); } }
        const float rstd = 1.0f / sqrtf(wave_sum(ss) * (1.f / D) + EPS);
        float acc[16]; f32x4 xm[4];
#pragma unroll
        for (int j = 0; j < 4; ++j) {
            const int col = 4 * lane + 256 * j;
            const f32x4 gg = *(const f32x4*)(g1n + col), sc = *(const f32x4*)(modr + D + col), sh = *(const f32x4*)(modr + col);
            xm[j] = (v[j] * rstd) * gg * (sc + 1.0f) + sh;
            v2u o; o.x = pk2(xm[j].x, xm[j].y); o.y = pk2(xm[j].z, xm[j].w);
            *(v2u*)(F.XM + (size_t)row * D + col) = o;
        }
#pragma unroll
        for (int g = 0; g < 16; ++g) {
            float a = 0.f;
#pragma unroll
            for (int j = 0; j < 4; ++j) { const f32x4 w = *(const LAS f32x4*)(wg + g * 1024 + 4 * lane + 256 * j); a += (xm[j].x * w.x + xm[j].y * w.y) + (xm[j].z * w.z + xm[j].w * w.w); }
            acc[g] = a;
            asm volatile("" ::: "memory");
        }
#pragma unroll
        for (int i = 0; i < 8; ++i) { const bool hi = lane & 32; const float mine = hi ? acc[i + 8] : acc[i], send = hi ? acc[i] : acc[i + 8]; acc[i] = mine + __shfl_xor(send, 32); }
#pragma unroll
        for (int i = 0; i < 4; ++i) { const bool hi = lane & 16; const float mine = hi ? acc[i + 4] : acc[i], send = hi ? acc[i] : acc[i + 4]; acc[i] = mine + __shfl_xor(send, 16); }
#pragma unroll
        for (int i = 0; i < 2; ++i) { const bool hi = lane & 8; const float mine = hi ? acc[i + 2] : acc[i], send = hi ? acc[i] : acc[i + 2]; acc[i] = mine + __shfl_xor(send, 8); }
        { const bool hi = lane & 4; const float mine = hi ? acc[1] : acc[0], send = hi ? acc[0] : acc[1]; acc[0] = mine + __shfl_xor(send, 4); }
        acc[0] += __shfl_xor(acc[0], 2); acc[0] += __shfl_xor(acc[0], 1);
        if ((lane & 3) == 0) {
            const int g = ((lane >> 5) & 1) * 8 + ((lane >> 4) & 1) * 4 + ((lane >> 3) & 1) * 2 + ((lane >> 2) & 1);
            const float val = acc[0] + F.in[I_BGATE][g]; const int type = g >> 2, h = g & 3;
            const float o = (type & 1) ? log_sigmoid(val) : val;
            const int b = lat ? (row >> 13) : ((row - NTOK) >> 8), kidx = lat ? (CT + (row & (T - 1))) : ((row - NTOK) & (CT - 1));
            F.gates[((size_t)(b * NH + h) * TK + kidx) * 4 + type] = o;
        }
    }
}

template <class Epi>
__device__ __forceinline__ void naive_gemm(Frame& F, const bf16* A, int lda, int M, const float* W, int ldw, int N, int K, const Epi& E) {
    LAS float* As = (LAS float*)F.lds;
    LAS float* Ws = As + 16 * 132;
    LAS float* Ct = (LAS float*)(F.lds + 32768);
    const int tid = F.tid, ty = tid >> 4, tx = tid & 15;
    const int tn_n = N / 128, ntiles = (M / 128) * tn_n;
    for (int tile = F.vcu; tile < ntiles; tile += F.G) {
        const int tm = tile / tn_n, tn = tile % tn_n;
        float acc[4][8];
#pragma unroll
        for (int i = 0; i < 4; ++i)
#pragma unroll
            for (int j = 0; j < 8; ++j) acc[i][j] = 0.f;
        const int ar = tid >> 2, ak = (tid & 3) * 4, wk = tid >> 5, wn = (tid & 31) * 4;
        const bf16* ap = A + (size_t)(tm * 128 + ar) * lda + ak;
        const float* wp = W + (size_t)wk * ldw + tn * 128 + wn;
        for (int k0 = 0; k0 < K; k0 += 16) {
            const v2u av = *(const v2u*)(ap + k0);
            const f32x4 wv = *(const f32x4*)(wp + (size_t)k0 * ldw);
            As[(ak + 0) * 132 + ar] = bflo(av.x); As[(ak + 1) * 132 + ar] = bfhi(av.x); As[(ak + 2) * 132 + ar] = bflo(av.y); As[(ak + 3) * 132 + ar] = bfhi(av.y);
            *(LAS f32x4*)(Ws + wk * 128 + wn) = wv;
            __syncthreads();
#pragma unroll
            for (int kk = 0; kk < 16; ++kk) {
                const f32x4 a = *(const LAS f32x4*)(As + kk * 132 + ty * 4);
                const f32x4 w0 = *(const LAS f32x4*)(Ws + kk * 128 + tx * 8), w1 = *(const LAS f32x4*)(Ws + kk * 128 + tx * 8 + 4);
                const float aa[4] = {a.x, a.y, a.z, a.w}; const float ww[8] = {w0.x, w0.y, w0.z, w0.w, w1.x, w1.y, w1.z, w1.w};
#pragma unroll
                for (int i = 0; i < 4; ++i)
#pragma unroll
                    for (int j = 0; j < 8; ++j) acc[i][j] += aa[i] * ww[j];
            }
            __syncthreads();
        }
#pragma unroll
        for (int i = 0; i < 4; ++i)
#pragma unroll
            for (int j = 0; j < 8; ++j) Ct[(ty * 4 + i) * 129 + tx * 8 + j] = acc[i][j];
        __syncthreads();
        E.tile(F, Ct, tm * 128, tn * 128);
        __syncthreads();
    }
}

__device__ __forceinline__ void row_decode(int row, bool& lat, int& b, int& t, int& kidx) {
    lat = row < NTOK;
    if (lat) { b = row >> 13; t = row & (T - 1); kidx = CT + t; } else { const int j = row - NTOK; b = j >> 8; t = -1; kidx = j & (CT - 1); }
}

struct NaiveInprojEpi {
    __device__ __forceinline__ void tile(Frame& F, const LAS float* Ct, int row0, int col0) const {
        for (int idx = F.tid; idx < 128 * 128; idx += 512) {
            const int r = idx >> 7, c = idx & 127, row = row0 + r, col = col0 + c;
            bool lat; int b, t, kidx; row_decode(row, lat, b, t, kidx);
            float val = Ct[r * 129 + c];
            if (col < 1024) {
                const bool isq = col < 512; const int cc = col & 511, h = cc >> 7, within = cc & 127, i = within & 63;
                if (isq && !lat) continue;
                if (lat) {
                    const bool lowhalf = (i & 31) < 16; const float partner = Ct[r * 129 + (lowhalf ? c + 16 : c - 16)];
                    const int pos = (i < 32) ? (t >> 6) : (128 + (t & 63)); const f32x2 cs = F.rope[pos * 16 + (i & 15)];
                    val = val * cs.x + (lowhalf ? -partner : partner) * cs.y;
                }
                if (isq) F.Qd[((size_t)(b * NH + h) * T + t) * 128 + within] = (bf16)f2bf(val * C2);
                else F.Kd[((size_t)(b * NH + h) * TK + kidx) * 128 + within] = (bf16)f2bf(val);
            } else if (col < 1536) { const int cc = col - 1024, h = cc >> 7, within = cc & 127; F.Vd[((size_t)(b * NH + h) * TK + kidx) * 128 + within] = (bf16)f2bf(val);
            } else if (col < 1792) { const int cc = col - 1536, h = cc >> 6, i = cc & 63; F.MQ[((size_t)(b * NH + h) * TK + kidx) * 64 + i] = (bf16)f2bf(val);
            } else if (col < 2048) { const int cc = col - 1792, h = cc >> 6, i = cc & 63; F.MK[((size_t)(b * NH + h) * TK + kidx) * 64 + i] = (bf16)f2bf(val * 0.125f);
            } else if (col < 2560) { const int cc = col - 2048, h = cc >> 7, within = cc & 127; F.MV[((size_t)(b * NH + h) * TK + kidx) * 128 + within] = (bf16)f2bf(val);
            } else { if (!lat) continue; F.MO[(size_t)row * 512 + (col - 2560)] = (bf16)f2bf(1.f / (1.f + __expf(-val))); }
        }
    }
};
struct NaiveOutprojEpi {
    __device__ __forceinline__ void tile(Frame& F, const LAS float* Ct, int row0, int col0) const {
        for (int rr = 0; rr < 16; ++rr) {
            const int r = F.wave * 16 + rr, row = row0 + r, b = row >> 13; const float* modr = F.mod + (size_t)b * 6 * D;
            float ss = 0.f;
#pragma unroll
            for (int e = 0; e < 2; ++e) { const int c = F.lane + 64 * e, col = col0 + c;
                const float x1 = F.in[I_X][(size_t)row * D + col] + modr[2 * D + col] * Ct[r * 129 + c];
                F.out[(size_t)row * D + col] = x1; ss += x1 * x1;
                F.A2[(size_t)row * D + col] = (bf16)f2bf(x1 * F.in[I_N2G][col] * (1.f + modr[4 * D + col])); }
            ss = wave_sum(ss); if (F.lane == 0) atomicAdd(F.rowsq1 + row, ss);
        }
    }
};
struct NaiveFc1Epi {
    __device__ __forceinline__ void tile(Frame& F, const LAS float* Ct, int row0, int col0) const {
        for (int idx = F.tid; idx < 128 * 128; idx += 512) {
            const int r = idx >> 7, c = idx & 127, row = row0 + r, col = col0 + c, b = row >> 13;
            const float rstd = 1.0f / sqrtf(F.rowsq1[row] * (1.f / D) + EPS);
            float v = rstd * Ct[r * 129 + c] + F.bias1[b * FF + col]; v = fmaxf(v, 0.f);
            F.Hh[(size_t)row * FF + col] = (bf16)f2bf(v * v);
        }
    }
};
struct NaiveFc2Epi {
    __device__ __forceinline__ void tile(Frame& F, const LAS float* Ct, int row0, int col0) const {
        for (int rr = 0; rr < 16; ++rr) {
            const int r = F.wave * 16 + rr, row = row0 + r, b = row >> 13; const float* modr = F.mod + (size_t)b * 6 * D;
            float ss = 0.f;
#pragma unroll
            for (int e = 0; e < 2; ++e) { const int c = F.lane + 64 * e, col = col0 + c;
                const float x2 = F.out[(size_t)row * D + col] + modr[5 * D + col] * Ct[r * 129 + c];
                F.out[(size_t)row * D + col] = x2; ss += x2 * x2; }
            ss = wave_sum(ss); if (F.lane == 0) atomicAdd(F.rowsq2 + row, ss);
        }
    }
};


namespace pg8 {
#define PG8_LAS __attribute__((address_space(3)))
typedef unsigned short bf16_t;
typedef short bf16x8 __attribute__((ext_vector_type(8)));
typedef float f32x4 __attribute__((ext_vector_type(4)));
typedef unsigned u32x4 __attribute__((ext_vector_type(4)));
constexpr int BM = 256, BK = 64, HALF = 128, HTB = HALF * BK * 2  , STAGE_BYTES = 8 * HTB, NXCD = 8, WGM = 8;

__host__ __device__ __forceinline__ int lds_byte(int r, int c) { const int st = (r >> 4) * 2 + (c >> 5), rr = r & 15, cc = c & 31, ob = rr * 64 + cc * 2; return st * 1024 + (ob ^ (((ob >> 9) & 1) << 5)); }
__host__ __device__ __forceinline__ void stage_rc(int b, int& R, int& C) { const int st = b / 1024, sb = b % 1024, swz = sb ^ (((sb >> 9) & 1) << 5); R = (st >> 1) * 16 + swz / 64; C = (st & 1) * 32 + (swz % 64) / 2; }
__host__ __device__ __forceinline__ int perm32(int rho) { const int n = rho >> 4, i = rho & 15; return 8 * (i >> 2) + 4 * n + (i & 3); }

struct Unit { int pm, pn; };
struct Gemm { const bf16_t* A; const bf16_t* Bt; int M, N, K; };

struct StaticOrder {
    int nM, nN, nwg, G, c;
    __host__ __device__ void init(int M, int N, int G_, int c_) { nM = M / BM; nN = N / BM; nwg = nM * nN; G = G_; c = c_; }
    __host__ __device__ bool next(int i, Unit& u) const {
        const long L = (long)i * G + c; if (L >= nwg) return false;
        int wgid = (int)L; { const int q = nwg / NXCD, r = nwg % NXCD, xcd = wgid % NXCD, off = wgid / NXCD; wgid = (xcd < r ? xcd * (q + 1) : r * (q + 1) + (xcd - r) * q) + off; }
        const int nig = WGM * nN, gid = wgid / nig, fm = gid * WGM, gsz = (nM - fm) < WGM ? (nM - fm) : WGM;
        u.pm = fm + ((wgid % nig) % gsz); u.pn = (wgid % nig) / gsz; return true;
    }
    __device__ __forceinline__ void a_ready(const Unit&) const {}
    __device__ __forceinline__ void done(const Unit&) const {}
};

__device__ __forceinline__ unsigned cvt_pk_bf16(float lo, float hi) { unsigned r; asm volatile("v_cvt_pk_bf16_f32 %0, %1, %2" : "=v"(r) : "v"(lo), "v"(hi)); return r; }
template <class Epi, class Sched, bool ALIGN_EPI = false, bool SP2 = false>
__device__ __forceinline__ void gemm_phase(PG8_LAS unsigned char* lds, const Gemm g, const Sched& S, const Epi& E, const int tid) {
    const int wid = __builtin_amdgcn_readfirstlane(tid >> 6), lane = tid & 63, wr = wid >> 2, wc = wid & 3, fr = lane & 15, fq = lane >> 4;
    const int K = g.K, nt = K / BK;
    unsigned voffA[2], voffB[2];
#pragma unroll
    for (int i = 0; i < 2; ++i) { int R, C; stage_rc(tid * 16 + i * 8192, R, C); const int Rb = Epi::PERM ? ((R & ~31) + perm32(R & 31)) : R;
        voffA[i] = (unsigned)(R * K + C) * 2u; voffB[i] = (unsigned)(Rb * K + C) * 2u; }
    const size_t kstep = (size_t)(BK * 2);
    const size_t hstep = (size_t)HALF * K * 2;
    const size_t tstep = 2 * hstep;
    const unsigned ldsw = (unsigned)wid * 1024u;
    const int aoff = lds_byte(wr * 64 + fr, fq * 8), boff = lds_byte(wc * 32 + fr, fq * 8);
#define PG8_SA(b, h) (((b) * 2 + (h)) * HTB)
#define PG8_SB(b, h) ((4 + (b) * 2 + (h)) * HTB)
#define PG8_STAGE(bufoff, gbase, voff) do { _Pragma("unroll") for (int _i = 0; _i < 2; ++_i) \
        __builtin_amdgcn_global_load_lds((const unsigned*)((const char*)(gbase) + (voff)[_i]), (PG8_LAS unsigned*)(lds + (bufoff) + ldsw + _i * 8192), 16, 0, 0); } while (0)
#define PG8_LDA(dst, b, h) do { _Pragma("unroll") for (int m = 0; m < 4; ++m) _Pragma("unroll") for (int k = 0; k < 2; ++k) dst[m][k] = *(const PG8_LAS bf16x8*)(lds + PG8_SA(b, h) + aoff + m * 2048 + k * 1024); } while (0)
#define PG8_LDB(dst, b, h) do { _Pragma("unroll") for (int n = 0; n < 2; ++n) _Pragma("unroll") for (int k = 0; k < 2; ++k) dst[n][k] = *(const PG8_LAS bf16x8*)(lds + PG8_SB(b, h) + boff + n * 2048 + k * 1024); } while (0)
#define PG8_MMA(ai, bj, At, Bt) do { __builtin_amdgcn_s_setprio(1); _Pragma("unroll") for (int m = 0; m < 4; ++m) _Pragma("unroll") for (int n = 0; n < 2; ++n) _Pragma("unroll") for (int k = 0; k < 2; ++k) \
        acc[ai][bj][m][n] = __builtin_amdgcn_mfma_f32_16x16x32_bf16(Bt[n][k], At[m][k], acc[ai][bj][m][n], 0, 0, 0); __builtin_amdgcn_s_setprio(0); } while (0)
#define PG8_WAIT_V(n) asm volatile("s_waitcnt vmcnt(" #n ")" ::: "memory")
#define PG8_WAIT_L(n) asm volatile("s_waitcnt lgkmcnt(" #n ")" ::: "memory")
#define PG8_BAR __builtin_amdgcn_s_barrier()
#define PG8_SCHED __builtin_amdgcn_sched_barrier(0)
    Unit cur, nxt; int ui = 0;
    if (!S.next(0, cur)) return;
    f32x4 acc[2][2][4][2];
#pragma unroll
    for (int a = 0; a < 2; ++a)
#pragma unroll
        for (int b = 0; b < 2; ++b)
#pragma unroll
            for (int m = 0; m < 4; ++m)
#pragma unroll
                for (int n = 0; n < 2; ++n) acc[a][b][m][n] = (f32x4){0.f, 0.f, 0.f, 0.f};
    bf16x8 At[4][2], B0[2][2], B1[2][2];
    const char* cA = (const char*)g.A + (size_t)cur.pm * tstep; const char* cB = (const char*)g.Bt + (size_t)cur.pn * tstep;
    S.a_ready(cur);
    if constexpr (SP2) {
        PG8_STAGE(PG8_SB(0, 0), cB, voffB); PG8_STAGE(PG8_SB(0, 1), cB + hstep, voffB); PG8_STAGE(PG8_SA(0, 0), cA, voffA); PG8_STAGE(PG8_SA(0, 1), cA + hstep, voffA);
        if (wr == 1) PG8_BAR;
        PG8_WAIT_V(2); PG8_BAR;
        PG8_STAGE(PG8_SB(1, 0), cB + kstep, voffB); PG8_STAGE(PG8_SA(1, 0), cA + kstep, voffA); PG8_STAGE(PG8_SB(1, 1), cB + hstep + kstep, voffB);
        PG8_WAIT_V(6); PG8_BAR;
    } else {
        PG8_STAGE(PG8_SB(0, 0), cB, voffB); PG8_STAGE(PG8_SA(0, 0), cA, voffA); PG8_STAGE(PG8_SB(0, 1), cB + hstep, voffB); PG8_STAGE(PG8_SA(0, 1), cA + hstep, voffA);
        if (wr == 1) PG8_BAR;
        PG8_WAIT_V(4); PG8_BAR;
        PG8_STAGE(PG8_SB(1, 0), cB + kstep, voffB); PG8_STAGE(PG8_SA(1, 0), cA + kstep, voffA); PG8_STAGE(PG8_SB(1, 1), cB + hstep + kstep, voffB);
        PG8_WAIT_V(6); PG8_BAR;
    }
    for (;;) {
        const bool has_next = S.next(ui + 1, nxt);
        const char* nA = has_next ? (const char*)g.A + (size_t)nxt.pm * tstep : cA; const char* nB = has_next ? (const char*)g.Bt + (size_t)nxt.pn * tstep : cB;
        for (int t = 0; t < nt; t += 2) {
            const bool last = (t == nt - 2);
            const char* a1 = cA + (size_t)(t + 1) * kstep;
            const char* a2 = last ? nA : cA + (size_t)(t + 2) * kstep; const char* b2 = last ? nB : cB + (size_t)(t + 2) * kstep;
            const char* a3 = a2 + kstep; const char* b3 = b2 + kstep;
            if (last && has_next) S.a_ready(nxt);
            if constexpr (SP2) {
            PG8_LDB(B0, 0, 0); PG8_LDB(B1, 0, 1); PG8_SCHED; PG8_LDA(At, 0, 0); PG8_STAGE(PG8_SA(1, 1), a1 + hstep, voffA);
            PG8_WAIT_V(8); PG8_WAIT_L(0); PG8_BAR; PG8_MMA(0, 0, At, B0); PG8_MMA(0, 1, At, B1); PG8_BAR; PG8_SCHED;
            PG8_LDA(At, 0, 1); PG8_STAGE(PG8_SB(0, 0), b2, voffB); PG8_STAGE(PG8_SB(0, 1), b2 + hstep, voffB); PG8_STAGE(PG8_SA(0, 0), a2, voffA);
            PG8_WAIT_V(8); PG8_WAIT_L(0); PG8_BAR; PG8_MMA(1, 0, At, B0); PG8_MMA(1, 1, At, B1); PG8_BAR; PG8_SCHED;
            PG8_LDB(B0, 1, 0); PG8_LDB(B1, 1, 1); PG8_SCHED; PG8_LDA(At, 1, 0); PG8_STAGE(PG8_SA(0, 1), a2 + hstep, voffA);
            PG8_WAIT_V(8); PG8_WAIT_L(0); PG8_BAR; PG8_MMA(0, 0, At, B0); PG8_MMA(0, 1, At, B1); PG8_BAR; PG8_SCHED;
            PG8_LDA(At, 1, 1); PG8_STAGE(PG8_SB(1, 0), b3, voffB); PG8_STAGE(PG8_SB(1, 1), b3 + hstep, voffB); PG8_STAGE(PG8_SA(1, 0), a3, voffA);
            PG8_WAIT_V(8); PG8_WAIT_L(0); PG8_BAR; PG8_MMA(1, 0, At, B0); PG8_MMA(1, 1, At, B1); PG8_BAR; PG8_SCHED;
            } else {
            PG8_LDB(B0, 0, 0); PG8_SCHED; PG8_LDA(At, 0, 0); PG8_STAGE(PG8_SA(1, 1), a1 + hstep, voffA);
            PG8_WAIT_L(8); PG8_BAR; PG8_WAIT_L(0); PG8_MMA(0, 0, At, B0); PG8_BAR; PG8_SCHED;
            PG8_LDB(B1, 0, 1); PG8_STAGE(PG8_SB(0, 0), b2, voffB);
            PG8_BAR; PG8_WAIT_L(0); PG8_MMA(0, 1, At, B1); PG8_BAR;
            PG8_LDA(At, 0, 1); PG8_STAGE(PG8_SA(0, 0), a2, voffA);
            PG8_BAR; PG8_WAIT_L(0); PG8_MMA(1, 0, At, B0); PG8_BAR; PG8_SCHED;
            PG8_STAGE(PG8_SB(0, 1), b2 + hstep, voffB);
            PG8_WAIT_V(6); PG8_BAR; PG8_MMA(1, 1, At, B1); PG8_BAR;
            PG8_LDB(B0, 1, 0); PG8_SCHED; PG8_LDA(At, 1, 0); PG8_STAGE(PG8_SA(0, 1), a2 + hstep, voffA);
            PG8_WAIT_L(8); PG8_BAR; PG8_WAIT_L(0); PG8_MMA(0, 0, At, B0); PG8_BAR; PG8_SCHED;
            PG8_LDB(B1, 1, 1); PG8_STAGE(PG8_SB(1, 0), b3, voffB);
            PG8_BAR; PG8_WAIT_L(0); PG8_MMA(0, 1, At, B1); PG8_BAR;
            PG8_LDA(At, 1, 1); PG8_STAGE(PG8_SA(1, 0), a3, voffA);
            PG8_BAR; PG8_WAIT_L(0); PG8_MMA(1, 0, At, B0); PG8_BAR; PG8_SCHED;
            PG8_STAGE(PG8_SB(1, 1), b3 + hstep, voffB);
            PG8_WAIT_V(6); PG8_BAR; PG8_MMA(1, 1, At, B1); PG8_BAR;
            }
        }
        if constexpr (ALIGN_EPI) { if (wr == 0) PG8_BAR; }
        if constexpr (!Epi::AFTER_DRAIN) { E(acc, cur, wr, wc, fr, fq); S.done(cur); }
        if (!has_next) break;
#pragma unroll
        for (int a = 0; a < 2; ++a)
#pragma unroll
            for (int b = 0; b < 2; ++b)
#pragma unroll
                for (int m = 0; m < 4; ++m)
#pragma unroll
                    for (int n = 0; n < 2; ++n) acc[a][b][m][n] = (f32x4){0.f, 0.f, 0.f, 0.f};
        cur = nxt; cA = nA; cB = nB; ++ui;
        if constexpr (ALIGN_EPI) { if (wr == 1) PG8_BAR; }
    }
    PG8_WAIT_V(0);
    if constexpr (!ALIGN_EPI) { if (wr == 0) PG8_BAR; }
    PG8_BAR;
    if constexpr (Epi::AFTER_DRAIN) { E.fused(acc, cur, wr, wc, fr, fq, lds, wid, lane); S.done(cur); }
#undef PG8_SA
#undef PG8_SB
#undef PG8_STAGE
#undef PG8_LDA
#undef PG8_LDB
#undef PG8_MMA
#undef PG8_WAIT_V
#undef PG8_WAIT_L
#undef PG8_BAR
#undef PG8_SCHED
}
}

__device__ __forceinline__ v4u pack8(const f32x4& a, const f32x4& b) { v4u w; w.x = pg8::cvt_pk_bf16(a[0], a[1]); w.y = pg8::cvt_pk_bf16(a[2], a[3]); w.z = pg8::cvt_pk_bf16(b[0], b[1]); w.w = pg8::cvt_pk_bf16(b[2], b[3]); return w; }
struct EpiInproj {
    static constexpr bool PERM = true, AFTER_DRAIN = false;
    bf16 *Qd, *Kd, *Vd, *MQ, *MK, *MV, *MO; const f32x2* rope;
    __device__ __forceinline__ void operator()(const f32x4 (&acc)[2][2][4][2], const pg8::Unit& u, int wr, int wc, int fr, int fq) const {
        const int pn = u.pn; const bool lat = u.pm < 128;
        if (!lat && (pn < 2 || pn >= 10)) return;
        const int b = lat ? (u.pm >> 5) : (u.pm - 128);
        const int tbase = lat ? ((u.pm & 31) * 256) : 0;
        const int within0 = wc * 32 + fq * 8;
        if (pn < 4) {
            const bool isq = pn < 2; const int hb = (pn & 1) * 2; const bool rowaxis = (wc & 1) == 0, low = fq < 2; const int j0 = (fq & 1) * 8;
#pragma unroll
            for (int ai = 0; ai < 2; ++ai)
#pragma unroll
                for (int m = 0; m < 4; ++m) {
                    const int rloc = ai * 128 + wr * 64 + m * 16 + fr, t = tbase + rloc;
                    f32x4 cs[4];
                    if (lat) { const int pos = rowaxis ? (t >> 6) : (128 + (t & 63)); const f32x4* rp = (const f32x4*)(rope + pos * 16 + j0);
#pragma unroll
                        for (int q = 0; q < 4; ++q) cs[q] = rp[q]; }
#pragma unroll
                    for (int bj = 0; bj < 2; ++bj) {
                        f32x4 v0 = acc[ai][bj][m][0], v1 = acc[ai][bj][m][1];
                        if (lat) {
                            f32x4 p0, p1;
#pragma unroll
                            for (int e = 0; e < 4; ++e) { p0[e] = __shfl_xor(v0[e], 32); p1[e] = __shfl_xor(v1[e], 32); }
                            if (low) { p0 = -p0; p1 = -p1; }
                            v0[0] = v0[0] * cs[0][0] + p0[0] * cs[0][1]; v0[1] = v0[1] * cs[0][2] + p0[1] * cs[0][3];
                            v0[2] = v0[2] * cs[1][0] + p0[2] * cs[1][1]; v0[3] = v0[3] * cs[1][2] + p0[3] * cs[1][3];
                            v1[0] = v1[0] * cs[2][0] + p1[0] * cs[2][1]; v1[1] = v1[1] * cs[2][2] + p1[1] * cs[2][3];
                            v1[2] = v1[2] * cs[3][0] + p1[2] * cs[3][1]; v1[3] = v1[3] * cs[3][2] + p1[3] * cs[3][3];
                        }
                        if (isq) { v0 = v0 * C2; v1 = v1 * C2; *(v4u*)(Qd + ((size_t)(b * NH + hb + bj) * T + t) * 128 + within0) = pack8(v0, v1); }
                        else *(v4u*)(Kd + ((size_t)(b * NH + hb + bj) * TK + (lat ? CT + t : rloc)) * 128 + within0) = pack8(v0, v1);
                    }
                }
        } else if (pn == 6 || pn == 7) {
            bf16* dst = pn == 6 ? MQ : MK; const float sc = pn == 6 ? 1.f : 0.125f; const int i0 = 32 * (wc & 1) + 8 * fq;
#pragma unroll
            for (int ai = 0; ai < 2; ++ai)
#pragma unroll
                for (int m = 0; m < 4; ++m) { const int rloc = ai * 128 + wr * 64 + m * 16 + fr, kidx = lat ? CT + tbase + rloc : rloc;
#pragma unroll
                    for (int bj = 0; bj < 2; ++bj) { const int h = 2 * bj + (wc >> 1);
                        *(v4u*)(dst + ((size_t)(b * NH + h) * TK + kidx) * 64 + i0) = pack8(acc[ai][bj][m][0] * sc, acc[ai][bj][m][1] * sc); } }
        } else if (pn < 10) {
            bf16* dst = pn < 6 ? Vd : MV; const int hb = (pn & 1) * 2;
#pragma unroll
            for (int ai = 0; ai < 2; ++ai)
#pragma unroll
                for (int m = 0; m < 4; ++m) { const int rloc = ai * 128 + wr * 64 + m * 16 + fr, kidx = lat ? CT + tbase + rloc : rloc;
#pragma unroll
                    for (int bj = 0; bj < 2; ++bj)
                        *(v4u*)(dst + ((size_t)(b * NH + hb + bj) * TK + kidx) * 128 + within0) = pack8(acc[ai][bj][m][0], acc[ai][bj][m][1]); }
        } else {
#pragma unroll
            for (int ai = 0; ai < 2; ++ai)
#pragma unroll
                for (int m = 0; m < 4; ++m) { const int row = u.pm * 256 + ai * 128 + wr * 64 + m * 16 + fr;
#pragma unroll
                    for (int bj = 0; bj < 2; ++bj) { f32x4 v0 = acc[ai][bj][m][0], v1 = acc[ai][bj][m][1];
#pragma unroll
                        for (int e = 0; e < 4; ++e) { v0[e] = __builtin_amdgcn_rcpf(1.f + __expf(-v0[e])); v1[e] = __builtin_amdgcn_rcpf(1.f + __expf(-v1[e])); }
                        *(v4u*)(MO + (size_t)row * 512 + (pn - 10) * 256 + bj * 128 + within0) = pack8(v0, v1); } }
        }
    }
};
struct EpiOutproj {
    static constexpr bool PERM = true, AFTER_DRAIN = false;
    const float* x; float* out; bf16* A2; const float* mod; const float* n2g; float* rowsq;
    __device__ __forceinline__ void operator()(const f32x4 (&acc)[2][2][4][2], const pg8::Unit& u, int wr, int wc, int fr, int fq) const {
        const int b = u.pm >> 5; const float* modr = mod + (size_t)b * 6 * D; const int col0 = u.pn * 256 + wc * 32 + fq * 8;
        f32x4 g1v[2][2], gs2[2][2];
#pragma unroll
        for (int bj = 0; bj < 2; ++bj)
#pragma unroll
            for (int n = 0; n < 2; ++n) { const int c = col0 + bj * 128 + 4 * n; g1v[bj][n] = *(const f32x4*)(modr + 2 * D + c);
                gs2[bj][n] = *(const f32x4*)(n2g + c) * (*(const f32x4*)(modr + 4 * D + c) + 1.0f); }
#pragma unroll
        for (int ai = 0; ai < 2; ++ai)
#pragma unroll
            for (int m = 0; m < 4; ++m) { const int row = u.pm * 256 + ai * 128 + wr * 64 + m * 16 + fr; float ss = 0.f;
#pragma unroll
                for (int bj = 0; bj < 2; ++bj) { const size_t o = (size_t)row * D + col0 + bj * 128;
                    const f32x4 x0 = *(const f32x4*)(x + o) + g1v[bj][0] * acc[ai][bj][m][0], x1 = *(const f32x4*)(x + o + 4) + g1v[bj][1] * acc[ai][bj][m][1];
                    *(f32x4*)(out + o) = x0; *(f32x4*)(out + o + 4) = x1;
                    ss += (x0[0] * x0[0] + x0[1] * x0[1]) + (x0[2] * x0[2] + x0[3] * x0[3]) + (x1[0] * x1[0] + x1[1] * x1[1]) + (x1[2] * x1[2] + x1[3] * x1[3]);
                    *(v4u*)(A2 + o) = pack8(x0 * gs2[bj][0], x1 * gs2[bj][1]); }
                ss += __shfl_xor(ss, 16); ss += __shfl_xor(ss, 32);
                if (fq == 0) atomicAdd(rowsq + row, ss); }
    }
};
struct EpiFc1 {
    static constexpr bool PERM = true, AFTER_DRAIN = false;
    bf16* Hh; const float* bias1; const float* rowsq;
    __device__ __forceinline__ void operator()(const f32x4 (&acc)[2][2][4][2], const pg8::Unit& u, int wr, int wc, int fr, int fq) const {
        const int b = u.pm >> 5; const int col0 = u.pn * 256 + wc * 32 + fq * 8;
        f32x4 bv[2][2];
#pragma unroll
        for (int bj = 0; bj < 2; ++bj)
#pragma unroll
            for (int n = 0; n < 2; ++n) bv[bj][n] = *(const f32x4*)(bias1 + (size_t)b * FF + col0 + bj * 128 + 4 * n);
#pragma unroll
        for (int ai = 0; ai < 2; ++ai)
#pragma unroll
            for (int m = 0; m < 4; ++m) { const int row = u.pm * 256 + ai * 128 + wr * 64 + m * 16 + fr;
                const float rstd = 1.0f / sqrtf(rowsq[row] * (1.f / D) + EPS);
#pragma unroll
                for (int bj = 0; bj < 2; ++bj) { f32x4 v0 = acc[ai][bj][m][0] * rstd + bv[bj][0], v1 = acc[ai][bj][m][1] * rstd + bv[bj][1];
#pragma unroll
                    for (int e = 0; e < 4; ++e) { const float a0 = fmaxf(v0[e], 0.f), a1 = fmaxf(v1[e], 0.f); v0[e] = a0 * a0; v1[e] = a1 * a1; }
                    *(v4u*)(Hh + (size_t)row * FF + col0 + bj * 128) = pack8(v0, v1); } }
    }
};
struct EpiFc2 {
    static constexpr bool PERM = true, AFTER_DRAIN = false;
    float* out; const float* mod; float* rowsq;
    __device__ __forceinline__ void operator()(const f32x4 (&acc)[2][2][4][2], const pg8::Unit& u, int wr, int wc, int fr, int fq) const {
        const int b = u.pm >> 5; const float* modr = mod + (size_t)b * 6 * D; const int col0 = u.pn * 256 + wc * 32 + fq * 8;
        f32x4 g2v[2][2];
#pragma unroll
        for (int bj = 0; bj < 2; ++bj)
#pragma unroll
            for (int n = 0; n < 2; ++n) g2v[bj][n] = *(const f32x4*)(modr + 5 * D + col0 + bj * 128 + 4 * n);
#pragma unroll
        for (int ai = 0; ai < 2; ++ai)
#pragma unroll
            for (int m = 0; m < 4; ++m) { const int row = u.pm * 256 + ai * 128 + wr * 64 + m * 16 + fr; float ss = 0.f;
#pragma unroll
                for (int bj = 0; bj < 2; ++bj) { const size_t o = (size_t)row * D + col0 + bj * 128;
                    const f32x4 x0 = *(const f32x4*)(out + o) + g2v[bj][0] * acc[ai][bj][m][0], x1 = *(const f32x4*)(out + o + 4) + g2v[bj][1] * acc[ai][bj][m][1];
                    *(f32x4*)(out + o) = x0; *(f32x4*)(out + o + 4) = x1;
                    ss += (x0[0] * x0[0] + x0[1] * x0[1]) + (x0[2] * x0[2] + x0[3] * x0[3]) + (x1[0] * x1[0] + x1[1] * x1[1]) + (x1[2] * x1[2] + x1[3] * x1[3]); }
                ss += __shfl_xor(ss, 16); ss += __shfl_xor(ss, 32);
                if (fq == 0) atomicAdd(rowsq + row, ss); }
    }
};

__device__ __forceinline__ void naive_mlstm(Frame& F) {
    LAS float* ks = (LAS float*)F.lds;
    LAS float* qs = ks + 64 * 64;
    LAS float* vs = qs + 64 * 64;
    LAS float* fg = vs + 64 * 128;
    LAS float* ig = fg + 64;
    const int tid = F.tid, v = tid >> 2, dq = (tid & 3) * 16;
    for (int item = F.vcu; item < 32; item += F.G) {
        const int bh = item >> 1, dir = item & 1;
        float C[16], n[16];
#pragma unroll
        for (int e = 0; e < 16; ++e) { C[e] = 0.f; n[e] = 0.f; }
        float* Hout = (dir ? F.HB : F.HF) + (size_t)bh * T * 128;
        for (int blk = 0; blk < TK / 64; ++blk) {
            int c;
            if (!dir) c = blk; else c = (blk < 4) ? (3 - blk) : (TK / 64 - 1 - (blk - 4));
            const int kidx0 = c * 64; const bool lat = c >= 4;
            const size_t base64 = ((size_t)bh * TK + kidx0) * 64, base128 = ((size_t)bh * TK + kidx0) * 128;
            for (int i = tid; i < 64 * 64; i += 512) { ks[i] = bf2f(F.MK[base64 + i]); qs[i] = bf2f(F.MQ[base64 + i]); }
            for (int i = tid; i < 64 * 128; i += 512) vs[i] = bf2f(F.MV[base128 + i]);
            if (tid < 64) { const float* g = F.gates + ((size_t)bh * TK + kidx0 + tid) * 4 + dir * 2; ig[tid] = __expf(g[0]); fg[tid] = __expf(g[1]); }
            __syncthreads();
            for (int step = 0; step < 64; ++step) {
                const int s = dir ? 63 - step : step;
                const float f = fg[s], iw = ig[s], vv = vs[s * 128 + v] * iw;
                float num = 0.f, den = 0.f;
#pragma unroll
                for (int e = 0; e < 16; ++e) { const float kk = ks[s * 64 + dq + e], qq = qs[s * 64 + dq + e];
                    C[e] = f * C[e] + vv * kk; n[e] = f * n[e] + iw * kk; num += C[e] * qq; den += n[e] * qq; }
                if (lat) {
                    num += __shfl_xor(num, 1); num += __shfl_xor(num, 2); den += __shfl_xor(den, 1); den += __shfl_xor(den, 2);
                    if ((tid & 3) == 0) Hout[(size_t)(kidx0 - CT + s) * 128 + v] = num / fmaxf(fabsf(den), 1.f);
                }
            }
            __syncthreads();
        }
    }
}
__device__ __forceinline__ void naive_mlstm_combine(Frame& F) {
    const int gw = F.vcu * NWAVES + F.wave, NGW = F.G * NWAVES, lane = F.lane;
    for (int rid = gw; rid < NTOK * NH; rid += NGW) {
        const int row = rid >> 2, h = rid & 3, b = row >> 13, t = row & (T - 1);
        const size_t o = ((size_t)(b * NH + h) * T + t) * 128 + 2 * lane;
        const float a0 = F.HF[o] + F.HB[o], a1 = F.HF[o + 1] + F.HB[o + 1];
        const float r = 1.0f / sqrtf(wave_sum(a0 * a0 + a1 * a1) * (1.f / 128.f) + EPS);
        const float* g = F.in[I_MLNG] + h * 128 + 2 * lane;
        const unsigned mo = *(const unsigned*)(F.MO + (size_t)row * 512 + h * 128 + 2 * lane);
        *(unsigned*)(F.MIX + (size_t)row * D + 512 + h * 128 + 2 * lane) = pk2(a0 * r * g[0] * bflo(mo), a1 * r * g[1] * bfhi(mo));
    }
}

__device__ __forceinline__ void naive_attn(Frame& F) {
    LAS float* qs = (LAS float*)F.lds + F.wave * 64;
    const int gw = F.vcu * NWAVES + F.wave, NGW = F.G * NWAVES, lane = F.lane;
    float lam;
    { const float s1 = wave_sum(F.in[I_LQ1][lane] * F.in[I_LK1][lane]), s2 = wave_sum(F.in[I_LQ2][lane] * F.in[I_LK2][lane]); lam = __expf(s1) - __expf(s2) + LAMBDA_INIT; }
    for (int rid = gw; rid < NB * NH * T; rid += NGW) {
        const int bh = rid >> 13, t = rid & (T - 1), b = bh >> 2, h = bh & 3;
        float o0 = 0.f, o1 = 0.f;
        for (int map = 0; map < 2; ++map) {
            qs[lane] = bf2f(F.Qd[((size_t)bh * T + t) * 128 + map * 64 + lane]);
            asm volatile("s_waitcnt lgkmcnt(0)" ::: "memory");
            float m = -1e30f, l = 0.f, a0 = 0.f, a1 = 0.f;
            for (int ch = 0; ch < TK / 64; ++ch) {
                const bf16* kp = F.Kd + ((size_t)bh * TK + ch * 64 + lane) * 128 + map * 64;
                float s = 0.f;
#pragma unroll
                for (int d8 = 0; d8 < 8; ++d8) { const v4u kv = *(const v4u*)(kp + d8 * 8); const f32x4 qa = *(const LAS f32x4*)(qs + d8 * 8), qb = *(const LAS f32x4*)(qs + d8 * 8 + 4);
                    s += bflo(kv.x) * qa.x + bfhi(kv.x) * qa.y + bflo(kv.y) * qa.z + bfhi(kv.y) * qa.w + bflo(kv.z) * qb.x + bfhi(kv.z) * qb.y + bflo(kv.w) * qb.z + bfhi(kv.w) * qb.w; }
                const float mn = fmaxf(m, wave_max(s)), alpha = exp2f(m - mn), p = exp2f(s - mn);
                l = l * alpha + wave_sum(p); a0 *= alpha; a1 *= alpha; m = mn;
                const bf16* vp = F.Vd + ((size_t)bh * TK + ch * 64) * 128 + 2 * lane;
#pragma unroll 8
                for (int kk = 0; kk < 64; ++kk) { const float pk = __shfl(p, kk); const unsigned vv = *(const unsigned*)(vp + (size_t)kk * 128); a0 += pk * bflo(vv); a1 += pk * bfhi(vv); }
            }
            const float il = 1.f / l;
            if (map == 0) { o0 = a0 * il; o1 = a1 * il; } else { o0 -= lam * a0 * il; o1 -= lam * a1 * il; }
        }
        const float r = 1.0f / sqrtf(wave_sum(o0 * o0 + o1 * o1) * (1.f / 128.f) + EPS);
        const float* g = F.in[I_SUBLN] + 2 * lane;
        *(unsigned*)(F.MIX + (size_t)(b * T + t) * D + h * 128 + 2 * lane) = pk2(o0 * r * g[0] * (1.f - LAMBDA_INIT), o1 * r * g[1] * (1.f - LAMBDA_INIT));
    }
}


namespace da {
using bf16x8 = __attribute__((ext_vector_type(8))) short;
using s16x4  = __attribute__((ext_vector_type(4))) short;
using f32x16 = __attribute__((ext_vector_type(16))) float;
using u32x4  = __attribute__((ext_vector_type(4))) unsigned;
constexpr int KVBLK = 64;
constexpr size_t SHM_V = KVBLK * 128 * 2, SHM_K = KVBLK * 128 * 2;
constexpr float THR2 = 8.f * 1.4426950408889634f;
#define KSWZ(row, colB) ((row) * 256 + ((colB) ^ (((row) & 7) << 4)))
#define SBAR() __builtin_amdgcn_sched_barrier(0)
__device__ __forceinline__ int crow(int r, int hi) { return (r & 3) + 8 * (r >> 2) + 4 * hi; }
__device__ __forceinline__ unsigned cvtpk(float lo, float hi) { unsigned r; asm volatile("v_cvt_pk_bf16_f32 %0, %1, %2" : "=v"(r) : "v"(lo), "v"(hi)); return r; }
#define PKR(P, BASE, OUT) do { u32x4 w = {cvtpk(P[BASE + 0], P[BASE + 1]), cvtpk(P[BASE + 2], P[BASE + 3]), cvtpk(P[BASE + 4], P[BASE + 5]), cvtpk(P[BASE + 6], P[BASE + 7])}; OUT = *reinterpret_cast<bf16x8*>(&w); } while (0)
__device__ __forceinline__ void partialSM(f32x16& p0, f32x16& p1, float& m_reg, float& mn, float& alpha) {
  float pmax = p0[0]; for (int r = 1; r < 16; ++r) pmax = fmaxf(pmax, p0[r]); for (int r = 0; r < 16; ++r) pmax = fmaxf(pmax, p1[r]);
  { auto rr = __builtin_amdgcn_permlane32_swap(__float_as_uint(pmax), __float_as_uint(pmax), false, false);
    pmax = fmaxf(__uint_as_float(rr[0]), __uint_as_float(rr[1])); }
  if (__builtin_expect(__all(pmax - m_reg <= THR2), 1)) { mn = m_reg; alpha = 1.f; }
  else { mn = fmaxf(m_reg, pmax); alpha = __builtin_amdgcn_exp2f(m_reg - mn); m_reg = mn; }
  for (int r = 0; r < 16; ++r) p0[r] = p0[r] - mn; for (int r = 0; r < 16; ++r) p1[r] = p1[r] - mn;
  for (int r = 0; r < 16; ++r) p0[r] = __builtin_amdgcn_exp2f(p0[r]);
}
__device__ __forceinline__ void finishSM(f32x16& p0, f32x16& p1, float alpha, float& l_reg, bf16x8& pa0, bf16x8& pa1, bf16x8& pa2, bf16x8& pa3) {
  for (int r = 0; r < 16; ++r) p1[r] = __builtin_amdgcn_exp2f(p1[r]);
  float ps = 0; for (int r = 0; r < 16; ++r) ps += p0[r]; for (int r = 0; r < 16; ++r) ps += p1[r];
  { auto rr = __builtin_amdgcn_permlane32_swap(__float_as_uint(ps), __float_as_uint(ps), false, false);
    ps = __uint_as_float(rr[0]) + __uint_as_float(rr[1]); }
  l_reg = l_reg * alpha + ps;
  PKR(p0, 0, pa0); PKR(p0, 8, pa1); PKR(p1, 0, pa2); PKR(p1, 8, pa3);
}
constexpr float FAST_BOUND = 60.f;
__device__ __forceinline__ void partialSM_fast(f32x16& p0) { for (int r = 0; r < 16; ++r) p0[r] = __builtin_amdgcn_exp2f(p0[r]); }
__device__ __forceinline__ void finishSM_fast(f32x16& p0, f32x16& p1, float& l_reg, bf16x8& pa0, bf16x8& pa1, bf16x8& pa2, bf16x8& pa3) {
  for (int r = 0; r < 16; ++r) p1[r] = __builtin_amdgcn_exp2f(p1[r]);
  float ps0 = 0, ps1 = 0, ps2 = 0, ps3 = 0;
  for (int r = 0; r < 16; r += 4) { ps0 += p0[r]; ps1 += p0[r + 1]; ps2 += p0[r + 2]; ps3 += p0[r + 3]; }
  for (int r = 0; r < 16; r += 4) { ps0 += p1[r]; ps1 += p1[r + 1]; ps2 += p1[r + 2]; ps3 += p1[r + 3]; }
  float ps = (ps0 + ps1) + (ps2 + ps3);
  { auto rr = __builtin_amdgcn_permlane32_swap(__float_as_uint(ps), __float_as_uint(ps), false, false);
    ps = __uint_as_float(rr[0]) + __uint_as_float(rr[1]); }
  l_reg += ps;
  PKR(p0, 0, pa0); PKR(p0, 8, pa1); PKR(p1, 0, pa2); PKR(p1, 8, pa3);
}
__device__ __forceinline__ void qkt(f32x16& p0, f32x16& p1, const char* Ks, const bf16x8* qr, int r32, int hi, int mapB) {
  p0 = f32x16{}; p1 = f32x16{};
  for (int d0 = 0; d0 < 4; ++d0) { int cb = mapB + (d0 * 16 + hi * 8) * 2;
    bf16x8 b0 = *reinterpret_cast<const bf16x8*>(Ks + KSWZ(r32, cb));
    bf16x8 b1 = *reinterpret_cast<const bf16x8*>(Ks + KSWZ(32 + r32, cb));
    p0 = __builtin_amdgcn_mfma_f32_32x32x16_bf16(b0, qr[d0], p0, 0, 0, 0);
    p1 = __builtin_amdgcn_mfma_f32_32x32x16_bf16(b1, qr[d0], p1, 0, 0, 0); }
}
__device__ __forceinline__ int v_st(int k, int c) { const int kk = (k & ~0xC) | ((k & 4) << 1) | ((k & 8) >> 1); return ((kk >> 3) * 4 + (c >> 5)) * 512 + ((kk & 7) * 32 + (c & 31)) * 2; }
__device__ __forceinline__ int v_st_raw(int k, int c) { return ((k >> 3) * 4 + (c >> 5)) * 512 + ((k & 7) * 32 + (c & 31)) * 2; }
__device__ __forceinline__ int v_rd_base(int lane) { return ((lane & 3) << 3) | (((lane >> 2) & 3) << 6) | (((lane >> 4) & 1) << 5) | (((lane >> 5) & 1) << 8); }
constexpr int v_rd_off(int d0, int ks, int half) { return d0 * 512 + ks * 4096 + half * 2048; }
template <int OFF> __device__ __forceinline__ s16x4 tr_read(int vb) {
  s16x4 r; asm volatile("ds_read_b64_tr_b16 %0, %1 offset:%2" : "=&v"(r) : "v"(vb), "i"(OFF) : "memory"); return r;
}
template <int D0> __device__ __forceinline__ void pv_one(f32x16& od, int vb, bf16x8 pa0, bf16x8 pa1, bf16x8 pa2, bf16x8 pa3) {
  const s16x4 l0 = tr_read<v_rd_off(D0, 0, 0)>(vb), h0 = tr_read<v_rd_off(D0, 0, 1)>(vb), l1 = tr_read<v_rd_off(D0, 1, 0)>(vb), h1 = tr_read<v_rd_off(D0, 1, 1)>(vb);
  const s16x4 l2 = tr_read<v_rd_off(D0, 2, 0)>(vb), h2 = tr_read<v_rd_off(D0, 2, 1)>(vb), l3 = tr_read<v_rd_off(D0, 3, 0)>(vb), h3 = tr_read<v_rd_off(D0, 3, 1)>(vb);
  asm volatile("s_waitcnt lgkmcnt(0)" ::: "memory"); SBAR();
#define PK(L, H) (bf16x8){L[0], L[1], L[2], L[3], H[0], H[1], H[2], H[3]}
  od = __builtin_amdgcn_mfma_f32_32x32x16_bf16(pa0, PK(l0, h0), od, 0, 0, 0);
  od = __builtin_amdgcn_mfma_f32_32x32x16_bf16(pa1, PK(l1, h1), od, 0, 0, 0);
  od = __builtin_amdgcn_mfma_f32_32x32x16_bf16(pa2, PK(l2, h2), od, 0, 0, 0);
  od = __builtin_amdgcn_mfma_f32_32x32x16_bf16(pa3, PK(l3, h3), od, 0, 0, 0);
#undef PK
}
__device__ __forceinline__ void pv_d0(f32x16* o, int vb, bf16x8 pa0, bf16x8 pa1, bf16x8 pa2, bf16x8 pa3) {
  pv_one<0>(o[0], vb, pa0, pa1, pa2, pa3); pv_one<1>(o[1], vb, pa0, pa1, pa2, pa3); pv_one<2>(o[2], vb, pa0, pa1, pa2, pa3); pv_one<3>(o[3], vb, pa0, pa1, pa2, pa3);
}
__device__ __forceinline__ void da_unit(const bf16* __restrict__ Qb, const bf16* __restrict__ Kh, const bf16* __restrict__ Vh, bf16* __restrict__ Mx,
                                        const float* __restrict__ subg, float lam, int seq, char* lds, const unsigned* kmax2, int wave_s) {
  int tid = wave_s * 64 + lane_id(); asm volatile("" : "+v"(tid));
  const int wid = tid >> 6, lane = tid & 63, r32 = lane & 31, hi = lane >> 5, map = wid >> 2, wq = wid & 3;
  char* V_lds = lds; char* K_lds = lds + 3 * SHM_V;
  float* ws = (float*)(lds + 3 * SHM_V + 3 * SHM_K) + wid * 64; float* li_l = ws; float* al_l = ws + 32;
  float m_reg = -1e30f, l_reg = 0; f32x16 o[4] = {}; bf16x8 qr[4];
  const bf16* Qw = Qb + (long)(wq * 32 + r32) * 128 + map * 64 + hi * 8;
#pragma unroll
  for (int d0 = 0; d0 < 4; ++d0) qr[d0] = *reinterpret_cast<const bf16x8*>(Qw + d0 * 16);
  const int mapB = map * 128;
  const int sr = tid >> 4, sc = (tid & 15) * 8, vst0 = v_st_raw(sr, sc), vst1 = v_st_raw(32 + sr, sc);
  const int vb0 = (int)(uintptr_t)V_lds + v_rd_base(lane);
  struct { bf16x8 vs0, vs1, ks0, ks1; } sr_;
#define SLOAD(k0) do { sr_.vs0 = *reinterpret_cast<const bf16x8*>(&Vh[(long)((k0) + sr) * 128 + sc]); sr_.vs1 = *reinterpret_cast<const bf16x8*>(&Vh[(long)((k0) + 32 + sr) * 128 + sc]); \
    sr_.ks0 = *reinterpret_cast<const bf16x8*>(&Kh[(long)((k0) + sr) * 128 + sc]); sr_.ks1 = *reinterpret_cast<const bf16x8*>(&Kh[(long)((k0) + 32 + sr) * 128 + sc]); } while (0)
#define SWRITE(so) do { *(bf16x8*)(V_lds + (so) + vst0) = sr_.vs0; *(bf16x8*)(V_lds + (so) + vst1) = sr_.vs1; const int kc = sc * 2;  \
    *(bf16x8*)(K_lds + (so) + KSWZ(sr, kc)) = sr_.ks0; *(bf16x8*)(K_lds + (so) + KSWZ(32 + sr, kc)) = sr_.ks1; } while (0)
#define SWAIT() asm volatile("s_waitcnt vmcnt(0)" ::: "memory")
#define RESC(a) do { if (__any((a) < 1.f)) { if (hi == 0) al_l[r32] = (a); asm volatile("s_waitcnt lgkmcnt(0)" ::: "memory"); \
    for (int d = 0; d < 4; ++d) for (int r = 0; r < 16; ++r) o[d][r] *= al_l[crow(r, hi)]; } } while (0)
#define ROT() do { const int t_ = sprev; sprev = scur; scur = snext; snext = t_; } while (0)
  f32x16 pA0, pA1, pB0, pB1; float mnA, mnB, alA, alB; bf16x8 pa0, pa1, pa2, pa3; const int NT = seq / KVBLK;
  int sprev = 0, scur = (int)SHM_V, snext = 2 * (int)SHM_V;
  bool fast;
  { float q2 = 0.f;
#pragma unroll
    for (int d0 = 0; d0 < 4; ++d0)
#pragma unroll
      for (int j = 0; j < 8; ++j) { const float qv = bf2f((unsigned short)qr[d0][j]); q2 += qv * qv; }
    { auto rr = __builtin_amdgcn_permlane32_swap(__float_as_uint(q2), __float_as_uint(q2), false, false); q2 = __uint_as_float(rr[0]) + __uint_as_float(rr[1]); }
    const float k2 = __uint_as_float(kmax2[map]);
    fast = __all(q2 * k2 < FAST_BOUND * FAST_BOUND); }
#define STEP(PC0, PC1, PP0, PP1, alP, mnC, alC, t) do { \
    SBAR(); qkt(PC0, PC1, K_lds + scur, qr, r32, hi, mapB); \
    finishSM(PP0, PP1, alP, l_reg, pa0, pa1, pa2, pa3); SBAR(); \
    pv_d0(o, vb0 + sprev, pa0, pa1, pa2, pa3); partialSM(PC0, PC1, m_reg, mnC, alC); \
    if ((t) + 1 < NT) { SWAIT(); SWRITE(snext); if ((t) + 2 < NT) SLOAD(((t) + 2) * KVBLK); } \
    RESC(alC); __syncthreads(); ROT(); } while (0)
#define STEPF(PC0, PC1, PP0, PP1, t) do { \
    SBAR(); qkt(PC0, PC1, K_lds + scur, qr, r32, hi, mapB); \
    finishSM_fast(PP0, PP1, l_reg, pa0, pa1, pa2, pa3); SBAR(); \
    pv_d0(o, vb0 + sprev, pa0, pa1, pa2, pa3); partialSM_fast(PC0); \
    if ((t) + 1 < NT) { SWAIT(); SWRITE(snext); if ((t) + 2 < NT) SLOAD(((t) + 2) * KVBLK); } \
    __syncthreads(); ROT(); } while (0)
  if (fast) {
    SLOAD(0); SWAIT(); SWRITE(0); SLOAD(KVBLK); __syncthreads();
    qkt(pA0, pA1, K_lds, qr, r32, hi, mapB); partialSM_fast(pA0);
    SWAIT(); SWRITE(scur); SLOAD(2 * KVBLK); __syncthreads();
    for (int t = 1; t + 1 < NT; t += 2) { STEPF(pB0, pB1, pA0, pA1, t); STEPF(pA0, pA1, pB0, pB1, t + 1); }
    STEPF(pB0, pB1, pA0, pA1, NT - 1);
    finishSM_fast(pB0, pB1, l_reg, pa0, pa1, pa2, pa3); SBAR();
    pv_d0(o, vb0 + sprev, pa0, pa1, pa2, pa3);
  } else {
    SLOAD(0); SWAIT(); SWRITE(0); SLOAD(KVBLK); __syncthreads();
    qkt(pA0, pA1, K_lds, qr, r32, hi, mapB); partialSM(pA0, pA1, m_reg, mnA, alA);
    SWAIT(); SWRITE(scur); SLOAD(2 * KVBLK); __syncthreads();
    for (int t = 1; t + 1 < NT; t += 2) {
      STEP(pB0, pB1, pA0, pA1, alA, mnB, alB, t);
      STEP(pA0, pA1, pB0, pB1, alB, mnA, alA, t + 1);
    }
    STEP(pB0, pB1, pA0, pA1, alA, mnB, alB, NT - 1);
    finishSM(pB0, pB1, alB, l_reg, pa0, pa1, pa2, pa3); SBAR();
    pv_d0(o, vb0 + sprev, pa0, pa1, pa2, pa3);
  }
#undef STEP
#undef STEPF
#undef ROT
  int lane_e = lane_id(); asm volatile("" : "+v"(lane_e));
  if (hi == 0) li_l[r32] = l_reg; asm volatile("s_waitcnt lgkmcnt(0)" ::: "memory");
  float rli[16];
#pragma unroll
  for (int r = 0; r < 16; ++r) rli[r] = __builtin_amdgcn_rcpf(li_l[crow(r, hi)]);
  __syncthreads();
  float* X = (float*)lds + (wq * 64 + lane_e) * 64;
  if (map == 1) {
#pragma unroll
    for (int d0 = 0; d0 < 4; ++d0)
#pragma unroll
      for (int r = 0; r < 16; ++r) X[d0 * 16 + r] = o[d0][r] * rli[r] * lam;
  }
  __syncthreads();
  if (map == 0) {
    float ssq[16];
#pragma unroll
    for (int r = 0; r < 16; ++r) ssq[r] = 0.f;
#pragma unroll
    for (int d0 = 0; d0 < 4; ++d0)
#pragma unroll
      for (int r = 0; r < 16; ++r) { o[d0][r] = o[d0][r] * rli[r] - X[d0 * 16 + r]; ssq[r] += o[d0][r] * o[d0][r]; }
#pragma unroll
    for (int r = 0; r < 16; ++r) {
#pragma unroll
      for (int off = 1; off < 32; off <<= 1) ssq[r] += __shfl_xor(ssq[r], off);
      ssq[r] = (1.f - LAMBDA_INIT) / sqrtf(ssq[r] * (1.f / 128.f) + EPS);
    }
    char* st = lds + 65536 + wq * 8704;
#pragma unroll
    for (int d0 = 0; d0 < 4; ++d0) { const float g = subg[d0 * 32 + (lane_e & 31)];
#pragma unroll
      for (int r = 0; r < 16; ++r) *(bf16*)(st + crow(r, lane_e >> 5) * 272 + (d0 * 32 + (lane_e & 31)) * 2) = (bf16)f2bf(o[d0][r] * ssq[r] * g); }
    asm volatile("s_waitcnt lgkmcnt(0)" ::: "memory");
    bf16* Mw = Mx + (long)(wq * 32 + (lane_e >> 4)) * D + (lane_e & 15) * 8;
#pragma unroll
    for (int it = 0; it < 8; ++it) { const u32x4 v = *(const u32x4*)(st + (it * 4 + (lane_e >> 4)) * 272 + (lane_e & 15) * 16); *(u32x4*)(Mw + (long)(it * 4) * D) = v; }
  }
  __syncthreads();
#undef SLOAD
#undef SWRITE
#undef SWAIT
#undef RESC
}
#undef KSWZ
#undef SBAR
}

__device__ __forceinline__ void knorm_pass(Frame& F) {
    const int gw = F.vcu * NWAVES + F.wave, NGW = F.G * NWAVES, lane = F.lane;
    unsigned* KM = (unsigned*)(F.ws + WS_KMAX);
    for (int it = gw; it < NB * NH * (TK / 64); it += NGW) {
        const int bh = it / (TK / 64), kb = it % (TK / 64);
        const v4u* kp = (const v4u*)(F.Kd + ((size_t)bh * TK + kb * 64 + lane) * 128);
        float s0 = 0.f, s1 = 0.f;
#pragma unroll
        for (int c = 0; c < 16; ++c) { const v4u w = kp[c]; const float a = bflo(w.x), b = bfhi(w.x), cc = bflo(w.y), d = bfhi(w.y), e = bflo(w.z), f = bfhi(w.z), g = bflo(w.w), h = bfhi(w.w);
            const float q = (a * a + b * b) + (cc * cc + d * d) + (e * e + f * f) + (g * g + h * h); if (c < 8) s0 += q; else s1 += q; }
        s0 = wave_max(s0); s1 = wave_max(s1);
        if (lane == 0) { atomicMax(KM + bh * 2, __float_as_uint(s0)); atomicMax(KM + bh * 2 + 1, __float_as_uint(s1)); }
    }
}

__device__ __forceinline__ void fast_attn(Frame& F) {
    float lam;
    { const int l = F.lane; const float s1 = wave_sum(F.in[I_LQ1][l] * F.in[I_LK1][l]), s2 = wave_sum(F.in[I_LQ2][l] * F.in[I_LK2][l]); lam = __expf(s1) - __expf(s2) + LAMBDA_INIT; lam = __builtin_bit_cast(float, __builtin_amdgcn_readfirstlane(__builtin_bit_cast(int, lam))); }
    for (int u = F.vcu * 4; u < NB * NH * (T / 128); u += F.G * 4)
        for (int i = 0; i < 4; ++i) {
            const int uu = u + i, bh = uu >> 6, qb = uu & 63, b = bh >> 2, h = bh & 3;
            da::da_unit(F.Qd + ((size_t)bh * T + qb * 128) * 128, F.Kd + (size_t)bh * TK * 128, F.Vd + (size_t)bh * TK * 128,
                        F.MIX + ((size_t)b * T + qb * 128) * D + h * 128, F.in[I_SUBLN], lam, TK, (char*)(F.lds), (const unsigned*)(F.ws + WS_KMAX) + bh * 2, F.wave);
        }
}


namespace ml {
using da::bf16x8; using da::s16x4; using da::f32x16; using da::u32x4; using da::crow; using da::cvtpk; using da::v_st; using da::v_rd_base; using da::tr_read; using da::v_rd_off;
constexpr int NCH = TK / 64;
constexpr int CE = 129 * 64;
constexpr float LOG2E = 1.4426950408889634f;
#define KSWZ64(row, colB) ((row) * 128 + ((colB) ^ ((((row) >> 1) & 7) << 4)))
__device__ __forceinline__ float scan_add(float v, int lane) {
#pragma unroll
    for (int o = 1; o < 64; o <<= 1) { const float t = __shfl_up(v, o); if (lane >= o) v += t; }
    return v;
}
__device__ __forceinline__ float scan_max(float v, int lane) {
#pragma unroll
    for (int o = 1; o < 64; o <<= 1) { const float t = __shfl_up(v, o); if (lane >= o) v = fmaxf(v, t); }
    return v;
}
__device__ __forceinline__ int pos_of(int dir, int c) { return dir ? (c < 4 ? 3 - c : 135 - c) : c; }
__device__ __forceinline__ v4u scale8(v4u x, float w) { v4u o; o.x = pk2(bflo(x.x) * w, bfhi(x.x) * w); o.y = pk2(bflo(x.y) * w, bfhi(x.y) * w); o.z = pk2(bflo(x.z) * w, bfhi(x.z) * w); o.w = pk2(bflo(x.w) * w, bfhi(x.w) * w); return o; }
#define ML_PK(L, H) (bf16x8){L[0], L[1], L[2], L[3], H[0], H[1], H[2], H[3]}

__device__ __forceinline__ void phase_a(Frame& F, float* DC, float* SCL) {
    char* lds = (char*)F.lds; const int VI = 0, KW = 16384; float* WL = (float*)(lds + 32768);
    const int tid = F.tid, lane = F.lane, wid = F.wave, r32 = lane & 31, hi = lane >> 5;
    const int dir = wid >> 2, dt = (wid >> 1) & 1, vs = wid & 1;
    const int ldsb = (int)(uintptr_t)lds;
    const int krow = tid >> 3, kch = tid & 7, sr = tid >> 4, sc = (tid & 15) * 8;
    v4u kv, v0, v1; float gli = 0.f, glf = 0.f;
#define A_LOAD(uu) do { const int bh_ = (uu) / NCH, k0_ = ((uu) % NCH) * 64; \
        kv = *(const v4u*)(F.MK + ((size_t)bh_ * TK + k0_ + krow) * 64 + kch * 8); \
        v0 = *(const v4u*)(F.MV + ((size_t)bh_ * TK + k0_ + sr) * 128 + sc); v1 = *(const v4u*)(F.MV + ((size_t)bh_ * TK + k0_ + 32 + sr) * 128 + sc); \
        if (wid < 2) { const float* g4_ = F.gates + ((size_t)bh_ * TK + k0_ + (wid ? 63 - lane : lane)) * 4 + wid * 2; gli = g4_[0]; glf = g4_[1]; } } while (0)
    if (F.vcu < NB * NH * NCH) A_LOAD(F.vcu);
    for (int u = F.vcu; u < NB * NH * NCH; u += F.G) {
        const int bh = u / NCH, c = u % NCH;
        if (wid < 2) {
            const int d = wid, s = d ? 63 - lane : lane;
            const float li = gli, lf = glf;
            const float b = scan_add(lf, lane), bl = __shfl(b, 63), g = bl - b + li, m = wave_max(g);
            WL[d * 64 + s] = __expf(g - m);
            if (lane == 0) { float* sp = SCL + ((size_t)(bh * 2 + d) * NCH + pos_of(d, c)) * 2; sp[0] = bl; sp[1] = m; }
        }
        __syncthreads();
        *(v4u*)(lds + KW + v_st(krow, kch * 8)) = scale8(kv, WL[krow]);
        *(v4u*)(lds + KW + v_st(krow, 64 + kch * 8)) = scale8(kv, WL[64 + krow]);
        *(v4u*)(lds + VI + v_st(sr, sc)) = v0; *(v4u*)(lds + VI + v_st(32 + sr, sc)) = v1;
        if (u + F.G < NB * NH * NCH) A_LOAD(u + F.G);
        __syncthreads();
        bf16x8 kw[4];
        { const int vb = ldsb + KW + v_rd_base(lane) + (2 * dir + dt) * 512;
          const s16x4 l0 = tr_read<v_rd_off(0, 0, 0)>(vb), h0 = tr_read<v_rd_off(0, 0, 1)>(vb), l1 = tr_read<v_rd_off(0, 1, 0)>(vb), h1 = tr_read<v_rd_off(0, 1, 1)>(vb);
          const s16x4 l2 = tr_read<v_rd_off(0, 2, 0)>(vb), h2 = tr_read<v_rd_off(0, 2, 1)>(vb), l3 = tr_read<v_rd_off(0, 3, 0)>(vb), h3 = tr_read<v_rd_off(0, 3, 1)>(vb);
          asm volatile("s_waitcnt lgkmcnt(0)" ::: "memory"); __builtin_amdgcn_sched_barrier(0);
          kw[0] = ML_PK(l0, h0); kw[1] = ML_PK(l1, h1); kw[2] = ML_PK(l2, h2); kw[3] = ML_PK(l3, h3); }
        float* dcb = DC + ((size_t)(bh * 2 + dir) * NCH + pos_of(dir, c)) * CE + dt * 32 + r32;
#pragma unroll
        for (int t = 0; t < 2; ++t) {
            const int vt = 2 * vs + t; const int vb = ldsb + VI + v_rd_base(lane) + vt * 512;
            const s16x4 l0 = tr_read<v_rd_off(0, 0, 0)>(vb), h0 = tr_read<v_rd_off(0, 0, 1)>(vb), l1 = tr_read<v_rd_off(0, 1, 0)>(vb), h1 = tr_read<v_rd_off(0, 1, 1)>(vb);
            const s16x4 l2 = tr_read<v_rd_off(0, 2, 0)>(vb), h2 = tr_read<v_rd_off(0, 2, 1)>(vb), l3 = tr_read<v_rd_off(0, 3, 0)>(vb), h3 = tr_read<v_rd_off(0, 3, 1)>(vb);
            asm volatile("s_waitcnt lgkmcnt(0)" ::: "memory"); __builtin_amdgcn_sched_barrier(0);
            f32x16 acc = {};
            acc = __builtin_amdgcn_mfma_f32_32x32x16_bf16(ML_PK(l0, h0), kw[0], acc, 0, 0, 0);
            acc = __builtin_amdgcn_mfma_f32_32x32x16_bf16(ML_PK(l1, h1), kw[1], acc, 0, 0, 0);
            acc = __builtin_amdgcn_mfma_f32_32x32x16_bf16(ML_PK(l2, h2), kw[2], acc, 0, 0, 0);
            acc = __builtin_amdgcn_mfma_f32_32x32x16_bf16(ML_PK(l3, h3), kw[3], acc, 0, 0, 0);
#pragma unroll
            for (int r = 0; r < 16; ++r) dcb[(size_t)(vt * 32 + crow(r, hi)) * 64] = acc[r];
        }
        if (vs == 0) {
            const short one = (r32 == 0) ? (short)0x3F80 : (short)0; const bf16x8 ones = {one, one, one, one, one, one, one, one};
            f32x16 acc = {};
#pragma unroll
            for (int ks = 0; ks < 4; ++ks) acc = __builtin_amdgcn_mfma_f32_32x32x16_bf16(ones, kw[ks], acc, 0, 0, 0);
            if (hi == 0) dcb[(size_t)128 * 64] = acc[0];
        }
        __syncthreads();
    }
#undef A_LOAD
}

__device__ __forceinline__ void phase_b(Frame& F, const float* DC, const float* SCL, bf16* CIN, float* MINV) {
    const int NPAIR = CE / 2, TOTAL = NB * NH * 2 * NPAIR;
    for (int pr = F.vcu * 512 + F.tid; pr < TOTAL; pr += F.G * 512) {
        const int cd = pr / NPAIR, e = pr % NPAIR;
        const float* dcp = DC + (size_t)cd * NCH * CE + 2 * e; const float* scp = SCL + (size_t)cd * NCH * 2;
        bf16* cop = CIN + (size_t)cd * 128 * CE + 2 * e;
        float M = 0.f, c0 = 0.f, c1 = 0.f;
        for (int p0 = 0; p0 < NCH; p0 += 12) {
            f32x2 dc[12], sl[12];
#pragma unroll
            for (int i = 0; i < 12; ++i) { dc[i] = *(const f32x2*)(dcp + (size_t)(p0 + i) * CE); sl[i] = *(const f32x2*)(scp + (p0 + i) * 2); }
#pragma unroll
            for (int i = 0; i < 12; ++i) { const int pos = p0 + i;
                if (pos >= 4) { *(unsigned*)(cop + (size_t)(pos - 4) * CE) = pk2(c0, c1); if (e == 0) MINV[cd * 128 + pos - 4] = M; }
                const float Mn = fmaxf(sl[i].x + M, sl[i].y), a = __expf(sl[i].x + M - Mn), cc = __expf(sl[i].y - Mn);
                c0 = a * c0 + cc * dc[i].x; c1 = a * c1 + cc * dc[i].y; M = Mn; }
        }
    }
}

__device__ __forceinline__ void phase_c(Frame& F, const bf16* CIN, const float* MINV) {
    char* lds = (char*)F.lds; const int ldsb = (int)(uintptr_t)lds;
    constexpr int KI = 0, VIo = 16384, CI = 49152, NLo = 81920, AAo = 82432, MMo = 82944, WIo = 83456, CFo = 83968, SCWo = 84480, SSQo = 86528, XO = 0, STO = 32768;
    float* NL = (float*)(lds + NLo); float* AA = (float*)(lds + AAo); float* MM = (float*)(lds + MMo); float* WI = (float*)(lds + WIo); float* CF = (float*)(lds + CFo);
    float* SSQ = (float*)(lds + SSQo); float* X = (float*)(lds + XO);
    const int wid = F.wave;
    const int dir = wid >> 2, rb = (wid >> 1) & 1, vh = wid & 1;
    float* SCW = (float*)(lds + SCWo) + wid * 64;
    float* ST = (float*)(lds + STO) + (rb * 2 + vh) * 2048;
    v4u kv, v0, v1, c0, c1, c2, c3; float gli = 0.f, glf = 0.f, gM = 0.f, nval = 0.f; bf16x8 qr[4];
#define C_LOAD_STAGE(uu_, tid_, lane_) do { const int bh_ = (uu_) >> 7, cl_ = (uu_) & 127, k0_ = CT + cl_ * 64; const int kr_ = (tid_) >> 3, kc_ = (tid_) & 7, sr_ = (tid_) >> 4, sc_ = ((tid_) & 15) * 8; \
        kv = *(const v4u*)(F.MK + ((size_t)bh_ * TK + k0_ + kr_) * 64 + kc_ * 8); \
        v0 = *(const v4u*)(F.MV + ((size_t)bh_ * TK + k0_ + sr_) * 128 + sc_); v1 = *(const v4u*)(F.MV + ((size_t)bh_ * TK + k0_ + 32 + sr_) * 128 + sc_); \
        const bf16* cf_ = CIN + ((size_t)(bh_ * 2 + 0) * 128 + cl_) * CE; const bf16* cb_ = CIN + ((size_t)(bh_ * 2 + 1) * 128 + (127 - cl_)) * CE; \
        c0 = *(const v4u*)(cf_ + kr_ * 64 + kc_ * 8); c1 = *(const v4u*)(cf_ + (64 + kr_) * 64 + kc_ * 8); c2 = *(const v4u*)(cb_ + kr_ * 64 + kc_ * 8); c3 = *(const v4u*)(cb_ + (64 + kr_) * 64 + kc_ * 8); \
        if ((tid_) < 128) nval = bf2f(((tid_) >> 6 ? cb_ : cf_)[128 * 64 + ((tid_) & 63)]); \
        if (wid < 2) { const int s_ = wid ? 63 - (lane_) : (lane_); const float* g4_ = F.gates + ((size_t)bh_ * TK + k0_ + s_) * 4 + wid * 2; gli = g4_[0]; glf = g4_[1]; gM = MINV[(bh_ * 2 + wid) * 128 + (wid ? 127 - cl_ : cl_)]; } } while (0)
#define C_LOAD_Q(uu_, lane_) do { const int bh_ = (uu_) >> 7, k0_ = CT + ((uu_) & 127) * 64; const int pr_ = rb * 32 + ((lane_) & 31), sw_ = dir ? 63 - pr_ : pr_; \
        const bf16* qp_ = F.MQ + ((size_t)bh_ * TK + k0_ + sw_) * 64 + ((lane_) >> 5) * 8; \
        _Pragma("unroll") for (int d0 = 0; d0 < 4; ++d0) qr[d0] = *reinterpret_cast<const bf16x8*>(qp_ + d0 * 16); } while (0)
    { const int l0_ = F.lane, t0_ = wid * 64 + l0_; C_LOAD_STAGE(F.vcu * 8, t0_, l0_); C_LOAD_Q(F.vcu * 8, l0_); }
    for (int u = F.vcu * 8; u < NB * NH * 128; u += F.G * 8)
      for (int ui = 0; ui < 8; ++ui) {
        int lane = F.lane; asm volatile("" : "+v"(lane));
        const int tid = wid * 64 + lane, r32 = lane & 31, hi = lane >> 5;
        const int uu = u + ui, bh = uu >> 7, cl = uu & 127, b = bh >> 2, h = bh & 3, t0 = cl * 64;
        const int unext = (ui < 7) ? uu + 1 : u + F.G * 8; const bool has_next = unext < NB * NH * 128;
        if (wid < 2) {
            const int d = wid;
            const float li = gli, lf = glf;
            const float bq = scan_add(lf, lane), aa = li - bq, pm = scan_max(aa, lane);
            const float M = gM, mm = fmaxf(M, pm);
            AA[d * 64 + lane] = aa * LOG2E; MM[d * 64 + lane] = mm * LOG2E; WI[d * 64 + lane] = __expf(M - mm); CF[d * 64 + lane] = __expf(-(bq + mm));
        }
        {
            const int krow = tid >> 3, kch = tid & 7, sr = tid >> 4, sc = (tid & 15) * 8;
            if (tid < 128) NL[(tid >> 6) * 64 + (tid & 63)] = nval;
            *(v4u*)(lds + KI + KSWZ64(krow, kch * 16)) = kv; *(v4u*)(lds + KI + 8192 + KSWZ64(63 - krow, kch * 16)) = kv;
            *(v4u*)(lds + VIo + v_st(sr, sc)) = v0; *(v4u*)(lds + VIo + v_st(32 + sr, sc)) = v1;
            *(v4u*)(lds + VIo + 16384 + v_st(63 - sr, sc)) = v0; *(v4u*)(lds + VIo + 16384 + v_st(31 - sr, sc)) = v1;
            *(v4u*)(lds + CI + KSWZ64(krow, kch * 16)) = c0; *(v4u*)(lds + CI + KSWZ64(64 + krow, kch * 16)) = c1;
            *(v4u*)(lds + CI + 16384 + KSWZ64(krow, kch * 16)) = c2; *(v4u*)(lds + CI + 16384 + KSWZ64(64 + krow, kch * 16)) = c3;
            if (has_next) C_LOAD_STAGE(unext, tid, lane);
        }
        const int prow = rb * 32 + r32;
        __syncthreads();
        f32x16 p0 = {}, p1 = {};
        { const char* Ks = lds + KI + dir * 8192;
#pragma unroll
          for (int d0 = 0; d0 < 4; ++d0) { const int cbb = (d0 * 16 + hi * 8) * 2;
            const bf16x8 b0 = *reinterpret_cast<const bf16x8*>(Ks + KSWZ64(r32, cbb)), b1 = *reinterpret_cast<const bf16x8*>(Ks + KSWZ64(32 + r32, cbb));
            p0 = __builtin_amdgcn_mfma_f32_32x32x16_bf16(b0, qr[d0], p0, 0, 0, 0); p1 = __builtin_amdgcn_mfma_f32_32x32x16_bf16(b1, qr[d0], p1, 0, 0, 0); } }
        const float mmp = MM[dir * 64 + prow], wip = WI[dir * 64 + prow];
#pragma unroll
        for (int r = 0; r < 16; ++r) { const int k0 = crow(r, hi), k1 = 32 + k0;
            const float e0 = __builtin_amdgcn_exp2f(AA[dir * 64 + k0] - mmp), e1 = __builtin_amdgcn_exp2f(AA[dir * 64 + k1] - mmp);
            p0[r] *= (k0 <= prow) ? e0 : 0.f; p1[r] *= (k1 <= prow) ? e1 : 0.f; }
        float ps = 0.f;
#pragma unroll
        for (int r = 0; r < 16; ++r) ps += p0[r] + p1[r];
        float nq = 0.f;
#pragma unroll
        for (int d0 = 0; d0 < 4; ++d0)
#pragma unroll
            for (int j = 0; j < 8; ++j) nq += bf2f((unsigned short)qr[d0][j]) * NL[dir * 64 + d0 * 16 + hi * 8 + j];
        { auto rr = __builtin_amdgcn_permlane32_swap(__float_as_uint(ps), __float_as_uint(ps), false, false); ps = __uint_as_float(rr[0]) + __uint_as_float(rr[1]); }
        { auto rr = __builtin_amdgcn_permlane32_swap(__float_as_uint(nq), __float_as_uint(nq), false, false); nq = __uint_as_float(rr[0]) + __uint_as_float(rr[1]); }
        const float den = ps + wip * nq, rscale = 1.0f / fmaxf(fabsf(den), CF[dir * 64 + prow]);
        if (hi == 0) SCW[r32] = rscale;
        bf16x8 pa0, pa1, pa2, pa3;
#define PK4(P, BASE, OUT) do { unsigned a0 = cvtpk(P[BASE + 0], P[BASE + 1]), a1 = cvtpk(P[BASE + 2], P[BASE + 3]);   \
    unsigned b0 = cvtpk(P[BASE + 4], P[BASE + 5]), b1 = cvtpk(P[BASE + 6], P[BASE + 7]);                              \
    auto r0 = __builtin_amdgcn_permlane32_swap(a0, b0, false, false); auto r1 = __builtin_amdgcn_permlane32_swap(a1, b1, false, false); \
    u32x4 w = {r0[0], r1[0], r0[1], r1[1]}; OUT = *reinterpret_cast<bf16x8*>(&w); } while (0)
        PK4(p0, 0, pa0); PK4(p0, 8, pa1); PK4(p1, 0, pa2); PK4(p1, 8, pa3);
#undef PK4
        f32x16 o[2] = {};
        { const int vb = ldsb + VIo + dir * 16384 + v_rd_base(lane) + (2 * vh) * 512;
          da::pv_one<0>(o[0], vb, pa0, pa1, pa2, pa3); da::pv_one<1>(o[1], vb, pa0, pa1, pa2, pa3); }
        bf16x8 qs[4];
#pragma unroll
        for (int d0 = 0; d0 < 4; ++d0) { u32x4 w;
            w[0] = cvtpk(bf2f((unsigned short)qr[d0][0]) * wip, bf2f((unsigned short)qr[d0][1]) * wip); w[1] = cvtpk(bf2f((unsigned short)qr[d0][2]) * wip, bf2f((unsigned short)qr[d0][3]) * wip);
            w[2] = cvtpk(bf2f((unsigned short)qr[d0][4]) * wip, bf2f((unsigned short)qr[d0][5]) * wip); w[3] = cvtpk(bf2f((unsigned short)qr[d0][6]) * wip, bf2f((unsigned short)qr[d0][7]) * wip);
            qs[d0] = *reinterpret_cast<bf16x8*>(&w); }
        if (has_next) C_LOAD_Q(unext, lane);
        { const char* Cs = lds + CI + dir * 16384;
#pragma unroll
          for (int t = 0; t < 2; ++t)
#pragma unroll
            for (int ks = 0; ks < 4; ++ks) { const bf16x8 cfr = *reinterpret_cast<const bf16x8*>(Cs + KSWZ64((2 * vh + t) * 32 + r32, (ks * 16 + hi * 8) * 2));
                o[t] = __builtin_amdgcn_mfma_f32_32x32x16_bf16(qs[ks], cfr, o[t], 0, 0, 0); } }
        asm volatile("s_waitcnt lgkmcnt(0)" ::: "memory");
#pragma unroll
        for (int r = 0; r < 16; ++r) { const float sv = SCW[crow(r, hi)]; o[0][r] *= sv; o[1][r] *= sv; }
        __syncthreads();
        if (dir == 1) {
#pragma unroll
            for (int t = 0; t < 2; ++t)
#pragma unroll
                for (int r = 0; r < 16; ++r) X[(63 - (rb * 32 + crow(r, hi))) * 128 + (2 * vh + t) * 32 + r32] = o[t][r];
        }
        __syncthreads();
        float ssq[16];
        if (dir == 0) {
#pragma unroll
            for (int r = 0; r < 16; ++r) { float a = 0.f;
#pragma unroll
                for (int t = 0; t < 2; ++t) { o[t][r] += X[(rb * 32 + crow(r, hi)) * 128 + (2 * vh + t) * 32 + r32]; a += o[t][r] * o[t][r]; }
#pragma unroll
                for (int off = 1; off < 32; off <<= 1) a += __shfl_xor(a, off);
                ssq[r] = a; if (r32 == 0) SSQ[(rb * 2 + vh) * 32 + crow(r, hi)] = a; }
        }
        __syncthreads();
        if (dir == 0) {
            const float* gn = F.in[I_MLNG] + h * 128 + vh * 64;
#pragma unroll
            for (int r = 0; r < 16; ++r) { const float tot = ssq[r] + SSQ[(rb * 2 + (1 - vh)) * 32 + crow(r, hi)]; const float rs = 1.0f / sqrtf(tot * (1.f / 128.f) + EPS);
#pragma unroll
                for (int t = 0; t < 2; ++t) ST[crow(r, hi) * 64 + t * 32 + r32] = o[t][r] * rs * gn[t * 32 + r32]; }
            asm volatile("s_waitcnt lgkmcnt(0)" ::: "memory");
            const size_t row0 = (size_t)b * T + t0 + rb * 32;
#pragma unroll
            for (int it = 0; it < 4; ++it) { const int row = it * 8 + (lane >> 3), ch = lane & 7;
                const f32x4 y0 = *(const f32x4*)(ST + row * 64 + ch * 8), y1 = *(const f32x4*)(ST + row * 64 + ch * 8 + 4);
                const v4u mo = *(const v4u*)(F.MO + (row0 + row) * 512 + h * 128 + vh * 64 + ch * 8);
                v4u ov; ov.x = pk2(y0[0] * bflo(mo.x), y0[1] * bfhi(mo.x)); ov.y = pk2(y0[2] * bflo(mo.y), y0[3] * bfhi(mo.y)); ov.z = pk2(y1[0] * bflo(mo.z), y1[1] * bfhi(mo.z)); ov.w = pk2(y1[2] * bflo(mo.w), y1[3] * bfhi(mo.w));
                *(v4u*)(F.MIX + (row0 + row) * D + 512 + h * 128 + vh * 64 + ch * 8) = ov; }
        }
        __syncthreads();
      }
#undef C_LOAD_STAGE
#undef C_LOAD_Q
}
#undef KSWZ64
#undef ML_PK
}

__device__ __forceinline__ void p_final(Frame& F) {
    const int gw = F.vcu * NWAVES + F.wave, NGW = F.G * NWAVES, lane = F.lane;
    f32x4 g[4];
#pragma unroll
    for (int j = 0; j < 4; ++j) g[j] = *(const f32x4*)(F.in[I_FING] + 4 * lane + 256 * j);
    for (int row = gw; row < NTOK; row += 4 * NGW) {
        f32x4 v[4][4]; float rs[4];
#pragma unroll
        for (int q = 0; q < 4; ++q) { const int r = row + q * NGW; if (r < NTOK) { rs[q] = F.rowsq2[r];
#pragma unroll
            for (int j = 0; j < 4; ++j) v[q][j] = *(const f32x4*)(F.out + (size_t)r * D + 4 * lane + 256 * j); } }
#pragma unroll
        for (int q = 0; q < 4; ++q) { const int r = row + q * NGW; if (r < NTOK) { const float rstd = 1.0f / sqrtf(rs[q] * (1.f / D) + EPS);
#pragma unroll
            for (int j = 0; j < 4; ++j) *(f32x4*)(F.out + (size_t)r * D + 4 * lane + 256 * j) = (v[q][j] * rstd) * g[j]; } }
    }
}

#define XB_TMO      128
#define XB_XCNT(j)  (256  + 64 * (j))
#define XB_XSUB(j)  (1280 + 64 * (j))
#define XB_XGEN(j)  (2304 + 64 * (j))
#define XB_TOP      3328
#define XB_TOPGEN   3392
#define XCD_BAR_WORDS 3456
#define XB_SPIN_CAP (1u << 22)
constexpr int CW_BAR = 4096;
constexpr int MISC_OFF = 131072 + 320;
__device__ __forceinline__ unsigned xb_ld(unsigned* p)              { return __hip_atomic_load(p, __ATOMIC_RELAXED, __HIP_MEMORY_SCOPE_AGENT); }
__device__ __forceinline__ unsigned xb_add(unsigned* p, unsigned v) { return __hip_atomic_fetch_add(p, v, __ATOMIC_RELAXED, __HIP_MEMORY_SCOPE_AGENT); }
__device__ __forceinline__ unsigned xb_xcc_id() { return (unsigned)__builtin_amdgcn_s_getreg((3 << 11) | 20) & 0xFu; }
#define XB_SPIN(cond, bar) do { unsigned _sp = 0; while (cond) { __builtin_amdgcn_s_sleep(1); \
    if ((++_sp & 255u) == 0u) { if (xb_ld(&(bar)[XB_TMO])) break; if (_sp > XB_SPIN_CAP) { atomicAdd(&(bar)[XB_TMO], 1u); break; } } } } while (0)
struct XcdBarrier { unsigned* bar; unsigned x; volatile LAS unsigned* st; };
__device__ __forceinline__ XcdBarrier xcd_barrier_post(unsigned* bar, volatile LAS unsigned* st, int tid) {
    XcdBarrier b; b.bar = bar; b.x = xb_xcc_id(); b.st = st;
    if (tid == 0) (void)xb_add(&bar[XB_XCNT(b.x)], 1u);
    return b;
}
__device__ __forceinline__ void xcd_barrier_complete(unsigned* bar, unsigned x, unsigned& nloc, unsigned& nx) {
    const unsigned G = gridDim.x * gridDim.y * gridDim.z;
    unsigned sum, cnt, mine, sp = 0u;
    for (;;) {
        sum = 0u; cnt = 0u; mine = 0u;
#pragma unroll
        for (unsigned j = 0; j < 16; ++j) { const unsigned c = xb_ld(&bar[XB_XCNT(j)]); sum += c; cnt += (c > 0u) ? 1u : 0u; mine = (j == x) ? c : mine; }
        if (sum == G) break;
        __builtin_amdgcn_s_sleep(1);
        if ((++sp & 255u) == 0u) { if (xb_ld(&bar[XB_TMO])) break; if (sp > XB_SPIN_CAP) { atomicAdd(&bar[XB_TMO], 1u); break; } }
    }
    nloc = mine > 0u ? mine : 1u; nx = cnt > 0u ? cnt : 1u;
}
__device__ __forceinline__ void xcd_barrier(const XcdBarrier& b, int tid) {
    asm volatile("s_waitcnt vmcnt(0)" ::: "memory");
    __syncthreads();
    if (tid == 0) {
        unsigned* bar = b.bar;
        __builtin_amdgcn_s_waitcnt(0);
        unsigned nloc = b.st[0], nx = b.st[1];
        if (nloc == 0u) { xcd_barrier_complete(bar, b.x, nloc, nx); b.st[0] = nloc; b.st[1] = nx; }
        const unsigned old = xb_add(&bar[XB_XSUB(b.x)], 1u);
        const unsigned gen = old / nloc;
        if (old + 1u == (gen + 1u) * nloc) {
            __builtin_amdgcn_fence(__ATOMIC_RELEASE, "agent");
            asm volatile("s_waitcnt vmcnt(0)" ::: "memory");
            const unsigned og = xb_add(&bar[XB_TOP], 1u);
            const unsigned tg = og / nx;
            if (og + 1u == (tg + 1u) * nx) xb_add(&bar[XB_TOPGEN], 1u);
            else XB_SPIN(xb_ld(&bar[XB_TOPGEN]) == tg, bar);
            __builtin_amdgcn_fence(__ATOMIC_ACQUIRE, "agent");
            xb_add(&bar[XB_XGEN(b.x)], 1u);
            asm volatile("s_waitcnt vmcnt(0)" ::: "memory");
        } else {
            XB_SPIN(xb_ld(&bar[XB_XGEN(b.x)]) == gen, bar);
            __builtin_amdgcn_fence(__ATOMIC_ACQUIRE, "agent");
            asm volatile("s_waitcnt vmcnt(0)" ::: "memory");
        }
    }
    __syncthreads();
}

constexpr int NPHASE = 10;
__global__ void __launch_bounds__(NWAVES * 64, 2) fwd_kernel(Args args) {
    extern __shared__ __attribute__((aligned(16))) unsigned char lds_raw[];
    Frame F;
    F.lds = (LAS unsigned char*)lds_raw;
    F.tid = threadIdx.x; F.lane = F.tid & 63; F.wave = __builtin_amdgcn_readfirstlane(F.tid >> 6);
    F.G = gridDim.x; { const int bx = blockIdx.x; F.vcu = (F.G % 8 == 0) ? (bx % 8) * (F.G / 8) + bx / 8 : bx; }
#pragma unroll
    for (int i = 0; i < 20; ++i) F.in[i] = args.in[i];
    F.out = args.out; F.ws = args.ws; unsigned char* ws = args.ws;
    F.mod = (float*)(ws + WS_MOD); F.rope = (f32x2*)(ws + WS_ROPE); F.bias1 = (float*)(ws + WS_BIAS1); F.wgt = (float*)(ws + WS_WGT); F.gates = (float*)(ws + WS_G);
    F.rowsq1 = (float*)(ws + WS_ROWSQ1); F.rowsq2 = (float*)(ws + WS_ROWSQ2);
    F.WinT = (bf16*)(ws + WS_WIN); F.WoT = (bf16*)(ws + WS_WO); F.W1T = (bf16*)(ws + WS_W1); F.W2T = (bf16*)(ws + WS_W2);
    F.XM = (bf16*)(ws + WS_XM); F.A2 = (bf16*)(ws + WS_XM);
    F.Qd = (bf16*)(ws + WS_Q); F.Kd = (bf16*)(ws + WS_K); F.Vd = (bf16*)(ws + WS_V); F.MQ = (bf16*)(ws + WS_MQ); F.MK = (bf16*)(ws + WS_MK); F.MV = (bf16*)(ws + WS_MV); F.MO = (bf16*)(ws + WS_MO);
    F.HF = (float*)(ws + WS_DC); F.HB = (float*)(ws + WS_DC + 64 * MiB);
#if FAST_MLSTM
    F.MIX = (bf16*)(ws + WS_DC);
#else
    F.MIX = (bf16*)(ws + WS_CIN);
#endif
    F.Hh = (bf16*)(ws + WS_H);
    const int lo = args.ph_lo, hi = args.ph_hi;
    for (int u = F.tid; u < (LDS_BYTES - 131072) / 4; u += NWAVES * 64) ((LAS unsigned*)(F.lds + 131072))[u] = 0u;
    __syncthreads();
    XcdBarrier bar = xcd_barrier_post((unsigned*)(ws + WS_CTL) + CW_BAR + args.li * XCD_BAR_WORDS, (volatile LAS unsigned*)(F.lds + MISC_OFF), F.tid);
#define IN(k) (refresh_ids(F), (lo <= (k) && (k) < hi))
#define SEAM(k) do { if (IN(k) && IN((k) + 1)) xcd_barrier(bar, F.tid); } while (0)
    if (IN(0)) { p0_prologue(F); if (DOUBLE_MASK & 1) { __syncthreads(); p0_prologue(F); } }
    SEAM(0);
    if (IN(1)) { p1_rows(F); if (DOUBLE_MASK & 2) { __syncthreads(); p1_rows(F); } }
    SEAM(1);
#if FAST_GEMM & 1
    if (IN(2)) { pg8::Gemm g{F.XM, F.WinT, MROWS, INP, D}; pg8::StaticOrder S; S.init(MROWS, INP, F.G, (int)blockIdx.x);
        EpiInproj E{F.Qd, F.Kd, F.Vd, F.MQ, F.MK, F.MV, F.MO, F.rope}; pg8::gemm_phase<EpiInproj, pg8::StaticOrder, true, true>(F.lds, g, S, E, F.tid);
        if (DOUBLE_MASK & 4) { __syncthreads(); pg8::gemm_phase<EpiInproj, pg8::StaticOrder, true, true>(F.lds, g, S, E, F.tid); } }
#else
    if (IN(2)) naive_gemm(F, F.XM, D, MROWS, F.in[I_WIN], INC, INP, D, NaiveInprojEpi{});
#endif
    SEAM(2);
#if FAST_MLSTM
    if (IN(3)) { knorm_pass(F); refresh_ids(F); ml::phase_a(F, (float*)(ws + WS_DC), (float*)(ws + WS_SCL)); if (DOUBLE_MASK & 8) { __syncthreads(); ml::phase_a(F, (float*)(ws + WS_DC), (float*)(ws + WS_SCL)); } }
    SEAM(3);
    if (IN(4)) { ml::phase_b(F, (const float*)(ws + WS_DC), (const float*)(ws + WS_SCL), (bf16*)(ws + WS_CIN), (float*)(ws + WS_MIN)); if (DOUBLE_MASK & 16) ml::phase_b(F, (const float*)(ws + WS_DC), (const float*)(ws + WS_SCL), (bf16*)(ws + WS_CIN), (float*)(ws + WS_MIN)); }
    SEAM(4);
    if (IN(5)) { fast_attn(F); if (DOUBLE_MASK & 32) fast_attn(F); refresh_ids(F); ml::phase_c(F, (const bf16*)(ws + WS_CIN), (const float*)(ws + WS_MIN)); if (DOUBLE_MASK & 64) { refresh_ids(F); ml::phase_c(F, (const bf16*)(ws + WS_CIN), (const float*)(ws + WS_MIN)); } }
#else
    if (IN(3)) naive_mlstm(F);
    SEAM(3);
    SEAM(4);
    if (IN(5)) { fast_attn(F); refresh_ids(F); naive_mlstm_combine(F); }
#endif
    SEAM(5);
#if FAST_GEMM & 2
    if (IN(6)) { pg8::Gemm g{F.MIX, F.WoT, NTOK, D, D}; pg8::StaticOrder S; S.init(NTOK, D, F.G, (int)blockIdx.x);
        EpiOutproj E{F.in[I_X], F.out, F.A2, F.mod, F.in[I_N2G], F.rowsq1}; pg8::gemm_phase<EpiOutproj, pg8::StaticOrder, true, true>(F.lds, g, S, E, F.tid); }
#else
    if (IN(6)) naive_gemm(F, F.MIX, D, NTOK, F.in[I_WOUT], D, D, D, NaiveOutprojEpi{});
#endif
    SEAM(6);
#if FAST_GEMM & 4
    if (IN(7)) { pg8::Gemm g{F.A2, F.W1T, NTOK, FF, D}; pg8::StaticOrder S; S.init(NTOK, FF, F.G, (int)blockIdx.x);
        EpiFc1 E{F.Hh, F.bias1, F.rowsq1}; pg8::gemm_phase<EpiFc1, pg8::StaticOrder, true, true>(F.lds, g, S, E, F.tid);
        if (DOUBLE_MASK & 128) { __syncthreads(); pg8::gemm_phase<EpiFc1, pg8::StaticOrder, true, true>(F.lds, g, S, E, F.tid); } }
#else
    if (IN(7)) naive_gemm(F, F.A2, D, NTOK, F.in[I_WFC1], FF, FF, D, NaiveFc1Epi{});
#endif
    SEAM(7);
#if FAST_GEMM & 8
    if (IN(8)) { pg8::Gemm g{F.Hh, F.W2T, NTOK, D, FF}; pg8::StaticOrder S; S.init(NTOK, D, F.G, (int)blockIdx.x);
        EpiFc2 E{F.out, F.mod, F.rowsq2}; pg8::gemm_phase<EpiFc2, pg8::StaticOrder, true, true>(F.lds, g, S, E, F.tid); }
#else
    if (IN(8)) naive_gemm(F, F.Hh, FF, NTOK, F.in[I_WFC2], D, D, FF, NaiveFc2Epi{});
#endif
    SEAM(8);
    if (IN(9)) p_final(F);
#undef IN
#undef SEAM
}

extern "C" void kernel_launch(void* const* d_in, const int* in_sizes, int n_in, void* d_out, int out_size, void* d_ws, size_t ws_size, hipStream_t stream) {
    static int grid = 0;
    if (grid == 0) {
        if (n_in != 20 || in_sizes[0] != NTOK * D || out_size != NTOK * D || ws_size < WS_END) { fprintf(stderr, "kernel_launch: unexpected shapes n_in %d in0 %d out %d ws %zu\n", n_in, n_in > 0 ? in_sizes[0] : -1, out_size, ws_size); grid = -1; return; }
        int dev = 0, cus = 0, per_cu = 0;
        if (hipGetDevice(&dev) != hipSuccess || hipDeviceGetAttribute(&cus, hipDeviceAttributeMultiprocessorCount, dev) != hipSuccess) { grid = -1; return; }
        if (hipFuncSetAttribute((const void*)fwd_kernel, hipFuncAttributeMaxDynamicSharedMemorySize, LDS_BYTES) != hipSuccess) { fprintf(stderr, "kernel_launch: hipFuncSetAttribute failed\n"); grid = -1; return; }
        if (hipOccupancyMaxActiveBlocksPerMultiprocessor(&per_cu, (const void*)fwd_kernel, NWAVES * 64, LDS_BYTES) != hipSuccess || per_cu < 1) { fprintf(stderr, "kernel_launch: occupancy query says %d\n", per_cu); per_cu = 1; }
        (void)hipGetLastError();
        grid = cus;
    }
    if (grid < 0) return;
    (void)hipMemsetAsync((char*)d_ws + WS_CTL, 0, CTL_ZERO_BYTES, stream);
    Args a{};
    for (int i = 0; i < 20; ++i) a.in[i] = (const float*)d_in[i];
    a.out = (float*)d_out; a.ws = (unsigned char*)d_ws;
    a.ph_lo = 0; a.ph_hi = NPHASE; a.li = 0;
    hipLaunchKernelGGL(fwd_kernel, dim3(grid), dim3(NWAVES * 64), LDS_BYTES, stream, a);
}
```
